# Optimizing an MI355X kernel written in HIP

```python
import math
import jax, jax.numpy as jnp
from jax import lax
import numpy as np

D_MODEL = 1024
BATCH = 8
SEQ = 4096
DEPTH = 2

MEM_LEN = 256
EPS = 1e-6
ROPE_BASE = 10000.0
RET_HEADS = 4
RET_DK = 128
RET_DV = 256
RET_CHUNK = 128
SWA_Q_HEADS = 16
SWA_KV_HEADS = 2
SWA_HD = 64
SWA_WINDOW = 128
MEM_HEADS = 4
MEM_HD = 256
D_FF = 2816
N_BRANCH = 3

RET_QK_W = RET_HEADS * RET_DK
RET_V_W = RET_HEADS * RET_DV
SWA_Q_W = SWA_Q_HEADS * SWA_HD
SWA_KV_W = SWA_KV_HEADS * SWA_HD
MEM_Q_W = MEM_HEADS * MEM_HD
SPLITS = [RET_QK_W, RET_QK_W, RET_V_W, RET_V_W, SWA_Q_W, SWA_KV_W, SWA_KV_W, MEM_Q_W, N_BRANCH * D_MODEL]
IN_W = sum(SPLITS)
SPLIT_POINTS = [sum(SPLITS[:i + 1]) for i in range(len(SPLITS) - 1)]
NEG_INF = -1e30

kernel_name = "hybrid_retention_swa_sink_memory_macaron"


def rmsnorm(x, g):
    xf = x.astype(jnp.float32)
    y = xf * lax.rsqrt(jnp.mean(xf * xf, axis=-1, keepdims=True) + EPS)
    return (y * g.astype(jnp.float32)).astype(x.dtype)


def swiglu(h, w1, w3, w2):
    return (jax.nn.silu(h @ w1) * (h @ w3)) @ w2


def rotary(x):
    S, d = x.shape[1], x.shape[-1]
    half = d // 2
    inv = ROPE_BASE ** (-jnp.arange(half, dtype=jnp.float32) / half)
    ang = jnp.arange(S, dtype=jnp.float32)[:, None] * inv[None, :]
    cos = jnp.cos(ang)[None, :, None, :]
    sin = jnp.sin(ang)[None, :, None, :]
    x1, x2 = x[..., :half], x[..., half:]
    return jnp.concatenate([x1 * cos - x2 * sin, x1 * sin + x2 * cos], axis=-1)


def retention(q, k, v):
    out_dtype = v.dtype
    B, S, H, dk = q.shape
    dv = v.shape[-1]
    C = RET_CHUNK
    N = S // C
    f32 = jnp.float32
    log_g = jnp.log1p(-jnp.power(2.0, -5.0 - jnp.arange(H, dtype=f32)))
    q = rotary(q.astype(f32))
    k = rotary(k.astype(f32)) * (dk ** -0.5)
    v = v.astype(f32)
    qc = q.reshape(B, N, C, H, dk)
    kc = k.reshape(B, N, C, H, dk)
    vc = v.reshape(B, N, C, H, dv)
    i = jnp.arange(C, dtype=f32)
    diff = i[:, None] - i[None, :]
    intra_decay = jnp.where(diff[None] >= 0,
                            jnp.exp(jnp.maximum(diff, 0.0)[None] * log_g[:, None, None]), 0.0)
    s = jnp.einsum('bnchd,bnshd->bnhcs', qc, kc) * intra_decay
    intra = jnp.einsum('bnhcs,bnshe->bnche', s, vc)
    zeta = jnp.exp((C - 1 - i)[:, None] * log_g[None, :])
    xi = jnp.exp((i + 1)[:, None] * log_g[None, :])
    chunk_state = jnp.einsum('bnchd,bnche->bnhde', kc * zeta[..., None], vc)
    g_chunk = jnp.exp(C * log_g)[:, None, None]

    def step(R, st):
        return R * g_chunk + st, R

    _, prev = lax.scan(step, jnp.zeros((B, H, dk, dv), f32), jnp.moveaxis(chunk_state, 1, 0))
    prev = jnp.moveaxis(prev, 0, 1)
    cross = jnp.einsum('bnchd,bnhde->bnche', qc * xi[..., None], prev)
    return (intra + cross).reshape(B, S, H, dv).astype(out_dtype)


def sliding_window_attention(q, k, v, sinks):
    B, S, Hq, hd = q.shape
    Hkv = k.shape[2]
    G = Hq // Hkv
    W = SWA_WINDOW
    N = S // W
    qb = q.reshape(B, N, W, Hkv, G, hd)
    kb = k.reshape(B, N, W, Hkv, hd)
    vb = v.reshape(B, N, W, Hkv, hd)
    pad = ((0, 0), (1, 0), (0, 0), (0, 0), (0, 0))
    kk = jnp.concatenate([jnp.pad(kb, pad)[:, :-1], kb], axis=2)
    vv = jnp.concatenate([jnp.pad(vb, pad)[:, :-1], vb], axis=2)
    s = jnp.einsum('bnqkgd,bnskd->bnkgqs', qb, kk,
                   preferred_element_type=jnp.float32) * (hd ** -0.5)
    qpos = jnp.arange(W)[:, None] + W
    kpos = jnp.arange(2 * W)[None, :]
    rel = qpos - kpos
    band = (rel >= 0) & (rel < W)
    first = (jnp.arange(N) == 0)[:, None, None] & (kpos < W)[None]
    valid = band[None] & ~first
    s = jnp.where(valid[None, :, None, None], s, NEG_INF)
    sink = sinks.astype(jnp.float32).reshape(Hkv, G)[None, None, :, :, None, None]
    m = jnp.maximum(jnp.max(s, axis=-1, keepdims=True), sink)
    p = jnp.exp(s - m)
    p = p / (jnp.sum(p, axis=-1, keepdims=True) + jnp.exp(sink - m))
    o = jnp.einsum('bnkgqs,bnskd->bnqkgd', p.astype(v.dtype), vv)
    return o.reshape(B, S, Hq * hd)


def memory_attention(q, mk, mv):
    B, S, H, d = q.shape
    s = jnp.einsum('bshd,bmhd->bhsm', q, mk, preferred_element_type=jnp.float32) * (d ** -0.5)
    p = jax.nn.softmax(s, axis=-1)
    o = jnp.einsum('bhsm,bmhd->bshd', p.astype(mv.dtype), mv)
    return o.reshape(B, S, H * d)


def setup_inputs(seed: int = 0) -> dict:
    key = jax.random.key(seed)
    ks = jax.random.split(key, 24)
    L, D, F = DEPTH, D_MODEL, D_FF

    def w(k, shape, fan_in):
        return jax.random.normal(k, shape, jnp.float32) * (fan_in ** -0.5)

    def gain(k, shape):
        return 1.0 + 0.02 * jax.random.normal(k, shape, jnp.float32)

    return {
        "x": jax.random.normal(ks[0], (BATCH, SEQ, D), jnp.float32),
        "mem": jax.random.normal(ks[1], (BATCH, MEM_LEN, D), jnp.float32),
        "norm_ffn1": gain(ks[2], (L, D)),
        "ffn1_w1": w(ks[3], (L, D, F), D),
        "ffn1_w3": w(ks[4], (L, D, F), D),
        "ffn1_w2": w(ks[5], (L, F, D), F),
        "norm_mix": gain(ks[6], (L, D)),
        "w_in": w(ks[7], (L, D, IN_W), D),
        "ret_gn": gain(ks[8], (L, RET_V_W)),
        "swa_sinks": 0.5 * jax.random.normal(ks[9], (L, SWA_Q_HEADS), jnp.float32),
        "norm_mem": gain(ks[10], (L, D)),
        "w_mem_kv": w(ks[11], (L, D, 2 * MEM_Q_W), D),
        "w_up_ret": w(ks[12], (L, RET_V_W, D), RET_V_W),
        "w_up_swa": w(ks[13], (L, SWA_Q_W, D), SWA_Q_W),
        "w_up_mem": w(ks[14], (L, MEM_Q_W, D), MEM_Q_W),
        "w_o": w(ks[15], (L, D, D), D),
        "norm_ffn2": gain(ks[16], (L, D)),
        "ffn2_w1": w(ks[17], (L, D, F), D),
        "ffn2_w3": w(ks[18], (L, D, F), D),
        "ffn2_w2": w(ks[19], (L, F, D), F),
        "norm_final": gain(ks[20], (D,)),
    }


def reference(x, mem, norm_ffn1, ffn1_w1, ffn1_w3, ffn1_w2, norm_mix, w_in, ret_gn, swa_sinks,
              norm_mem, w_mem_kv, w_up_ret, w_up_swa, w_up_mem, w_o, norm_ffn2, ffn2_w1,
              ffn2_w3, ffn2_w2, norm_final):
    B, S, D = x.shape
    for l in range(DEPTH):
        h = rmsnorm(x, norm_ffn1[l])
        x = x + 0.5 * swiglu(h, ffn1_w1[l], ffn1_w3[l], ffn1_w2[l])

        h = rmsnorm(x, norm_mix[l])
        proj = h @ w_in[l]
        rq, rk, rv, rg, sq, sk, sv, mq, gl = jnp.split(proj, SPLIT_POINTS, axis=-1)

        ret = retention(rq.reshape(B, S, RET_HEADS, RET_DK),
                        rk.reshape(B, S, RET_HEADS, RET_DK),
                        rv.reshape(B, S, RET_HEADS, RET_DV))
        ret = rmsnorm(ret, ret_gn[l].reshape(RET_HEADS, RET_DV))
        ret = ret.reshape(B, S, RET_V_W) * jax.nn.silu(rg)

        swa = sliding_window_attention(sq.reshape(B, S, SWA_Q_HEADS, SWA_HD),
                                       sk.reshape(B, S, SWA_KV_HEADS, SWA_HD),
                                       sv.reshape(B, S, SWA_KV_HEADS, SWA_HD),
                                       swa_sinks[l])

        mkv = rmsnorm(mem, norm_mem[l]) @ w_mem_kv[l]
        mk, mv = jnp.split(mkv, 2, axis=-1)
        mo = memory_attention(mq.reshape(B, S, MEM_HEADS, MEM_HD),
                              mk.reshape(B, MEM_LEN, MEM_HEADS, MEM_HD),
                              mv.reshape(B, MEM_LEN, MEM_HEADS, MEM_HD))

        gates = jax.nn.sigmoid(gl.reshape(B, S, N_BRANCH, D))
        merged = (gates[:, :, 0] * (ret @ w_up_ret[l])
                  + gates[:, :, 1] * (swa @ w_up_swa[l])
                  + gates[:, :, 2] * (mo @ w_up_mem[l]))
        x = x + merged @ w_o[l]

        h = rmsnorm(x, norm_ffn2[l])
        x = x + 0.5 * swiglu(h, ffn2_w1[l], ffn2_w3[l], ffn2_w2[l])
    return rmsnorm(x, norm_final)
```

```cpp
#include <hip/hip_runtime.h>
#include <hip/hip_cooperative_groups.h>
#include <cstdio>
#include <cstdint>
namespace cg = cooperative_groups;

#ifndef MK_ONE_LAUNCH
#define MK_ONE_LAUNCH 1
#endif

#ifndef PHMASK
#define PHMASK 0xffff
#endif
#define LAS __attribute__((address_space(3)))
typedef unsigned short bf16_t;
typedef short bf16x8 __attribute__((ext_vector_type(8)));
typedef short bf16x4 __attribute__((ext_vector_type(4)));
typedef float f32x4 __attribute__((ext_vector_type(4)));
typedef float f32x2 __attribute__((ext_vector_type(2)));
typedef unsigned u32x4 __attribute__((ext_vector_type(4)));
typedef unsigned u32x2 __attribute__((ext_vector_type(2)));

constexpr int T_ALL = 32768, DM = 1024, FF = 2816, INW = 8448, T_HALF = 16384, SEQ = 4096;
constexpr int C_RQ = 0, C_RK = 512, C_RV = 1024, C_RG = 2048, C_SQ = 3072, C_SK = 4096, C_SV = 4224, C_MQ = 4352, C_GL = 5376;
constexpr int LDS_BYTES = 143360;
constexpr int NPL = 19, NPH = 2 * NPL + 1;

constexpr size_t SZ_W13 = (size_t)2 * FF * DM * 2, SZ_W2 = (size_t)DM * FF * 2;
constexpr size_t WS_W13A = 0, WS_W2A = WS_W13A + SZ_W13, WS_W13B = WS_W2A + SZ_W2, WS_W2B = WS_W13B + SZ_W13;
constexpr size_t WS_WIN = WS_W2B + SZ_W2, WS_WMKV = WS_WIN + (size_t)INW * DM * 2, WS_WUP = WS_WMKV + (size_t)2048 * DM * 2;
constexpr size_t WS_WO = WS_WUP + (size_t)3 * DM * DM * 2, WS_TAB = WS_WO + (size_t)DM * DM * 2;
constexpr size_t WS_MEMH = WS_TAB + (size_t)SEQ * 64 * 8, WS_MK = WS_MEMH + (size_t)2048 * DM * 2, WS_MVT = WS_MK + (size_t)2048 * DM * 2;
constexpr size_t WS_H = WS_MVT + (size_t)2048 * DM * 2, WS_TMP = WS_H + (size_t)T_ALL * DM * 2;
constexpr size_t WS_U = WS_TMP, WS_PROJ = WS_TMP, WS_ST = WS_PROJ + (size_t)T_HALF * INW * 2;
constexpr size_t WS_END = WS_ST + (size_t)512 * 32768 * 4;

struct Params {
    const float* in[21];
    float* out;
    unsigned char* ws;
};

__device__ __forceinline__ unsigned cvt_pk_bf16(float lo, float hi) { unsigned r; asm volatile("v_cvt_pk_bf16_f32 %0, %1, %2" : "=v"(r) : "v"(lo), "v"(hi)); return r; }
__device__ __forceinline__ bf16_t f2bf(float f) { return (bf16_t)(cvt_pk_bf16(f, 0.f) & 0xffffu); }
__device__ __forceinline__ float bf2f(unsigned b) { return __uint_as_float(b << 16); }
__device__ __forceinline__ float bflo(unsigned w) { return __uint_as_float(w << 16); }
__device__ __forceinline__ float bfhi(unsigned w) { return __uint_as_float(w & 0xffff0000u); }
__device__ __forceinline__ float wave_sum(float v) {
#pragma unroll
    for (int o = 1; o < 64; o <<= 1) v += __shfl_xor(v, o);
    return v;
}
__device__ __forceinline__ f32x4 mfma16(bf16x8 a, bf16x8 b, f32x4 c) { return __builtin_amdgcn_mfma_f32_16x16x32_bf16(a, b, c, 0, 0, 0); }
__device__ __forceinline__ float sigmoidf_(float x) { return 1.0f / (1.0f + __expf(-x)); }
__device__ __forceinline__ float log2g(int h) { return h == 0 ? -0.04580368961312479f : h == 1 ? -0.02272007650008353f : h == 2 ? -0.011315313227834146f : -0.005646563141142063f; }

namespace pg8 {
constexpr int BM = 256, BK = 64, HALF = 128, HTB = HALF * BK * 2, STAGE_BYTES = 8 * HTB, NXCD = 8, WGM = 8;
__host__ __device__ __forceinline__ int lds_byte(int r, int c) { const int st = (r >> 4) * 2 + (c >> 5), rr = r & 15, cc = c & 31, ob = rr * 64 + cc * 2; return st * 1024 + (ob ^ (((ob >> 9) & 1) << 5)); }
__host__ __device__ __forceinline__ void stage_rc(int b, int& R, int& C) { const int st = b / 1024, sb = b % 1024, swz = sb ^ (((sb >> 9) & 1) << 5); R = (st >> 1) * 16 + swz / 64; C = (st & 1) * 32 + (swz % 64) / 2; }
__host__ __device__ __forceinline__ int perm32(int rho) { const int n = rho >> 4, i = rho & 15; return 8 * (i >> 2) + 4 * n + (i & 3); }

struct Unit { int pm, pn, z; };
struct Gemm { const bf16_t* A; const bf16_t* Bt; int M, N, K, lda; int zoff0, zoff1, zoff2; long zB; };

struct Order {
    int nM, nN, nwg, G, c, nZ;
    __device__ void init(int M, int N, int G_, int c_, int nZ_) { nM = M / BM; nN = N / BM; nwg = nM * nN; G = G_; c = c_; nZ = nZ_; }
    __device__ bool next(int i, Unit& u) const {
        int rnd = i, z = 0;
        if (nZ == 3) { rnd = i / 3; z = i - 3 * rnd; }
        u.z = z;
        const long L = (long)rnd * G + c; if (L >= nwg) return false;
        int wgid = (int)L; { const int q = nwg / NXCD, r = nwg % NXCD, xcd = wgid % NXCD, off = wgid / NXCD; wgid = (xcd < r ? xcd * (q + 1) : r * (q + 1) + (xcd - r) * q) + off; }
        const int nig = WGM * nN, gid = wgid / nig, fm = gid * WGM, gsz = (nM - fm) < WGM ? (nM - fm) : WGM;
        u.pm = fm + ((wgid % nig) % gsz); u.pn = (wgid % nig) / gsz; return true;
    }
};

struct EpiStore {
    static constexpr bool PERM = true;
    bf16_t* O; int ldc;
    __device__ __forceinline__ void operator()(const f32x4 (&acc)[2][2][4][2], const Unit& u, int wr, int wc, int fr, int fq) const {
        const int row0 = u.pm * BM + wr * 64 + fr, col0 = u.pn * BM + wc * 32 + 8 * fq;
#pragma unroll
        for (int ai = 0; ai < 2; ++ai)
#pragma unroll
            for (int m = 0; m < 4; ++m) { bf16_t* rowp = O + (size_t)(row0 + ai * HALF + m * 16) * ldc + col0;
#pragma unroll
                for (int bj = 0; bj < 2; ++bj) { const f32x4 v0 = acc[ai][bj][m][0], v1 = acc[ai][bj][m][1];
                    u32x4 w; w.x = cvt_pk_bf16(v0[0], v0[1]); w.y = cvt_pk_bf16(v0[2], v0[3]); w.z = cvt_pk_bf16(v1[0], v1[1]); w.w = cvt_pk_bf16(v1[2], v1[3]);
                    *(u32x4*)(rowp + bj * HALF) = w; } }
    }
};
struct EpiSwiglu {
    static constexpr bool PERM = true;
    bf16_t* U; int ldu;
    __device__ __forceinline__ void operator()(const f32x4 (&acc)[2][2][4][2], const Unit& u, int wr, int wc, int fr, int fq) const {
        const int row0 = u.pm * BM + wr * 64 + fr, col0 = u.pn * 128 + wc * 16 + 4 * fq;
#pragma unroll
        for (int ai = 0; ai < 2; ++ai)
#pragma unroll
            for (int m = 0; m < 4; ++m) { bf16_t* rowp = U + (size_t)(row0 + ai * HALF + m * 16) * ldu + col0;
#pragma unroll
                for (int bj = 0; bj < 2; ++bj) { const f32x4 a = acc[ai][bj][m][0], b = acc[ai][bj][m][1];
                    float r[4];
#pragma unroll
                    for (int j = 0; j < 4; ++j) r[j] = a[j] * sigmoidf_(a[j]) * b[j];
                    u32x2 w; w.x = cvt_pk_bf16(r[0], r[1]); w.y = cvt_pk_bf16(r[2], r[3]);
                    *(u32x2*)(rowp + bj * 64) = w; } }
    }
};
struct EpiResid {
    static constexpr bool PERM = false;
    const float* src; float* dst; int ld; float scale;
    __device__ __forceinline__ void operator()(const f32x4 (&acc)[2][2][4][2], const Unit& u, int wr, int wc, int fr, int fq) const {
        const int row0 = u.pm * BM + wr * 64 + fr, col0 = u.pn * BM + wc * 32 + 4 * fq;
#pragma unroll
        for (int ai = 0; ai < 2; ++ai)
#pragma unroll
            for (int m = 0; m < 4; ++m) { const size_t ro = (size_t)(row0 + ai * HALF + m * 16) * ld + col0;
#pragma unroll
                for (int bj = 0; bj < 2; ++bj)
#pragma unroll
                    for (int n = 0; n < 2; ++n) { const f32x4 s = *(const f32x4*)(src + ro + bj * HALF + n * 16);
                        *(f32x4*)(dst + ro + bj * HALF + n * 16) = s + acc[ai][bj][m][n] * scale; } }
    }
};
struct EpiGate {
    static constexpr bool PERM = true;
    bf16_t* Mg; const bf16_t* gl; int ldg;
    __device__ __forceinline__ void operator()(const f32x4 (&acc)[2][2][4][2], const Unit& u, int wr, int wc, int fr, int fq) const {
        const int row0 = u.pm * BM + wr * 64 + fr, col0 = u.pn * BM + wc * 32 + 8 * fq;
#pragma unroll
        for (int ai = 0; ai < 2; ++ai)
#pragma unroll
            for (int m = 0; m < 4; ++m) { const int row = row0 + ai * HALF + m * 16;
                bf16_t* mp = Mg + (size_t)row * 1024 + col0; const bf16_t* gp = gl + (size_t)row * ldg + u.z * 1024 + col0;
#pragma unroll
                for (int bj = 0; bj < 2; ++bj) { const f32x4 v0 = acc[ai][bj][m][0], v1 = acc[ai][bj][m][1];
                    const u32x4 g = *(const u32x4*)(gp + bj * HALF);
                    u32x4 o = (u32x4){0u, 0u, 0u, 0u};
                    if (u.z > 0) o = *(const u32x4*)(mp + bj * HALF);
                    float r[8];
                    r[0] = bflo(o.x) + sigmoidf_(bflo(g.x)) * v0[0]; r[1] = bfhi(o.x) + sigmoidf_(bfhi(g.x)) * v0[1];
                    r[2] = bflo(o.y) + sigmoidf_(bflo(g.y)) * v0[2]; r[3] = bfhi(o.y) + sigmoidf_(bfhi(g.y)) * v0[3];
                    r[4] = bflo(o.z) + sigmoidf_(bflo(g.z)) * v1[0]; r[5] = bfhi(o.z) + sigmoidf_(bfhi(g.z)) * v1[1];
                    r[6] = bflo(o.w) + sigmoidf_(bflo(g.w)) * v1[2]; r[7] = bfhi(o.w) + sigmoidf_(bfhi(g.w)) * v1[3];
                    u32x4 w; w.x = cvt_pk_bf16(r[0], r[1]); w.y = cvt_pk_bf16(r[2], r[3]); w.z = cvt_pk_bf16(r[4], r[5]); w.w = cvt_pk_bf16(r[6], r[7]);
                    *(u32x4*)(mp + bj * HALF) = w; } }
    }
};
struct EpiMkv {
    static constexpr bool PERM = true;
    bf16_t* mk; bf16_t* mvT;
    __device__ __forceinline__ void operator()(const f32x4 (&acc)[2][2][4][2], const Unit& u, int wr, int wc, int fr, int fq) const {
        const int row0 = u.pm * BM + wr * 64 + fr, col0 = u.pn * BM + wc * 32 + 8 * fq;
#pragma unroll
        for (int ai = 0; ai < 2; ++ai)
#pragma unroll
            for (int m = 0; m < 4; ++m) { const int row = row0 + ai * HALF + m * 16;
#pragma unroll
                for (int bj = 0; bj < 2; ++bj) { const f32x4 v0 = acc[ai][bj][m][0], v1 = acc[ai][bj][m][1]; const int col = col0 + bj * HALF;
                    if (u.pn < 4) {
                        u32x4 w; w.x = cvt_pk_bf16(v0[0], v0[1]); w.y = cvt_pk_bf16(v0[2], v0[3]); w.z = cvt_pk_bf16(v1[0], v1[1]); w.w = cvt_pk_bf16(v1[2], v1[3]);
                        *(u32x4*)(mk + (size_t)row * 1024 + col) = w;
                    } else {
                        const int b = row >> 8, mem = row & 255; bf16_t* base = mvT + ((size_t)b * 1024 + (col - 1024)) * 256 + mem;
#pragma unroll
                        for (int j = 0; j < 4; ++j) { base[(size_t)j * 256] = f2bf(v0[j]); base[(size_t)(4 + j) * 256] = f2bf(v1[j]); }
                    } } }
    }
};

template <class Epi>
__device__ __forceinline__ void gemm_phase(LAS unsigned char* lds, const Gemm g, const Order& S, const Epi& E, const int tid) {
    const int wid = __builtin_amdgcn_readfirstlane(tid >> 6), lane = tid & 63, wr = wid >> 2, wc = wid & 3, fr = lane & 15, fq = lane >> 4;
    const int K = g.K, nt = K / BK, lda = g.lda;
    unsigned voffA[2], voffB[2];
#pragma unroll
    for (int i = 0; i < 2; ++i) { int R, C; stage_rc(tid * 16 + i * 8192, R, C); const int Rb = Epi::PERM ? ((R & ~31) + perm32(R & 31)) : R;
        voffA[i] = (unsigned)(R * lda + C) * 2u; voffB[i] = (unsigned)(Rb * K + C) * 2u; }
    const size_t kstep = (size_t)(BK * 2);
    const size_t hstepA = (size_t)HALF * lda * 2, hstepB = (size_t)HALF * K * 2;
    const size_t tstepA = 2 * hstepA, tstepB = 2 * hstepB;
    const unsigned ldsw = (unsigned)wid * 1024u;
    const int aoff = lds_byte(wr * 64 + fr, fq * 8), boff = lds_byte(wc * 32 + fr, fq * 8);
#define PG8_SA(b, h) (((b) * 2 + (h)) * HTB)
#define PG8_SB(b, h) ((4 + (b) * 2 + (h)) * HTB)
#define PG8_STAGE(bufoff, gbase, voff) do { _Pragma("unroll") for (int _i = 0; _i < 2; ++_i) \
        __builtin_amdgcn_global_load_lds((const unsigned*)((const char*)(gbase) + (voff)[_i]), (LAS unsigned*)(lds + (bufoff) + ldsw + _i * 8192), 16, 0, 0); } while (0)
#define PG8_LDA(dst, b, h) do { _Pragma("unroll") for (int m = 0; m < 4; ++m) _Pragma("unroll") for (int k = 0; k < 2; ++k) dst[m][k] = *(const LAS bf16x8*)(lds + PG8_SA(b, h) + aoff + m * 2048 + k * 1024); } while (0)
#define PG8_LDB(dst, b, h) do { _Pragma("unroll") for (int n = 0; n < 2; ++n) _Pragma("unroll") for (int k = 0; k < 2; ++k) dst[n][k] = *(const LAS bf16x8*)(lds + PG8_SB(b, h) + boff + n * 2048 + k * 1024); } while (0)
#define PG8_MMA(ai, bj, At, Bt) do { __builtin_amdgcn_s_setprio(1); _Pragma("unroll") for (int m = 0; m < 4; ++m) _Pragma("unroll") for (int n = 0; n < 2; ++n) _Pragma("unroll") for (int k = 0; k < 2; ++k) \
        acc[ai][bj][m][n] = __builtin_amdgcn_mfma_f32_16x16x32_bf16(Bt[n][k], At[m][k], acc[ai][bj][m][n], 0, 0, 0); __builtin_amdgcn_s_setprio(0); } while (0)
#define PG8_WAIT_V(n) asm volatile("s_waitcnt vmcnt(" #n ")" ::: "memory")
#define PG8_WAIT_L(n) asm volatile("s_waitcnt lgkmcnt(" #n ")" ::: "memory")
#define PG8_BAR __builtin_amdgcn_s_barrier()
#define PG8_SCHED __builtin_amdgcn_sched_barrier(0)
#define PG8_ABASE(u) ((const char*)g.A + (size_t)((u).z == 0 ? g.zoff0 : (u).z == 1 ? g.zoff1 : g.zoff2) * 2 + (size_t)(u).pm * tstepA)
#define PG8_BBASE(u) ((const char*)g.Bt + (size_t)((u).z * g.zB) * 2 + (size_t)(u).pn * tstepB)
    Unit cur, nxt; int ui = 0;
    if (!S.next(0, cur)) return;
    f32x4 acc[2][2][4][2];
#pragma unroll
    for (int a = 0; a < 2; ++a)
#pragma unroll
        for (int b = 0; b < 2; ++b)
#pragma unroll
            for (int m = 0; m < 4; ++m)
#pragma unroll
                for (int n = 0; n < 2; ++n) acc[a][b][m][n] = (f32x4){0.f, 0.f, 0.f, 0.f};
    bf16x8 At[4][2], B0[2][2], B1[2][2];
    const char* cA = PG8_ABASE(cur); const char* cB = PG8_BBASE(cur);
    PG8_STAGE(PG8_SB(0, 0), cB, voffB); PG8_STAGE(PG8_SA(0, 0), cA, voffA); PG8_STAGE(PG8_SB(0, 1), cB + hstepB, voffB); PG8_STAGE(PG8_SA(0, 1), cA + hstepA, voffA);
    if (wr == 1) PG8_BAR;
    PG8_WAIT_V(4); PG8_BAR;
    PG8_STAGE(PG8_SB(1, 0), cB + kstep, voffB); PG8_STAGE(PG8_SA(1, 0), cA + kstep, voffA); PG8_STAGE(PG8_SB(1, 1), cB + hstepB + kstep, voffB);
    PG8_WAIT_V(6); PG8_BAR;
    for (;;) {
        const bool has_next = S.next(ui + 1, nxt);
        const char* nA = has_next ? PG8_ABASE(nxt) : cA; const char* nB = has_next ? PG8_BBASE(nxt) : cB;
        for (int t = 0; t < nt; t += 2) {
            const bool last = (t == nt - 2);
            const char* a1 = cA + (size_t)(t + 1) * kstep;
            const char* a2 = last ? nA : cA + (size_t)(t + 2) * kstep; const char* b2 = last ? nB : cB + (size_t)(t + 2) * kstep;
            const char* a3 = a2 + kstep; const char* b3 = b2 + kstep;
            PG8_LDB(B0, 0, 0); PG8_SCHED; PG8_LDA(At, 0, 0); PG8_STAGE(PG8_SA(1, 1), a1 + hstepA, voffA);
            PG8_WAIT_L(8); PG8_BAR; PG8_WAIT_L(0); PG8_MMA(0, 0, At, B0); PG8_BAR; PG8_SCHED;
            PG8_LDB(B1, 0, 1); PG8_STAGE(PG8_SB(0, 0), b2, voffB);
            PG8_BAR; PG8_WAIT_L(0); PG8_MMA(0, 1, At, B1); PG8_BAR;
            PG8_LDA(At, 0, 1); PG8_STAGE(PG8_SA(0, 0), a2, voffA);
            PG8_BAR; PG8_WAIT_L(0); PG8_MMA(1, 0, At, B0); PG8_BAR; PG8_SCHED;
            PG8_STAGE(PG8_SB(0, 1), b2 + hstepB, voffB);
            PG8_WAIT_V(6); PG8_BAR; PG8_MMA(1, 1, At, B1); PG8_BAR;
            PG8_LDB(B0, 1, 0); PG8_SCHED; PG8_LDA(At, 1, 0); PG8_STAGE(PG8_SA(0, 1), a2 + hstepA, voffA);
            PG8_WAIT_L(8); PG8_BAR; PG8_WAIT_L(0); PG8_MMA(0, 0, At, B0); PG8_BAR; PG8_SCHED;
            PG8_LDB(B1, 1, 1); PG8_STAGE(PG8_SB(1, 0), b3, voffB);
            PG8_BAR; PG8_WAIT_L(0); PG8_MMA(0, 1, At, B1); PG8_BAR;
            PG8_LDA(At, 1, 1); PG8_STAGE(PG8_SA(1, 0), a3, voffA);
            PG8_BAR; PG8_WAIT_L(0); PG8_MMA(1, 0, At, B0); PG8_BAR; PG8_SCHED;
            PG8_STAGE(PG8_SB(1, 1), b3 + hstepB, voffB);
            PG8_WAIT_V(6); PG8_BAR; PG8_MMA(1, 1, At, B1); PG8_BAR;
        }
        E(acc, cur, wr, wc, fr, fq);
        if (!has_next) break;
#pragma unroll
        for (int a = 0; a < 2; ++a)
#pragma unroll
            for (int b = 0; b < 2; ++b)
#pragma unroll
                for (int m = 0; m < 4; ++m)
#pragma unroll
                    for (int n = 0; n < 2; ++n) acc[a][b][m][n] = (f32x4){0.f, 0.f, 0.f, 0.f};
        cur = nxt; cA = nA; cB = nB; ++ui;
    }
    PG8_WAIT_V(0);
    if (wr == 0) PG8_BAR;
    PG8_BAR;
#undef PG8_SA
#undef PG8_SB
#undef PG8_STAGE
#undef PG8_LDA
#undef PG8_LDB
#undef PG8_MMA
#undef PG8_WAIT_V
#undef PG8_WAIT_L
#undef PG8_BAR
#undef PG8_SCHED
#undef PG8_ABASE
#undef PG8_BBASE
}
}

__device__ __forceinline__ void rms_row_bf16(const float* xrow, const float* g, bf16_t* orow, int lane) {
    const f32x4* xr = (const f32x4*)xrow + lane; const f32x4* gr = (const f32x4*)g + lane;
    f32x4 v[4]; float s = 0.f;
#pragma unroll
    for (int j = 0; j < 4; ++j) { v[j] = xr[64 * j]; s += (v[j].x * v[j].x + v[j].y * v[j].y) + (v[j].z * v[j].z + v[j].w * v[j].w); }
    const float rstd = rsqrtf(wave_sum(s) * (1.f / 1024.f) + 1e-6f);
    u32x2* o8 = (u32x2*)orow + lane;
#pragma unroll
    for (int j = 0; j < 4; ++j) { const f32x4 gg = gr[64 * j]; u32x2 w; w.x = cvt_pk_bf16(v[j].x * rstd * gg.x, v[j].y * rstd * gg.y); w.y = cvt_pk_bf16(v[j].z * rstd * gg.z, v[j].w * rstd * gg.w); o8[64 * j] = w; }
}
__device__ __forceinline__ void rms_row_f32(const float* xrow, const float* g, float* orow, int lane) {
    const f32x4* xr = (const f32x4*)xrow + lane; const f32x4* gr = (const f32x4*)g + lane;
    f32x4 v[4]; float s = 0.f;
#pragma unroll
    for (int j = 0; j < 4; ++j) { v[j] = xr[64 * j]; s += (v[j].x * v[j].x + v[j].y * v[j].y) + (v[j].z * v[j].z + v[j].w * v[j].w); }
    const float rstd = rsqrtf(wave_sum(s) * (1.f / 1024.f) + 1e-6f);
    f32x4* o = (f32x4*)orow + lane;
#pragma unroll
    for (int j = 0; j < 4; ++j) { const f32x4 gg = gr[64 * j]; o[64 * j] = v[j] * rstd * gg; }
}

__device__ __forceinline__ void wt_item(const float* W, int K, int N, bf16_t* WT, int mode, int item, LAS bf16_t* scr, int tid) {
    const int nblk = N >> 6, kb = item / nblk, nb = item - kb * nblk, k0 = kb * 64, n0 = nb * 64;
#pragma unroll
    for (int i = 0; i < 8; ++i) { const int k = (tid >> 6) + 8 * i, n = tid & 63; scr[n * 66 + k] = f2bf(W[(size_t)(k0 + k) * N + n0 + n]); }
    __syncthreads();
#pragma unroll
    for (int i = 0; i < 8; ++i) { const int n = (tid >> 6) + 8 * i, k = tid & 63, sn = n0 + n;
        const int dr = mode == 0 ? sn : (8 * (sn >> 2) + (sn & 3) + (mode == 2 ? 4 : 0));
        WT[(size_t)dr * K + k0 + k] = scr[n * 66 + k]; }
    __syncthreads();
}

__device__ __forceinline__ void rot16(const bf16_t* row, const f32x2* tabrow, int jg, float sc, unsigned (&y1)[8], unsigned (&y2)[8]) {
    const u32x4 a0 = *(const u32x4*)(row + jg * 16), a1 = *(const u32x4*)(row + jg * 16 + 8);
    const u32x4 b0 = *(const u32x4*)(row + 64 + jg * 16), b1 = *(const u32x4*)(row + 64 + jg * 16 + 8);
    const unsigned aw[8] = {a0.x, a0.y, a0.z, a0.w, a1.x, a1.y, a1.z, a1.w};
    const unsigned bw[8] = {b0.x, b0.y, b0.z, b0.w, b1.x, b1.y, b1.z, b1.w};
    const f32x4* tp = (const f32x4*)(tabrow + jg * 16);
#pragma unroll
    for (int i = 0; i < 8; ++i) {
        const f32x4 cs = tp[i];
        const float x1a = bflo(aw[i]), x1b = bfhi(aw[i]), x2a = bflo(bw[i]), x2b = bfhi(bw[i]);
        y1[i] = cvt_pk_bf16((x1a * cs.x - x2a * cs.y) * sc, (x1b * cs.z - x2b * cs.w) * sc);
        y2[i] = cvt_pk_bf16((x1a * cs.y + x2a * cs.x) * sc, (x1b * cs.w + x2b * cs.z) * sc);
    }
}

constexpr int RP = 136;

__device__ __forceinline__ void ret_state_item(const bf16_t* proj, const f32x2* tab, float* states, int item, LAS unsigned char* lds, int tid) {
    const int wave = tid >> 6, lane = tid & 63, fr = lane & 15, fq = lane >> 4;
    const int h = item & 3, n = (item >> 2) & 31, bl = item >> 7;
    const size_t tok0 = (size_t)bl * SEQ + n * 128;
    LAS bf16_t* KT = (LAS bf16_t*)lds;
    LAS bf16_t* VT = (LAS bf16_t*)(lds + 128 * RP * 2);
    const float lg = log2g(h);
    {
        const int c = tid >> 2, jg = tid & 3;
        const bf16_t* row = proj + (tok0 + c) * INW + C_RK + h * 128;
        unsigned y1[8], y2[8];
        rot16(row, tab + (size_t)(n * 128 + c) * 64, jg, 0.08838834764831845f * exp2f(-(float)(c + 1) * lg), y1, y2);
#pragma unroll
        for (int i = 0; i < 8; ++i) {
            const int j = jg * 16 + 2 * i;
            KT[(j) * RP + c] = (bf16_t)(y1[i] & 0xffffu); KT[(j + 1) * RP + c] = (bf16_t)(y1[i] >> 16);
            KT[(j + 64) * RP + c] = (bf16_t)(y2[i] & 0xffffu); KT[(j + 65) * RP + c] = (bf16_t)(y2[i] >> 16);
        }
        const bf16_t* vrow = proj + (tok0 + c) * INW + C_RV + h * 256 + jg * 64;
#pragma unroll
        for (int i = 0; i < 8; ++i) {
            const u32x4 v = *(const u32x4*)(vrow + i * 8);
            const unsigned vw[4] = {v.x, v.y, v.z, v.w};
#pragma unroll
            for (int k = 0; k < 4; ++k) { const int e = jg * 64 + i * 8 + 2 * k; VT[e * RP + c] = (bf16_t)(vw[k] & 0xffffu); VT[(e + 1) * RP + c] = (bf16_t)(vw[k] >> 16); }
        }
    }
    __syncthreads();
    f32x4 acc[8][2];
#pragma unroll
    for (int dt = 0; dt < 8; ++dt) { acc[dt][0] = (f32x4){0.f, 0.f, 0.f, 0.f}; acc[dt][1] = (f32x4){0.f, 0.f, 0.f, 0.f}; }
#pragma unroll
    for (int ks = 0; ks < 4; ++ks) {
        bf16x8 bfr[2];
#pragma unroll
        for (int et = 0; et < 2; ++et) bfr[et] = *(const LAS bf16x8*)(VT + (32 * wave + 16 * et + fr) * RP + 32 * ks + 8 * fq);
#pragma unroll
        for (int dt = 0; dt < 8; ++dt) {
            const bf16x8 a = *(const LAS bf16x8*)(KT + (16 * dt + fr) * RP + 32 * ks + 8 * fq);
            acc[dt][0] = mfma16(a, bfr[0], acc[dt][0]); acc[dt][1] = mfma16(a, bfr[1], acc[dt][1]);
        }
    }
    const float gch = exp2f(128.f * lg);
    float* sp = states + (size_t)item * 32768;
#pragma unroll
    for (int et = 0; et < 2; ++et)
#pragma unroll
        for (int dt = 0; dt < 8; ++dt) *(f32x4*)(sp + (size_t)(32 * wave + 16 * et + fr) * 128 + 16 * dt + 4 * fq) = acc[dt][et] * gch;
    __syncthreads();
}

__device__ __forceinline__ void ret_scan(float* states, int gtid, int nthreads) {
    for (int i = gtid; i < 16 * 8192; i += nthreads) {
        const int bh = i >> 13, off = i & 8191, bl = bh >> 2, h = bh & 3;
        const float g = exp2f(128.f * log2g(h));
        f32x4* p = (f32x4*)(states + ((size_t)(bl * 32) * 4 + h) * 32768) + off;
        f32x4 R = (f32x4){0.f, 0.f, 0.f, 0.f};
        for (int n0 = 0; n0 < 32; n0 += 8) {
            f32x4 s[8];
#pragma unroll
            for (int k = 0; k < 8; ++k) s[k] = p[(size_t)(n0 + k) * 32768];
#pragma unroll
            for (int k = 0; k < 8; ++k) { p[(size_t)(n0 + k) * 32768] = R; R = R * g + s[k]; }
        }
    }
}

__device__ __forceinline__ void ret_out_item(bf16_t* proj, const f32x2* tab, const float* states, const float* gn, int item, LAS unsigned char* lds, int tid) {
    const int wave = tid >> 6, lane = tid & 63, fr = lane & 15, fq = lane >> 4;
    const int h = item & 3, n = (item >> 2) & 31, bl = item >> 7;
    const size_t tok0 = (size_t)bl * SEQ + n * 128;
    LAS bf16_t* QS = (LAS bf16_t*)lds;
    LAS bf16_t* KS = (LAS bf16_t*)(lds + 128 * RP * 2);
    LAS bf16_t* VT = (LAS bf16_t*)(lds + 2 * 128 * RP * 2);
    LAS float* red = (LAS float*)(lds + 4 * 128 * RP * 2);
    const float lg = log2g(h);
    {
        const int c = tid >> 2, jg = tid & 3;
        const f32x2* tr = tab + (size_t)(n * 128 + c) * 64;
        unsigned y1[8], y2[8];
        rot16(proj + (tok0 + c) * INW + C_RQ + h * 128, tr, jg, exp2f((float)(c + 1) * lg), y1, y2);
        *(LAS u32x4*)(QS + c * RP + jg * 16) = (u32x4){y1[0], y1[1], y1[2], y1[3]}; *(LAS u32x4*)(QS + c * RP + jg * 16 + 8) = (u32x4){y1[4], y1[5], y1[6], y1[7]};
        *(LAS u32x4*)(QS + c * RP + 64 + jg * 16) = (u32x4){y2[0], y2[1], y2[2], y2[3]}; *(LAS u32x4*)(QS + c * RP + 64 + jg * 16 + 8) = (u32x4){y2[4], y2[5], y2[6], y2[7]};
        rot16(proj + (tok0 + c) * INW + C_RK + h * 128, tr, jg, 0.08838834764831845f * exp2f(-(float)(c + 1) * lg), y1, y2);
        *(LAS u32x4*)(KS + c * RP + jg * 16) = (u32x4){y1[0], y1[1], y1[2], y1[3]}; *(LAS u32x4*)(KS + c * RP + jg * 16 + 8) = (u32x4){y1[4], y1[5], y1[6], y1[7]};
        *(LAS u32x4*)(KS + c * RP + 64 + jg * 16) = (u32x4){y2[0], y2[1], y2[2], y2[3]}; *(LAS u32x4*)(KS + c * RP + 64 + jg * 16 + 8) = (u32x4){y2[4], y2[5], y2[6], y2[7]};
        const bf16_t* vrow = proj + (tok0 + c) * INW + C_RV + h * 256 + jg * 64;
#pragma unroll
        for (int i = 0; i < 8; ++i) {
            const u32x4 v = *(const u32x4*)(vrow + i * 8);
            const unsigned vw[4] = {v.x, v.y, v.z, v.w};
#pragma unroll
            for (int k = 0; k < 4; ++k) { const int e = jg * 64 + i * 8 + 2 * k; VT[e * RP + c] = (bf16_t)(vw[k] & 0xffffu); VT[(e + 1) * RP + c] = (bf16_t)(vw[k] >> 16); }
        }
    }
    __syncthreads();
    unsigned pk[8][2];
    {
        f32x4 pacc[8];
#pragma unroll
        for (int st = 0; st < 8; ++st) pacc[st] = (f32x4){0.f, 0.f, 0.f, 0.f};
#pragma unroll
        for (int ks = 0; ks < 4; ++ks) {
            const bf16x8 b = *(const LAS bf16x8*)(QS + (16 * wave + fr) * RP + 32 * ks + 8 * fq);
#pragma unroll
            for (int st = 0; st < 8; ++st) { const bf16x8 a = *(const LAS bf16x8*)(KS + (16 * st + fr) * RP + 32 * ks + 8 * fq); pacc[st] = mfma16(a, b, pacc[st]); }
        }
        const int c = 16 * wave + fr;
#pragma unroll
        for (int st = 0; st < 8; ++st) { float v[4];
#pragma unroll
            for (int j = 0; j < 4; ++j) { const int s = 16 * st + 4 * fq + j; v[j] = (s <= c) ? pacc[st][j] : 0.f; }
            pk[st][0] = cvt_pk_bf16(v[0], v[1]); pk[st][1] = cvt_pk_bf16(v[2], v[3]); }
    }
    __syncthreads();
    {
        const int c = 16 * wave + fr;
#pragma unroll
        for (int st = 0; st < 8; ++st) *(LAS u32x2*)(KS + c * RP + 16 * st + 4 * fq) = (u32x2){pk[st][0], pk[st][1]};
    }
    __syncthreads();
    f32x4 acc[2][8];
#pragma unroll
    for (int et = 0; et < 2; ++et)
#pragma unroll
        for (int ct = 0; ct < 8; ++ct) acc[et][ct] = (f32x4){0.f, 0.f, 0.f, 0.f};
    const float* sp = states + (size_t)item * 32768;
#pragma unroll
    for (int ks = 0; ks < 4; ++ks) {
        bf16x8 av[2], ar[2];
#pragma unroll
        for (int et = 0; et < 2; ++et) {
            const int e = 32 * wave + 16 * et + fr;
            av[et] = *(const LAS bf16x8*)(VT + e * RP + 32 * ks + 8 * fq);
            const f32x4 r0 = *(const f32x4*)(sp + (size_t)e * 128 + 32 * ks + 8 * fq), r1 = *(const f32x4*)(sp + (size_t)e * 128 + 32 * ks + 8 * fq + 4);
            u32x4 w; w.x = cvt_pk_bf16(r0.x, r0.y); w.y = cvt_pk_bf16(r0.z, r0.w); w.z = cvt_pk_bf16(r1.x, r1.y); w.w = cvt_pk_bf16(r1.z, r1.w);
            ar[et] = __builtin_bit_cast(bf16x8, w);
        }
#pragma unroll
        for (int ct = 0; ct < 8; ++ct) {
            const bf16x8 bp = *(const LAS bf16x8*)(KS + (16 * ct + fr) * RP + 32 * ks + 8 * fq);
            const bf16x8 bq = *(const LAS bf16x8*)(QS + (16 * ct + fr) * RP + 32 * ks + 8 * fq);
#pragma unroll
            for (int et = 0; et < 2; ++et) { acc[et][ct] = mfma16(av[et], bp, acc[et][ct]); acc[et][ct] = mfma16(ar[et], bq, acc[et][ct]); }
        }
    }
#pragma unroll
    for (int ct = 0; ct < 8; ++ct) {
        float s = 0.f;
#pragma unroll
        for (int et = 0; et < 2; ++et) s += (acc[et][ct][0] * acc[et][ct][0] + acc[et][ct][1] * acc[et][ct][1]) + (acc[et][ct][2] * acc[et][ct][2] + acc[et][ct][3] * acc[et][ct][3]);
        s += __shfl_xor(s, 16); s += __shfl_xor(s, 32);
        if (fq == 0) red[wave * 128 + 16 * ct + fr] = s;
    }
    __syncthreads();
#pragma unroll
    for (int ct = 0; ct < 8; ++ct) {
        const int c = 16 * ct + fr;
        float s = 0.f;
#pragma unroll
        for (int w = 0; w < 8; ++w) s += red[w * 128 + c];
        const float rstd = rsqrtf(s * (1.f / 256.f) + 1e-6f);
        bf16_t* grow = proj + (tok0 + c) * INW + C_RG + h * 256;
#pragma unroll
        for (int et = 0; et < 2; ++et) {
            const int e = 32 * wave + 16 * et + 4 * fq;
            const u32x2 gw = *(const u32x2*)(grow + e);
            const f32x4 gg = *(const f32x4*)(gn + h * 256 + e);
            const float g0 = bflo(gw.x), g1 = bfhi(gw.x), g2 = bflo(gw.y), g3 = bfhi(gw.y);
            const float o0 = acc[et][ct][0] * rstd * gg.x * g0 * sigmoidf_(g0), o1 = acc[et][ct][1] * rstd * gg.y * g1 * sigmoidf_(g1);
            const float o2 = acc[et][ct][2] * rstd * gg.z * g2 * sigmoidf_(g2), o3 = acc[et][ct][3] * rstd * gg.w * g3 * sigmoidf_(g3);
            *(u32x2*)(grow + e) = (u32x2){cvt_pk_bf16(o0, o1), cvt_pk_bf16(o2, o3)};
        }
    }
    __syncthreads();
}

constexpr int SKP = 72, SVP = 264;
__device__ __forceinline__ void swa_item(bf16_t* proj, const float* sinks, int item, LAS unsigned char* lds, int tid) {
    const int wave = tid >> 6, lane = tid & 63, fr = lane & 15, fq = lane >> 4;
    const int kh = item & 1, n = (item >> 1) & 31, bl = item >> 6;
    const size_t tok0 = (size_t)bl * SEQ + n * 128;
    LAS bf16_t* Ks = (LAS bf16_t*)lds;
    LAS bf16_t* Vt = (LAS bf16_t*)(lds + 256 * SKP * 2);
#pragma unroll
    for (int i = 0; i < 4; ++i) {
        const int ch = tid + 512 * i, key = ch >> 3, part = ch & 7;
        u32x4 kv = (u32x4){0u, 0u, 0u, 0u}, vv = (u32x4){0u, 0u, 0u, 0u};
        if (n > 0 || key >= 128) { const bf16_t* r = proj + (tok0 + key - 128) * INW; kv = *(const u32x4*)(r + C_SK + kh * 64 + part * 8); vv = *(const u32x4*)(r + C_SV + kh * 64 + part * 8); }
        *(LAS u32x4*)(Ks + key * SKP + part * 8) = kv;
        const unsigned vw[4] = {vv.x, vv.y, vv.z, vv.w};
#pragma unroll
        for (int k = 0; k < 4; ++k) { const int d = part * 8 + 2 * k; Vt[d * SVP + key] = (bf16_t)(vw[k] & 0xffffu); Vt[(d + 1) * SVP + key] = (bf16_t)(vw[k] >> 16); }
    }
    __syncthreads();
    const int h = kh * 8 + wave; const float sink = sinks[h];
    for (int qt = 0; qt < 8; ++qt) {
        bf16_t* qrow = proj + (tok0 + 16 * qt + fr) * INW + C_SQ + h * 64;
        bf16x8 qf[2];
        qf[0] = *(const bf16x8*)(qrow + 8 * fq); qf[1] = *(const bf16x8*)(qrow + 32 + 8 * fq);
        f32x4 s[16];
#pragma unroll
        for (int t = 0; t < 16; ++t) { s[t] = (f32x4){0.f, 0.f, 0.f, 0.f};
#pragma unroll
            for (int ks = 0; ks < 2; ++ks) { const bf16x8 a = *(const LAS bf16x8*)(Ks + (16 * t + fr) * SKP + 32 * ks + 8 * fq); s[t] = mfma16(a, qf[ks], s[t]); } }
        const int c = 16 * qt + fr; float mx = sink;
#pragma unroll
        for (int t = 0; t < 16; ++t)
#pragma unroll
            for (int j = 0; j < 4; ++j) { const int kpos = 16 * t + 4 * fq + j; const bool valid = (kpos > c) && (kpos <= c + 128) && (n > 0 || kpos >= 128);
                const float v = valid ? s[t][j] * 0.125f : -1e30f; s[t][j] = v; mx = fmaxf(mx, v); }
        mx = fmaxf(mx, __shfl_xor(mx, 16)); mx = fmaxf(mx, __shfl_xor(mx, 32));
        float sum = 0.f;
#pragma unroll
        for (int t = 0; t < 16; ++t)
#pragma unroll
            for (int j = 0; j < 4; ++j) { const float pv = __expf(s[t][j] - mx); s[t][j] = pv; sum += pv; }
        sum += __shfl_xor(sum, 16); sum += __shfl_xor(sum, 32);
        sum += __expf(sink - mx);
        const float inv = 1.0f / sum;
        f32x4 o[4];
#pragma unroll
        for (int dt = 0; dt < 4; ++dt) o[dt] = (f32x4){0.f, 0.f, 0.f, 0.f};
#pragma unroll
        for (int k2 = 0; k2 < 8; ++k2) {
            u32x4 pw; pw.x = cvt_pk_bf16(s[2 * k2][0], s[2 * k2][1]); pw.y = cvt_pk_bf16(s[2 * k2][2], s[2 * k2][3]); pw.z = cvt_pk_bf16(s[2 * k2 + 1][0], s[2 * k2 + 1][1]); pw.w = cvt_pk_bf16(s[2 * k2 + 1][2], s[2 * k2 + 1][3]);
            const bf16x8 pf = __builtin_bit_cast(bf16x8, pw);
#pragma unroll
            for (int dt = 0; dt < 4; ++dt) {
                const u32x2 v0 = *(const LAS u32x2*)(Vt + (16 * dt + fr) * SVP + 32 * k2 + 4 * fq), v1 = *(const LAS u32x2*)(Vt + (16 * dt + fr) * SVP + 32 * k2 + 16 + 4 * fq);
                const bf16x8 a = __builtin_bit_cast(bf16x8, ((u32x4){v0.x, v0.y, v1.x, v1.y}));
                o[dt] = mfma16(a, pf, o[dt]);
            }
        }
#pragma unroll
        for (int dt = 0; dt < 4; ++dt) *(u32x2*)(qrow + 16 * dt + 4 * fq) = (u32x2){cvt_pk_bf16(o[dt][0] * inv, o[dt][1] * inv), cvt_pk_bf16(o[dt][2] * inv, o[dt][3] * inv)};
    }
    __syncthreads();
}

constexpr int MP = 264;
__device__ __forceinline__ void mem_item(bf16_t* proj, const bf16_t* mk, const bf16_t* mvT, int bglob0, int item, LAS unsigned char* lds, int tid) {
    const int wave = tid >> 6, lane = tid & 63, fr = lane & 15, fq = lane >> 4;
    const int qt = item & 31, h = (item >> 5) & 3, bl = item >> 7, b = bglob0 + bl;
    const size_t tok0 = (size_t)bl * SEQ + qt * 128;
    LAS bf16_t* Ms = (LAS bf16_t*)lds;
    {
        const bf16_t* src = mk + (size_t)b * 256 * 1024 + h * 256;
#pragma unroll 4
        for (int i = 0; i < 16; ++i) { const int ch = tid + 512 * i, row = ch >> 5, part = ch & 31; *(LAS u32x4*)(Ms + row * MP + part * 8) = *(const u32x4*)(src + (size_t)row * 1024 + part * 8); }
    }
    bf16_t* qrow = proj + (tok0 + 16 * wave + fr) * INW + C_MQ + h * 256;
    bf16x8 qf[8];
#pragma unroll
    for (int ks = 0; ks < 8; ++ks) qf[ks] = *(const bf16x8*)(qrow + 32 * ks + 8 * fq);
    __syncthreads();
    f32x4 s[16];
#pragma unroll
    for (int t = 0; t < 16; ++t) { s[t] = (f32x4){0.f, 0.f, 0.f, 0.f};
#pragma unroll
        for (int ks = 0; ks < 8; ++ks) { const bf16x8 a = *(const LAS bf16x8*)(Ms + (16 * t + fr) * MP + 32 * ks + 8 * fq); s[t] = mfma16(a, qf[ks], s[t]); } }
    float mx = -1e30f;
#pragma unroll
    for (int t = 0; t < 16; ++t)
#pragma unroll
        for (int j = 0; j < 4; ++j) { const float v = s[t][j] * 0.0625f; s[t][j] = v; mx = fmaxf(mx, v); }
    mx = fmaxf(mx, __shfl_xor(mx, 16)); mx = fmaxf(mx, __shfl_xor(mx, 32));
    float sum = 0.f;
#pragma unroll
    for (int t = 0; t < 16; ++t)
#pragma unroll
        for (int j = 0; j < 4; ++j) { const float pv = __expf(s[t][j] - mx); s[t][j] = pv; sum += pv; }
    sum += __shfl_xor(sum, 16); sum += __shfl_xor(sum, 32);
    const float inv = 1.0f / sum;
    bf16x8 pf[8];
#pragma unroll
    for (int k2 = 0; k2 < 8; ++k2) { u32x4 pw; pw.x = cvt_pk_bf16(s[2 * k2][0], s[2 * k2][1]); pw.y = cvt_pk_bf16(s[2 * k2][2], s[2 * k2][3]); pw.z = cvt_pk_bf16(s[2 * k2 + 1][0], s[2 * k2 + 1][1]); pw.w = cvt_pk_bf16(s[2 * k2 + 1][2], s[2 * k2 + 1][3]);
        pf[k2] = __builtin_bit_cast(bf16x8, pw); }
    __syncthreads();
    {
        const bf16_t* src = mvT + ((size_t)b * 1024 + h * 256) * 256;
#pragma unroll 4
        for (int i = 0; i < 16; ++i) { const int ch = tid + 512 * i, row = ch >> 5, part = ch & 31; *(LAS u32x4*)(Ms + row * MP + part * 8) = *(const u32x4*)(src + (size_t)row * 256 + part * 8); }
    }
    __syncthreads();
#pragma unroll
    for (int dt = 0; dt < 16; ++dt) {
        f32x4 o = (f32x4){0.f, 0.f, 0.f, 0.f};
#pragma unroll
        for (int k2 = 0; k2 < 8; ++k2) {
            const u32x2 v0 = *(const LAS u32x2*)(Ms + (16 * dt + fr) * MP + 32 * k2 + 4 * fq), v1 = *(const LAS u32x2*)(Ms + (16 * dt + fr) * MP + 32 * k2 + 16 + 4 * fq);
            const bf16x8 a = __builtin_bit_cast(bf16x8, ((u32x4){v0.x, v0.y, v1.x, v1.y}));
            o = mfma16(a, pf[k2], o);
        }
        *(u32x2*)(qrow + 16 * dt + 4 * fq) = (u32x2){cvt_pk_bf16(o[0] * inv, o[1] * inv), cvt_pk_bf16(o[2] * inv, o[3] * inv)};
    }
    __syncthreads();
}

__device__ __forceinline__ void run_phase(const Params& p, int ph, LAS unsigned char* lds) {
    int tid = threadIdx.x; asm volatile("" : "+v"(tid));
    const int lane = tid & 63, wave = tid >> 6;
    int G = gridDim.x, cu = blockIdx.x; asm volatile("" : "+s"(G), "+s"(cu));
    const int gw = cu * 8 + wave, ngw = G * 8;
    unsigned char* ws = p.ws; asm volatile("" : "+s"(ws));
    float* X = p.out; asm volatile("" : "+s"(X));
    const float* xin = p.in[0]; asm volatile("" : "+s"(xin));
    bf16_t* Hb = (bf16_t*)(ws + WS_H);
    if ((PHMASK & 1) && ph == NPH - 1) {
        for (int r = gw; r < T_ALL; r += ngw) rms_row_f32(X + (size_t)r * DM, p.in[20], X + (size_t)r * DM, lane);
        return;
    }
    const int l = ph / NPL, k = ph - l * NPL;
    if ((PHMASK & 2) && k == 0) {
        const size_t oFF = (size_t)l * DM * FF, oDD = (size_t)l * DM * DM;
        constexpr int I_F = 16 * 44, I_IN = 16 * 132, I_MKV = 16 * 32, I_DD = 16 * 16;
        constexpr int NIT = 6 * I_F + I_IN + I_MKV + 4 * I_DD;
        LAS bf16_t* scr = (LAS bf16_t*)lds;
        for (int it = cu; it < NIT; it += G) {
            int r = it;
            if (r < I_F) { wt_item(p.in[3] + oFF, DM, FF, (bf16_t*)(ws + WS_W13A), 1, r, scr, tid); continue; } r -= I_F;
            if (r < I_F) { wt_item(p.in[4] + oFF, DM, FF, (bf16_t*)(ws + WS_W13A), 2, r, scr, tid); continue; } r -= I_F;
            if (r < I_F) { wt_item(p.in[5] + oFF, FF, DM, (bf16_t*)(ws + WS_W2A), 0, r, scr, tid); continue; } r -= I_F;
            if (r < I_F) { wt_item(p.in[17] + oFF, DM, FF, (bf16_t*)(ws + WS_W13B), 1, r, scr, tid); continue; } r -= I_F;
            if (r < I_F) { wt_item(p.in[18] + oFF, DM, FF, (bf16_t*)(ws + WS_W13B), 2, r, scr, tid); continue; } r -= I_F;
            if (r < I_F) { wt_item(p.in[19] + oFF, FF, DM, (bf16_t*)(ws + WS_W2B), 0, r, scr, tid); continue; } r -= I_F;
            if (r < I_IN) { wt_item(p.in[7] + (size_t)l * DM * INW, DM, INW, (bf16_t*)(ws + WS_WIN), 0, r, scr, tid); continue; } r -= I_IN;
            if (r < I_MKV) { wt_item(p.in[11] + (size_t)l * DM * 2048, DM, 2048, (bf16_t*)(ws + WS_WMKV), 0, r, scr, tid); continue; } r -= I_MKV;
            if (r < I_DD) { wt_item(p.in[12] + oDD, DM, DM, (bf16_t*)(ws + WS_WUP), 0, r, scr, tid); continue; } r -= I_DD;
            if (r < I_DD) { wt_item(p.in[13] + oDD, DM, DM, (bf16_t*)(ws + WS_WUP) + (size_t)DM * DM, 0, r, scr, tid); continue; } r -= I_DD;
            if (r < I_DD) { wt_item(p.in[14] + oDD, DM, DM, (bf16_t*)(ws + WS_WUP) + (size_t)2 * DM * DM, 0, r, scr, tid); continue; } r -= I_DD;
            wt_item(p.in[15] + oDD, DM, DM, (bf16_t*)(ws + WS_WO), 0, r, scr, tid);
        }
        const float* xs = (l == 0) ? xin : (const float*)X;
        for (int r = gw; r < T_ALL; r += ngw) rms_row_bf16(xs + (size_t)r * DM, p.in[2] + l * DM, Hb + (size_t)r * DM, lane);
        for (int r = gw; r < 2048; r += ngw) rms_row_bf16(p.in[1] + (size_t)r * DM, p.in[10] + l * DM, (bf16_t*)(ws + WS_MEMH) + (size_t)r * DM, lane);
        if (l == 0) {
            f32x2* tab = (f32x2*)(ws + WS_TAB);
            for (int i = cu * 512 + tid; i < SEQ * 64; i += G * 512) {
                const int pos = i >> 6, j = i & 63;
                const float inv = exp2f(-(float)j * (13.287712379549449f / 64.f));
                const float ang = (float)pos * inv;
                double rr = (double)ang * 0.15915494309189535; rr -= rint(rr);
                const float rf = (float)rr;
                tab[i] = (f32x2){__builtin_amdgcn_cosf(rf), __builtin_amdgcn_sinf(rf)};
            }
        }
        return;
    }
    if ((PHMASK & 4) && (k == 1 || k == 17)) {
        pg8::Gemm g; g.A = Hb; g.Bt = (const bf16_t*)(ws + (k == 1 ? WS_W13A : WS_W13B)); g.M = T_ALL; g.N = 2 * FF; g.K = DM; g.lda = DM; g.zoff0 = g.zoff1 = g.zoff2 = 0; g.zB = 0;
        pg8::Order S; S.init(g.M, g.N, G, cu, 1);
        pg8::EpiSwiglu E; E.U = (bf16_t*)(ws + WS_U); E.ldu = FF;
        pg8::gemm_phase(lds, g, S, E, tid);
        if ((PHMASK & 8) && k == 1) {
            pg8::Gemm g2; g2.A = (const bf16_t*)(ws + WS_MEMH); g2.Bt = (const bf16_t*)(ws + WS_WMKV); g2.M = 2048; g2.N = 2048; g2.K = DM; g2.lda = DM; g2.zoff0 = g2.zoff1 = g2.zoff2 = 0; g2.zB = 0;
            pg8::Order S2; S2.init(2048, 2048, G, (cu + 128) % G, 1);
            pg8::EpiMkv E2; E2.mk = (bf16_t*)(ws + WS_MK); E2.mvT = (bf16_t*)(ws + WS_MVT);
            pg8::gemm_phase(lds, g2, S2, E2, tid);
        }
        return;
    }
    if ((PHMASK & 16) && (k == 2 || k == 18 || k == 9 || k == 15)) {
        pg8::Gemm g; pg8::EpiResid E; g.zoff0 = g.zoff1 = g.zoff2 = 0; g.zB = 0; g.N = DM; E.ld = DM;
        if (k == 2 || k == 18) {
            g.A = (const bf16_t*)(ws + WS_U); g.Bt = (const bf16_t*)(ws + (k == 2 ? WS_W2A : WS_W2B)); g.M = T_ALL; g.K = FF; g.lda = FF;
            E.src = (l == 0 && k == 2) ? xin : (const float*)X; E.dst = X; E.scale = 0.5f;
        } else {
            const int half = (k == 9) ? 0 : 1;
            g.A = Hb + (size_t)half * T_HALF * DM; g.Bt = (const bf16_t*)(ws + WS_WO); g.M = T_HALF; g.K = DM; g.lda = DM;
            E.src = X + (size_t)half * T_HALF * DM; E.dst = X + (size_t)half * T_HALF * DM; E.scale = 1.0f;
        }
        pg8::Order S; S.init(g.M, g.N, G, cu, 1);
        pg8::gemm_phase(lds, g, S, E, tid);
        return;
    }
    if ((PHMASK & 32) && (k == 3 || k == 16)) {
        const float* g3 = p.in[6]; asm volatile("" : "+s"(g3)); const float* g16 = p.in[16]; asm volatile("" : "+s"(g16));
        const float* gg = (k == 3 ? g3 : g16) + l * DM;
        for (int r = gw; r < T_ALL; r += ngw) rms_row_bf16(X + (size_t)r * DM, gg, Hb + (size_t)r * DM, lane);
        return;
    }
    const int half = (k - 4) / 6, s = (k - 4) - 6 * half;
    bf16_t* proj = (bf16_t*)(ws + WS_PROJ);
    float* states = (float*)(ws + WS_ST);
    const f32x2* tab = (const f32x2*)(ws + WS_TAB);
    if ((PHMASK & 64) && s == 0) {
        pg8::Gemm g; g.A = Hb + (size_t)half * T_HALF * DM; g.Bt = (const bf16_t*)(ws + WS_WIN); g.M = T_HALF; g.N = INW; g.K = DM; g.lda = DM; g.zoff0 = g.zoff1 = g.zoff2 = 0; g.zB = 0;
        pg8::Order S; S.init(g.M, g.N, G, cu, 1);
        pg8::EpiStore E; E.O = proj; E.ldc = INW;
        pg8::gemm_phase(lds, g, S, E, tid);
        return;
    }
    if (s == 1) {
        if (PHMASK & 128) for (int it = cu; it < 512; it += G) ret_state_item(proj, tab, states, it, lds, tid);
        if (PHMASK & 256) for (int it = cu; it < 256; it += G) swa_item(proj, p.in[9] + l * 16, it, lds, tid);
        if (PHMASK & 512) for (int it = cu; it < 512; it += G) mem_item(proj, (const bf16_t*)(ws + WS_MK), (const bf16_t*)(ws + WS_MVT), half * 4, it, lds, tid);
        return;
    }
    if ((PHMASK & 1024) && s == 2) { ret_scan(states, cu * 512 + tid, G * 512); return; }
    if ((PHMASK & 2048) && s == 3) {
        for (int it = cu; it < 512; it += G) ret_out_item(proj, tab, states, p.in[8] + l * 1024, it, lds, tid);
        return;
    }
    if ((PHMASK & 4096) && s == 4) {
        pg8::Gemm g; g.A = proj; g.Bt = (const bf16_t*)(ws + WS_WUP); g.M = T_HALF; g.N = DM; g.K = DM; g.lda = INW; g.zoff0 = C_RG; g.zoff1 = C_SQ; g.zoff2 = C_MQ; g.zB = (long)DM * DM;
        pg8::Order S; S.init(g.M, g.N, G, cu, 3);
        pg8::EpiGate E; E.Mg = Hb + (size_t)half * T_HALF * DM; E.gl = proj + C_GL; E.ldg = INW;
        pg8::gemm_phase(lds, g, S, E, tid);
        return;
    }
}

__global__ __launch_bounds__(512, 2) void mega(Params p, int ph_lo, int ph_hi) {
    extern __shared__ __attribute__((aligned(16))) unsigned char shm[];
    LAS unsigned char* lds = (LAS unsigned char*)shm;
    cg::grid_group grid = cg::this_grid();
    for (int ph = ph_lo; ph < ph_hi; ++ph) {
        run_phase(p, ph, lds);
        if (ph + 1 < ph_hi) grid.sync();
    }
}

extern "C" void kernel_launch(void* const* d_in, const int* in_sizes, int n_in, void* d_out, int out_size, void* d_ws, size_t ws_size, hipStream_t stream) {
    static int grid = 0;
    if (grid == 0) {
        if (n_in != 21 || out_size != T_ALL * DM || ws_size < WS_END) { fprintf(stderr, "kernel_launch: unexpected shapes (n_in %d out %d ws %zu need %zu)\n", n_in, out_size, ws_size, (size_t)WS_END); grid = -1; return; }
        int dev = 0, cus = 0, per_cu = 0;
        if (hipGetDevice(&dev) != hipSuccess || hipDeviceGetAttribute(&cus, hipDeviceAttributeMultiprocessorCount, dev) != hipSuccess) { grid = -1; return; }
        if (hipFuncSetAttribute((const void*)mega, hipFuncAttributeMaxDynamicSharedMemorySize, LDS_BYTES) != hipSuccess) { fprintf(stderr, "kernel_launch: hipFuncSetAttribute failed\n"); grid = -1; return; }
        if (hipOccupancyMaxActiveBlocksPerMultiprocessor(&per_cu, (const void*)mega, 512, LDS_BYTES) != hipSuccess || per_cu < 1) { fprintf(stderr, "kernel_launch: occupancy query says %d\n", per_cu); per_cu = 1; }
        (void)hipGetLastError();
        grid = cus;
    }
    if (grid <= 0) return;
    Params p{};
    for (int i = 0; i < 21; ++i) p.in[i] = (const float*)d_in[i];
    p.out = (float*)d_out; p.ws = (unsigned char*)d_ws;
#if MK_ONE_LAUNCH
    int lo = 0, hi = NPH;
    void* args[] = {&p, &lo, &hi};
    hipError_t e = hipLaunchCooperativeKernel((const void*)mega, dim3(grid), dim3(512), args, LDS_BYTES, stream);
    if (e != hipSuccess) fprintf(stderr, "cooperative launch failed: %s (grid %d)\n", hipGetErrorString(e), grid);
#else
    for (int ph = 0; ph < NPH; ++ph) hipLaunchKernelGGL(mega, dim3(grid), dim3(512), LDS_BYTES, stream, p, ph, ph + 1);
#endif
}
```

```cpp
#include <hip/hip_runtime.h>
#include <hip/hip_cooperative_groups.h>
#include <cstdio>
#include <cstdint>
namespace cg = cooperative_groups;

#ifndef MK_ONE_LAUNCH
#define MK_ONE_LAUNCH 1
#endif

#ifndef DBL_MASK
#define DBL_MASK 0
#endif
#ifndef PHMASK
#define PHMASK 0xffff
#endif
#define LAS __attribute__((address_space(3)))
typedef unsigned short bf16_t;
typedef short bf16x8 __attribute__((ext_vector_type(8)));
typedef short bf16x4 __attribute__((ext_vector_type(4)));
typedef float f32x4 __attribute__((ext_vector_type(4)));
typedef float f32x2 __attribute__((ext_vector_type(2)));
typedef unsigned u32x4 __attribute__((ext_vector_type(4)));
typedef unsigned u32x2 __attribute__((ext_vector_type(2)));

constexpr int T_ALL = 32768, DM = 1024, FF = 2816, INW = 8448, T_HALF = 16384, SEQ = 4096;
constexpr int C_RQ = 0, C_RK = 512, C_RV = 1024, C_RG = 2048, C_SQ = 3072, C_SK = 4096, C_SV = 4224, C_MQ = 4352, C_GL = 5376;
constexpr int LDS_PHASE = 143360, LDS_BYTES = LDS_PHASE + 16;
constexpr int NPL = 19, NPH = 2 * NPL + 1;

constexpr size_t SZ_W13 = (size_t)2 * FF * DM * 2, SZ_W2 = (size_t)DM * FF * 2;
constexpr size_t WS_W13A = 0, WS_W2A = WS_W13A + SZ_W13, WS_W13B = WS_W2A + SZ_W2, WS_W2B = WS_W13B + SZ_W13;
constexpr size_t WS_WIN = WS_W2B + SZ_W2, WS_WMKV = WS_WIN + (size_t)INW * DM * 2, WS_WUP = WS_WMKV + (size_t)2048 * DM * 2;
constexpr size_t WS_WO = WS_WUP + (size_t)3 * DM * DM * 2, WS_TAB = WS_WO + (size_t)DM * DM * 2;
constexpr size_t WS_MEMH = WS_TAB + (size_t)SEQ * 64 * 8, WS_MK = WS_MEMH + (size_t)2048 * DM * 2, WS_MVT = WS_MK + (size_t)2048 * DM * 2;
constexpr size_t WS_H = WS_MVT + (size_t)2048 * DM * 2, WS_TMP = WS_H + (size_t)T_ALL * DM * 2;
constexpr size_t WS_U = WS_TMP, WS_PROJ = WS_TMP, WS_ST = WS_PROJ + (size_t)T_HALF * INW * 2;
constexpr size_t WS_BAR = WS_ST + (size_t)512 * 32768 * 4;
constexpr size_t WS_END = WS_BAR + 16384;

struct Params {
    const float* in[21];
    float* out;
    unsigned char* ws;
};

__device__ __forceinline__ unsigned cvt_pk_bf16(float lo, float hi) { unsigned r; asm volatile("v_cvt_pk_bf16_f32 %0, %1, %2" : "=v"(r) : "v"(lo), "v"(hi)); return r; }
__device__ __forceinline__ bf16_t f2bf(float f) { return (bf16_t)(cvt_pk_bf16(f, 0.f) & 0xffffu); }
__device__ __forceinline__ float bf2f(unsigned b) { return __uint_as_float(b << 16); }
__device__ __forceinline__ float bflo(unsigned w) { return __uint_as_float(w << 16); }
__device__ __forceinline__ float bfhi(unsigned w) { return __uint_as_float(w & 0xffff0000u); }
__device__ __forceinline__ float wave_sum(float v) {
#pragma unroll
    for (int o = 1; o < 64; o <<= 1) v += __shfl_xor(v, o);
    return v;
}
__device__ __forceinline__ f32x4 mfma16(bf16x8 a, bf16x8 b, f32x4 c) { return __builtin_amdgcn_mfma_f32_16x16x32_bf16(a, b, c, 0, 0, 0); }
__device__ __forceinline__ float sigmoidf_(float x) { return 1.0f / (1.0f + __expf(-x)); }
__device__ __forceinline__ float log2g(int h) { return h == 0 ? -0.04580368961312479f : h == 1 ? -0.02272007650008353f : h == 2 ? -0.011315313227834146f : -0.005646563141142063f; }

namespace pg8 {
constexpr int BM = 256, BK = 64, HALF = 128, HTB = HALF * BK * 2, STAGE_BYTES = 8 * HTB, NXCD = 8, WGM = 8;
__host__ __device__ __forceinline__ int lds_byte(int r, int c) { const int st = (r >> 4) * 2 + (c >> 5), rr = r & 15, cc = c & 31, ob = rr * 64 + cc * 2; return st * 1024 + (ob ^ (((ob >> 9) & 1) << 5)); }
__host__ __device__ __forceinline__ void stage_rc(int b, int& R, int& C) { const int st = b / 1024, sb = b % 1024, swz = sb ^ (((sb >> 9) & 1) << 5); R = (st >> 1) * 16 + swz / 64; C = (st & 1) * 32 + (swz % 64) / 2; }
__host__ __device__ __forceinline__ int perm32(int rho) { const int n = rho >> 4, i = rho & 15; return 8 * (i >> 2) + 4 * n + (i & 3); }

struct Unit { int pm, pn, z; };
struct Gemm { const bf16_t* A; const bf16_t* Bt; int M, N, K, lda; int zoff0, zoff1, zoff2; long zB; };

struct Order {
    int nM, nN, nwg, G, c, nZ;
    __device__ void init(int M, int N, int G_, int c_, int nZ_) { nM = M / BM; nN = N / BM; nwg = nM * nN; G = G_; c = c_; nZ = nZ_; }
    __device__ bool next(int i, Unit& u) const {
        int rnd = i, z = 0;
        if (nZ == 3) { rnd = i / 3; z = i - 3 * rnd; }
        u.z = z;
        const long L = (long)rnd * G + c; if (L >= nwg) return false;
        int wgid = (int)L; { const int q = nwg / NXCD, r = nwg % NXCD, xcd = wgid % NXCD, off = wgid / NXCD; wgid = (xcd < r ? xcd * (q + 1) : r * (q + 1) + (xcd - r) * q) + off; }
        const int nig = WGM * nN, gid = wgid / nig, fm = gid * WGM, gsz = (nM - fm) < WGM ? (nM - fm) : WGM;
        u.pm = fm + ((wgid % nig) % gsz); u.pn = (wgid % nig) / gsz; return true;
    }
};

struct EpiStore {
    static constexpr bool PERM = true;
    bf16_t* O; int ldc;
    __device__ __forceinline__ void operator()(const f32x4 (&acc)[2][2][4][2], const Unit& u, int wr, int wc, int fr, int fq) const {
        const int row0 = u.pm * BM + wr * 64 + fr, col0 = u.pn * BM + wc * 32 + 8 * fq;
#pragma unroll
        for (int ai = 0; ai < 2; ++ai)
#pragma unroll
            for (int m = 0; m < 4; ++m) { bf16_t* rowp = O + (size_t)(row0 + ai * HALF + m * 16) * ldc + col0;
#pragma unroll
                for (int bj = 0; bj < 2; ++bj) { const f32x4 v0 = acc[ai][bj][m][0], v1 = acc[ai][bj][m][1];
                    u32x4 w; w.x = cvt_pk_bf16(v0[0], v0[1]); w.y = cvt_pk_bf16(v0[2], v0[3]); w.z = cvt_pk_bf16(v1[0], v1[1]); w.w = cvt_pk_bf16(v1[2], v1[3]);
                    *(u32x4*)(rowp + bj * HALF) = w; } }
    }
};
struct EpiSwiglu {
    static constexpr bool PERM = true;
    bf16_t* U; int ldu;
    __device__ __forceinline__ void operator()(const f32x4 (&acc)[2][2][4][2], const Unit& u, int wr, int wc, int fr, int fq) const {
        const int row0 = u.pm * BM + wr * 64 + fr, col0 = u.pn * 128 + wc * 16 + 4 * fq;
#pragma unroll
        for (int ai = 0; ai < 2; ++ai)
#pragma unroll
            for (int m = 0; m < 4; ++m) { bf16_t* rowp = U + (size_t)(row0 + ai * HALF + m * 16) * ldu + col0;
#pragma unroll
                for (int bj = 0; bj < 2; ++bj) { const f32x4 a = acc[ai][bj][m][0], b = acc[ai][bj][m][1];
                    float r[4];
#pragma unroll
                    for (int j = 0; j < 4; ++j) r[j] = a[j] * sigmoidf_(a[j]) * b[j];
                    u32x2 w; w.x = cvt_pk_bf16(r[0], r[1]); w.y = cvt_pk_bf16(r[2], r[3]);
                    *(u32x2*)(rowp + bj * 64) = w; } }
    }
};
struct EpiResid {
    static constexpr bool PERM = false;
    const float* src; float* dst; int ld; float scale;
    __device__ __forceinline__ void operator()(const f32x4 (&acc)[2][2][4][2], const Unit& u, int wr, int wc, int fr, int fq) const {
        const int row0 = u.pm * BM + wr * 64 + fr, col0 = u.pn * BM + wc * 32 + 4 * fq;
#pragma unroll
        for (int ai = 0; ai < 2; ++ai)
#pragma unroll
            for (int m = 0; m < 4; ++m) { const size_t ro = (size_t)(row0 + ai * HALF + m * 16) * ld + col0;
#pragma unroll
                for (int bj = 0; bj < 2; ++bj)
#pragma unroll
                    for (int n = 0; n < 2; ++n) { const f32x4 s = *(const f32x4*)(src + ro + bj * HALF + n * 16);
                        *(f32x4*)(dst + ro + bj * HALF + n * 16) = s + acc[ai][bj][m][n] * scale; } }
    }
};
struct EpiGate {
    static constexpr bool PERM = true;
    bf16_t* Mg; const bf16_t* gl; int ldg;
    __device__ __forceinline__ void operator()(const f32x4 (&acc)[2][2][4][2], const Unit& u, int wr, int wc, int fr, int fq) const {
        const int row0 = u.pm * BM + wr * 64 + fr, col0 = u.pn * BM + wc * 32 + 8 * fq;
#pragma unroll
        for (int ai = 0; ai < 2; ++ai)
#pragma unroll
            for (int m = 0; m < 4; ++m) { const int row = row0 + ai * HALF + m * 16;
                bf16_t* mp = Mg + (size_t)row * 1024 + col0; const bf16_t* gp = gl + (size_t)row * ldg + u.z * 1024 + col0;
#pragma unroll
                for (int bj = 0; bj < 2; ++bj) { const f32x4 v0 = acc[ai][bj][m][0], v1 = acc[ai][bj][m][1];
                    const u32x4 g = *(const u32x4*)(gp + bj * HALF);
                    u32x4 o = (u32x4){0u, 0u, 0u, 0u};
                    if (u.z > 0) o = *(const u32x4*)(mp + bj * HALF);
                    float r[8];
                    r[0] = bflo(o.x) + sigmoidf_(bflo(g.x)) * v0[0]; r[1] = bfhi(o.x) + sigmoidf_(bfhi(g.x)) * v0[1];
                    r[2] = bflo(o.y) + sigmoidf_(bflo(g.y)) * v0[2]; r[3] = bfhi(o.y) + sigmoidf_(bfhi(g.y)) * v0[3];
                    r[4] = bflo(o.z) + sigmoidf_(bflo(g.z)) * v1[0]; r[5] = bfhi(o.z) + sigmoidf_(bfhi(g.z)) * v1[1];
                    r[6] = bflo(o.w) + sigmoidf_(bflo(g.w)) * v1[2]; r[7] = bfhi(o.w) + sigmoidf_(bfhi(g.w)) * v1[3];
                    u32x4 w; w.x = cvt_pk_bf16(r[0], r[1]); w.y = cvt_pk_bf16(r[2], r[3]); w.z = cvt_pk_bf16(r[4], r[5]); w.w = cvt_pk_bf16(r[6], r[7]);
                    *(u32x4*)(mp + bj * HALF) = w; } }
    }
};
struct EpiMkv {
    static constexpr bool PERM = true;
    bf16_t* mk; bf16_t* mvT;
    __device__ __forceinline__ void operator()(const f32x4 (&acc)[2][2][4][2], const Unit& u, int wr, int wc, int fr, int fq) const {
        const int row0 = u.pm * BM + wr * 64 + fr, col0 = u.pn * BM + wc * 32 + 8 * fq;
#pragma unroll
        for (int ai = 0; ai < 2; ++ai)
#pragma unroll
            for (int m = 0; m < 4; ++m) { const int row = row0 + ai * HALF + m * 16;
#pragma unroll
                for (int bj = 0; bj < 2; ++bj) { const f32x4 v0 = acc[ai][bj][m][0], v1 = acc[ai][bj][m][1]; const int col = col0 + bj * HALF;
                    if (u.pn < 4) {
                        u32x4 w; w.x = cvt_pk_bf16(v0[0], v0[1]); w.y = cvt_pk_bf16(v0[2], v0[3]); w.z = cvt_pk_bf16(v1[0], v1[1]); w.w = cvt_pk_bf16(v1[2], v1[3]);
                        *(u32x4*)(mk + (size_t)row * 1024 + col) = w;
                    } else {
                        const int b = row >> 8, mem = row & 255; bf16_t* base = mvT + ((size_t)b * 1024 + (col - 1024)) * 256 + mem;
#pragma unroll
                        for (int j = 0; j < 4; ++j) { base[(size_t)j * 256] = f2bf(v0[j]); base[(size_t)(4 + j) * 256] = f2bf(v1[j]); }
                    } } }
    }
};

template <class Epi>
__device__ __forceinline__ void gemm_phase(LAS unsigned char* lds, const Gemm g, const Order& S, const Epi& E, const int tid) {
    const int wid = __builtin_amdgcn_readfirstlane(tid >> 6), lane = tid & 63, wr = wid >> 2, wc = wid & 3, fr = lane & 15, fq = lane >> 4;
    const int K = g.K, nt = K / BK, lda = g.lda;
    unsigned voffA[2], voffB[2];
#pragma unroll
    for (int i = 0; i < 2; ++i) { int R, C; stage_rc(tid * 16 + i * 8192, R, C); const int Rb = Epi::PERM ? ((R & ~31) + perm32(R & 31)) : R;
        voffA[i] = (unsigned)(R * lda + C) * 2u; voffB[i] = (unsigned)(Rb * K + C) * 2u; }
    const size_t kstep = (size_t)(BK * 2);
    const size_t hstepA = (size_t)HALF * lda * 2, hstepB = (size_t)HALF * K * 2;
    const size_t tstepA = 2 * hstepA, tstepB = 2 * hstepB;
    const unsigned ldsw = (unsigned)wid * 1024u;
    const int aoff = lds_byte(wr * 64 + fr, fq * 8), boff = lds_byte(wc * 32 + fr, fq * 8);
#define PG8_SA(b, h) (((b) * 2 + (h)) * HTB)
#define PG8_SB(b, h) ((4 + (b) * 2 + (h)) * HTB)
#define PG8_STAGE(bufoff, gbase, voff) do { _Pragma("unroll") for (int _i = 0; _i < 2; ++_i) \
        __builtin_amdgcn_global_load_lds((const unsigned*)((const char*)(gbase) + (voff)[_i]), (LAS unsigned*)(lds + (bufoff) + ldsw + _i * 8192), 16, 0, 0); } while (0)
#define PG8_LDA(dst, b, h) do { _Pragma("unroll") for (int m = 0; m < 4; ++m) _Pragma("unroll") for (int k = 0; k < 2; ++k) dst[m][k] = *(const LAS bf16x8*)(lds + PG8_SA(b, h) + aoff + m * 2048 + k * 1024); } while (0)
#define PG8_LDB(dst, b, h) do { _Pragma("unroll") for (int n = 0; n < 2; ++n) _Pragma("unroll") for (int k = 0; k < 2; ++k) dst[n][k] = *(const LAS bf16x8*)(lds + PG8_SB(b, h) + boff + n * 2048 + k * 1024); } while (0)
#define PG8_MMA(ai, bj, At, Bt) do { __builtin_amdgcn_s_setprio(1); _Pragma("unroll") for (int m = 0; m < 4; ++m) _Pragma("unroll") for (int n = 0; n < 2; ++n) _Pragma("unroll") for (int k = 0; k < 2; ++k) \
        acc[ai][bj][m][n] = __builtin_amdgcn_mfma_f32_16x16x32_bf16(Bt[n][k], At[m][k], acc[ai][bj][m][n], 0, 0, 0); __builtin_amdgcn_s_setprio(0); } while (0)
#define PG8_WAIT_V(n) asm volatile("s_waitcnt vmcnt(" #n ")" ::: "memory")
#define PG8_WAIT_L(n) asm volatile("s_waitcnt lgkmcnt(" #n ")" ::: "memory")
#define PG8_BAR __builtin_amdgcn_s_barrier()
#define PG8_SCHED __builtin_amdgcn_sched_barrier(0)
#define PG8_ABASE(u) ((const char*)g.A + (size_t)((u).z == 0 ? g.zoff0 : (u).z == 1 ? g.zoff1 : g.zoff2) * 2 + (size_t)(u).pm * tstepA)
#define PG8_BBASE(u) ((const char*)g.Bt + (size_t)((u).z * g.zB) * 2 + (size_t)(u).pn * tstepB)
    Unit cur, nxt; int ui = 0;
    if (!S.next(0, cur)) return;
    f32x4 acc[2][2][4][2];
#pragma unroll
    for (int a = 0; a < 2; ++a)
#pragma unroll
        for (int b = 0; b < 2; ++b)
#pragma unroll
            for (int m = 0; m < 4; ++m)
#pragma unroll
                for (int n = 0; n < 2; ++n) acc[a][b][m][n] = (f32x4){0.f, 0.f, 0.f, 0.f};
    bf16x8 At[4][2], B0[2][2], B1[2][2];
    const char* cA = PG8_ABASE(cur); const char* cB = PG8_BBASE(cur);
    PG8_STAGE(PG8_SB(0, 0), cB, voffB); PG8_STAGE(PG8_SB(0, 1), cB + hstepB, voffB); PG8_STAGE(PG8_SA(0, 0), cA, voffA); PG8_STAGE(PG8_SA(0, 1), cA + hstepA, voffA);
    if (wr == 1) PG8_BAR;
    PG8_WAIT_V(2); PG8_BAR;
    PG8_STAGE(PG8_SB(1, 0), cB + kstep, voffB); PG8_STAGE(PG8_SA(1, 0), cA + kstep, voffA); PG8_STAGE(PG8_SB(1, 1), cB + hstepB + kstep, voffB);
    PG8_WAIT_V(6); PG8_BAR;
    for (;;) {
        const bool has_next = S.next(ui + 1, nxt);
        const char* nA = has_next ? PG8_ABASE(nxt) : cA; const char* nB = has_next ? PG8_BBASE(nxt) : cB;
        for (int t = 0; t < nt; t += 2) {
            const bool last = (t == nt - 2);
            const char* a1 = cA + (size_t)(t + 1) * kstep;
            const char* a2 = last ? nA : cA + (size_t)(t + 2) * kstep; const char* b2 = last ? nB : cB + (size_t)(t + 2) * kstep;
            const char* a3 = a2 + kstep; const char* b3 = b2 + kstep;
            PG8_LDB(B0, 0, 0); PG8_LDB(B1, 0, 1); PG8_SCHED; PG8_LDA(At, 0, 0); PG8_STAGE(PG8_SA(1, 1), a1 + hstepA, voffA);
            PG8_WAIT_V(8); PG8_WAIT_L(0); PG8_BAR; PG8_MMA(0, 0, At, B0); PG8_MMA(0, 1, At, B1); PG8_BAR; PG8_SCHED;
            PG8_LDA(At, 0, 1); PG8_STAGE(PG8_SB(0, 0), b2, voffB); PG8_STAGE(PG8_SB(0, 1), b2 + hstepB, voffB); PG8_STAGE(PG8_SA(0, 0), a2, voffA);
            PG8_WAIT_V(8); PG8_WAIT_L(0); PG8_BAR; PG8_MMA(1, 0, At, B0); PG8_MMA(1, 1, At, B1); PG8_BAR; PG8_SCHED;
            PG8_LDB(B0, 1, 0); PG8_LDB(B1, 1, 1); PG8_SCHED; PG8_LDA(At, 1, 0); PG8_STAGE(PG8_SA(0, 1), a2 + hstepA, voffA);
            PG8_WAIT_V(8); PG8_WAIT_L(0); PG8_BAR; PG8_MMA(0, 0, At, B0); PG8_MMA(0, 1, At, B1); PG8_BAR; PG8_SCHED;
            PG8_LDA(At, 1, 1); PG8_STAGE(PG8_SB(1, 0), b3, voffB); PG8_STAGE(PG8_SB(1, 1), b3 + hstepB, voffB); PG8_STAGE(PG8_SA(1, 0), a3, voffA);
            PG8_WAIT_V(8); PG8_WAIT_L(0); PG8_BAR; PG8_MMA(1, 0, At, B0); PG8_MMA(1, 1, At, B1); PG8_BAR; PG8_SCHED;
        }
        if (wr == 0) PG8_BAR;
        E(acc, cur, wr, wc, fr, fq);
        if (!has_next) break;
#pragma unroll
        for (int a = 0; a < 2; ++a)
#pragma unroll
            for (int b = 0; b < 2; ++b)
#pragma unroll
                for (int m = 0; m < 4; ++m)
#pragma unroll
                    for (int n = 0; n < 2; ++n) acc[a][b][m][n] = (f32x4){0.f, 0.f, 0.f, 0.f};
        cur = nxt; cA = nA; cB = nB; ++ui;
        if (wr == 1) PG8_BAR;
    }
    PG8_WAIT_V(0);
    PG8_BAR;
#undef PG8_SA
#undef PG8_SB
#undef PG8_STAGE
#undef PG8_LDA
#undef PG8_LDB
#undef PG8_MMA
#undef PG8_WAIT_V
#undef PG8_WAIT_L
#undef PG8_BAR
#undef PG8_SCHED
#undef PG8_ABASE
#undef PG8_BBASE
}
}

__device__ __forceinline__ void rms_row_bf16(const float* xrow, const float* g, bf16_t* orow, int lane) {
    const f32x4* xr = (const f32x4*)xrow + lane; const f32x4* gr = (const f32x4*)g + lane;
    f32x4 v[4]; float s = 0.f;
#pragma unroll
    for (int j = 0; j < 4; ++j) { v[j] = xr[64 * j]; s += (v[j].x * v[j].x + v[j].y * v[j].y) + (v[j].z * v[j].z + v[j].w * v[j].w); }
    const float rstd = rsqrtf(wave_sum(s) * (1.f / 1024.f) + 1e-6f);
    u32x2* o8 = (u32x2*)orow + lane;
#pragma unroll
    for (int j = 0; j < 4; ++j) { const f32x4 gg = gr[64 * j]; u32x2 w; w.x = cvt_pk_bf16(v[j].x * rstd * gg.x, v[j].y * rstd * gg.y); w.y = cvt_pk_bf16(v[j].z * rstd * gg.z, v[j].w * rstd * gg.w); o8[64 * j] = w; }
}
__device__ __forceinline__ void rms_row_f32(const float* xrow, const float* g, float* orow, int lane) {
    const f32x4* xr = (const f32x4*)xrow + lane; const f32x4* gr = (const f32x4*)g + lane;
    f32x4 v[4]; float s = 0.f;
#pragma unroll
    for (int j = 0; j < 4; ++j) { v[j] = xr[64 * j]; s += (v[j].x * v[j].x + v[j].y * v[j].y) + (v[j].z * v[j].z + v[j].w * v[j].w); }
    const float rstd = rsqrtf(wave_sum(s) * (1.f / 1024.f) + 1e-6f);
    f32x4* o = (f32x4*)orow + lane;
#pragma unroll
    for (int j = 0; j < 4; ++j) { const f32x4 gg = gr[64 * j]; o[64 * j] = v[j] * rstd * gg; }
}

__device__ __forceinline__ void wt_item(const float* W, int K, int N, bf16_t* WT, int mode, int item, LAS float* scr, int lane) {
    const int nblk = N >> 5, kb = item / nblk, nb = item - kb * nblk, k0 = kb * 64, n0 = nb * 32;
#pragma unroll 16
    for (int i = 0; i < 32; ++i) { const int kk = 2 * i + (lane >> 5); scr[kk * 33 + (lane & 31)] = W[(size_t)(k0 + kk) * N + n0 + (lane & 31)]; }
    asm volatile("s_waitcnt lgkmcnt(0)" ::: "memory");
    const int c = lane & 7;
#pragma unroll
    for (int j = 0; j < 4; ++j) { const int n = (lane >> 3) + 8 * j, sn = n0 + n; const LAS float* q = scr + (8 * c) * 33 + n;
        const int dr = mode == 0 ? sn : (8 * (sn >> 2) + (sn & 3) + (mode == 2 ? 4 : 0));
        u32x4 o; o.x = cvt_pk_bf16(q[0 * 33], q[1 * 33]); o.y = cvt_pk_bf16(q[2 * 33], q[3 * 33]); o.z = cvt_pk_bf16(q[4 * 33], q[5 * 33]); o.w = cvt_pk_bf16(q[6 * 33], q[7 * 33]);
        *(u32x4*)(WT + (size_t)dr * K + k0 + 8 * c) = o; }
    asm volatile("s_waitcnt lgkmcnt(0)" ::: "memory");
}

__device__ __forceinline__ void rot16(const bf16_t* row, const f32x2* tabrow, int jg, float sc, unsigned (&y1)[8], unsigned (&y2)[8]) {
    const u32x4 a0 = *(const u32x4*)(row + jg * 16), a1 = *(const u32x4*)(row + jg * 16 + 8);
    const u32x4 b0 = *(const u32x4*)(row + 64 + jg * 16), b1 = *(const u32x4*)(row + 64 + jg * 16 + 8);
    const unsigned aw[8] = {a0.x, a0.y, a0.z, a0.w, a1.x, a1.y, a1.z, a1.w};
    const unsigned bw[8] = {b0.x, b0.y, b0.z, b0.w, b1.x, b1.y, b1.z, b1.w};
    const f32x4* tp = (const f32x4*)(tabrow + jg * 16);
#pragma unroll
    for (int i = 0; i < 8; ++i) {
        const f32x4 cs = tp[i];
        const float x1a = bflo(aw[i]), x1b = bfhi(aw[i]), x2a = bflo(bw[i]), x2b = bfhi(bw[i]);
        y1[i] = cvt_pk_bf16((x1a * cs.x - x2a * cs.y) * sc, (x1b * cs.z - x2b * cs.w) * sc);
        y2[i] = cvt_pk_bf16((x1a * cs.y + x2a * cs.x) * sc, (x1b * cs.w + x2b * cs.z) * sc);
    }
}

constexpr int RP = 136;

__device__ __forceinline__ void ret_state_item(const bf16_t* proj, const f32x2* tab, float* states, int item, LAS unsigned char* lds, int tid) {
    const int wave = tid >> 6, lane = tid & 63, fr = lane & 15, fq = lane >> 4;
    const int h = item & 3, n = (item >> 2) & 31, bl = item >> 7;
    const size_t tok0 = (size_t)bl * SEQ + n * 128;
    LAS bf16_t* KT = (LAS bf16_t*)lds;
    LAS bf16_t* VT = (LAS bf16_t*)(lds + 128 * RP * 2);
    const float lg = log2g(h);
    {
        const int c = tid >> 2, jg = tid & 3;
        const bf16_t* row = proj + (tok0 + c) * INW + C_RK + h * 128;
        unsigned y1[8], y2[8];
        rot16(row, tab + (size_t)(n * 128 + c) * 64, jg, 0.08838834764831845f * exp2f(-(float)(c + 1) * lg), y1, y2);
#pragma unroll
        for (int i = 0; i < 8; ++i) {
            const int j = jg * 16 + 2 * i;
            KT[(j) * RP + c] = (bf16_t)(y1[i] & 0xffffu); KT[(j + 1) * RP + c] = (bf16_t)(y1[i] >> 16);
            KT[(j + 64) * RP + c] = (bf16_t)(y2[i] & 0xffffu); KT[(j + 65) * RP + c] = (bf16_t)(y2[i] >> 16);
        }
        const bf16_t* vrow = proj + (tok0 + c) * INW + C_RV + h * 256 + jg * 64;
#pragma unroll
        for (int i = 0; i < 8; ++i) {
            const u32x4 v = *(const u32x4*)(vrow + i * 8);
            const unsigned vw[4] = {v.x, v.y, v.z, v.w};
#pragma unroll
            for (int k = 0; k < 4; ++k) { const int e = jg * 64 + i * 8 + 2 * k; VT[e * RP + c] = (bf16_t)(vw[k] & 0xffffu); VT[(e + 1) * RP + c] = (bf16_t)(vw[k] >> 16); }
        }
    }
    __syncthreads();
    f32x4 acc[8][2];
#pragma unroll
    for (int dt = 0; dt < 8; ++dt) { acc[dt][0] = (f32x4){0.f, 0.f, 0.f, 0.f}; acc[dt][1] = (f32x4){0.f, 0.f, 0.f, 0.f}; }
#pragma unroll
    for (int ks = 0; ks < 4; ++ks) {
        bf16x8 bfr[2];
#pragma unroll
        for (int et = 0; et < 2; ++et) bfr[et] = *(const LAS bf16x8*)(VT + (32 * wave + 16 * et + fr) * RP + 32 * ks + 8 * fq);
#pragma unroll
        for (int dt = 0; dt < 8; ++dt) {
            const bf16x8 a = *(const LAS bf16x8*)(KT + (16 * dt + fr) * RP + 32 * ks + 8 * fq);
            acc[dt][0] = mfma16(a, bfr[0], acc[dt][0]); acc[dt][1] = mfma16(a, bfr[1], acc[dt][1]);
        }
    }
    const float gch = exp2f(128.f * lg);
    float* sp = states + (size_t)item * 32768;
#pragma unroll
    for (int et = 0; et < 2; ++et)
#pragma unroll
        for (int dt = 0; dt < 8; ++dt) *(f32x4*)(sp + (size_t)(32 * wave + 16 * et + fr) * 128 + 16 * dt + 4 * fq) = acc[dt][et] * gch;
    __syncthreads();
}

__device__ __forceinline__ void ret_scan(float* states, int gtid, int nthreads, int dry) {
    for (int i = gtid; i < 16 * 8192; i += nthreads) {
        const int bh = i >> 13, off = i & 8191, bl = bh >> 2, h = bh & 3;
        const float g = exp2f(128.f * log2g(h));
        f32x4* p = (f32x4*)(states + ((size_t)(bl * 32) * 4 + h) * 32768) + off;
        f32x4 R = (f32x4){0.f, 0.f, 0.f, 0.f};
        for (int n0 = 0; n0 < 32; n0 += 8) {
            f32x4 s[8];
#pragma unroll
            for (int k = 0; k < 8; ++k) s[k] = p[(size_t)(n0 + k) * 32768];
#pragma unroll
            for (int k = 0; k < 8; ++k) { if (!dry) p[(size_t)(n0 + k) * 32768] = R; R = R * g + s[k]; }
        }
    }
}

__device__ __forceinline__ void ret_out_item(bf16_t* proj, const f32x2* tab, const float* states, const float* gn, int item, LAS unsigned char* lds, int tid, int dry) {
    const int wave = tid >> 6, lane = tid & 63, fr = lane & 15, fq = lane >> 4;
    const int h = item & 3, n = (item >> 2) & 31, bl = item >> 7;
    const size_t tok0 = (size_t)bl * SEQ + n * 128;
    LAS bf16_t* QS = (LAS bf16_t*)lds;
    LAS bf16_t* KS = (LAS bf16_t*)(lds + 128 * RP * 2);
    LAS bf16_t* VT = (LAS bf16_t*)(lds + 2 * 128 * RP * 2);
    LAS float* red = (LAS float*)(lds + 4 * 128 * RP * 2);
    const float lg = log2g(h);
    {
        const int c = tid >> 2, jg = tid & 3;
        const f32x2* tr = tab + (size_t)(n * 128 + c) * 64;
        unsigned y1[8], y2[8];
        rot16(proj + (tok0 + c) * INW + C_RQ + h * 128, tr, jg, exp2f((float)(c + 1) * lg), y1, y2);
        *(LAS u32x4*)(QS + c * RP + jg * 16) = (u32x4){y1[0], y1[1], y1[2], y1[3]}; *(LAS u32x4*)(QS + c * RP + jg * 16 + 8) = (u32x4){y1[4], y1[5], y1[6], y1[7]};
        *(LAS u32x4*)(QS + c * RP + 64 + jg * 16) = (u32x4){y2[0], y2[1], y2[2], y2[3]}; *(LAS u32x4*)(QS + c * RP + 64 + jg * 16 + 8) = (u32x4){y2[4], y2[5], y2[6], y2[7]};
        rot16(proj + (tok0 + c) * INW + C_RK + h * 128, tr, jg, 0.08838834764831845f * exp2f(-(float)(c + 1) * lg), y1, y2);
        *(LAS u32x4*)(KS + c * RP + jg * 16) = (u32x4){y1[0], y1[1], y1[2], y1[3]}; *(LAS u32x4*)(KS + c * RP + jg * 16 + 8) = (u32x4){y1[4], y1[5], y1[6], y1[7]};
        *(LAS u32x4*)(KS + c * RP + 64 + jg * 16) = (u32x4){y2[0], y2[1], y2[2], y2[3]}; *(LAS u32x4*)(KS + c * RP + 64 + jg * 16 + 8) = (u32x4){y2[4], y2[5], y2[6], y2[7]};
        const bf16_t* vrow = proj + (tok0 + c) * INW + C_RV + h * 256 + jg * 64;
#pragma unroll
        for (int i = 0; i < 8; ++i) {
            const u32x4 v = *(const u32x4*)(vrow + i * 8);
            const unsigned vw[4] = {v.x, v.y, v.z, v.w};
#pragma unroll
            for (int k = 0; k < 4; ++k) { const int e = jg * 64 + i * 8 + 2 * k; VT[e * RP + c] = (bf16_t)(vw[k] & 0xffffu); VT[(e + 1) * RP + c] = (bf16_t)(vw[k] >> 16); }
        }
    }
    __syncthreads();
    unsigned pk[8][2];
    {
        f32x4 pacc[8];
#pragma unroll
        for (int st = 0; st < 8; ++st) pacc[st] = (f32x4){0.f, 0.f, 0.f, 0.f};
#pragma unroll
        for (int ks = 0; ks < 4; ++ks) {
            const bf16x8 b = *(const LAS bf16x8*)(QS + (16 * wave + fr) * RP + 32 * ks + 8 * fq);
#pragma unroll
            for (int st = 0; st < 8; ++st) { const bf16x8 a = *(const LAS bf16x8*)(KS + (16 * st + fr) * RP + 32 * ks + 8 * fq); pacc[st] = mfma16(a, b, pacc[st]); }
        }
        const int c = 16 * wave + fr;
#pragma unroll
        for (int st = 0; st < 8; ++st) { float v[4];
#pragma unroll
            for (int j = 0; j < 4; ++j) { const int s = 16 * st + 4 * fq + j; v[j] = (s <= c) ? pacc[st][j] : 0.f; }
            pk[st][0] = cvt_pk_bf16(v[0], v[1]); pk[st][1] = cvt_pk_bf16(v[2], v[3]); }
    }
    __syncthreads();
    {
        const int c = 16 * wave + fr;
#pragma unroll
        for (int st = 0; st < 8; ++st) *(LAS u32x2*)(KS + c * RP + 16 * st + 4 * fq) = (u32x2){pk[st][0], pk[st][1]};
    }
    __syncthreads();
    f32x4 acc[2][8];
#pragma unroll
    for (int et = 0; et < 2; ++et)
#pragma unroll
        for (int ct = 0; ct < 8; ++ct) acc[et][ct] = (f32x4){0.f, 0.f, 0.f, 0.f};
    const float* sp = states + (size_t)item * 32768;
#pragma unroll
    for (int ks = 0; ks < 4; ++ks) {
        bf16x8 av[2], ar[2];
#pragma unroll
        for (int et = 0; et < 2; ++et) {
            const int e = 32 * wave + 16 * et + fr;
            av[et] = *(const LAS bf16x8*)(VT + e * RP + 32 * ks + 8 * fq);
            const f32x4 r0 = *(const f32x4*)(sp + (size_t)e * 128 + 32 * ks + 8 * fq), r1 = *(const f32x4*)(sp + (size_t)e * 128 + 32 * ks + 8 * fq + 4);
            u32x4 w; w.x = cvt_pk_bf16(r0.x, r0.y); w.y = cvt_pk_bf16(r0.z, r0.w); w.z = cvt_pk_bf16(r1.x, r1.y); w.w = cvt_pk_bf16(r1.z, r1.w);
            ar[et] = __builtin_bit_cast(bf16x8, w);
        }
#pragma unroll
        for (int ct = 0; ct < 8; ++ct) {
            const bf16x8 bp = *(const LAS bf16x8*)(KS + (16 * ct + fr) * RP + 32 * ks + 8 * fq);
            const bf16x8 bq = *(const LAS bf16x8*)(QS + (16 * ct + fr) * RP + 32 * ks + 8 * fq);
#pragma unroll
            for (int et = 0; et < 2; ++et) { acc[et][ct] = mfma16(av[et], bp, acc[et][ct]); acc[et][ct] = mfma16(ar[et], bq, acc[et][ct]); }
        }
    }
#pragma unroll
    for (int ct = 0; ct < 8; ++ct) {
        float s = 0.f;
#pragma unroll
        for (int et = 0; et < 2; ++et) s += (acc[et][ct][0] * acc[et][ct][0] + acc[et][ct][1] * acc[et][ct][1]) + (acc[et][ct][2] * acc[et][ct][2] + acc[et][ct][3] * acc[et][ct][3]);
        s += __shfl_xor(s, 16); s += __shfl_xor(s, 32);
        if (fq == 0) red[wave * 128 + 16 * ct + fr] = s;
    }
    __syncthreads();
#pragma unroll
    for (int ct = 0; ct < 8; ++ct) {
        const int c = 16 * ct + fr;
        float s = 0.f;
#pragma unroll
        for (int w = 0; w < 8; ++w) s += red[w * 128 + c];
        const float rstd = rsqrtf(s * (1.f / 256.f) + 1e-6f);
        bf16_t* grow = proj + (tok0 + c) * INW + C_RG + h * 256;
#pragma unroll
        for (int et = 0; et < 2; ++et) {
            const int e = 32 * wave + 16 * et + 4 * fq;
            const u32x2 gw = *(const u32x2*)(grow + e);
            const f32x4 gg = *(const f32x4*)(gn + h * 256 + e);
            const float g0 = bflo(gw.x), g1 = bfhi(gw.x), g2 = bflo(gw.y), g3 = bfhi(gw.y);
            const float o0 = acc[et][ct][0] * rstd * gg.x * g0 * sigmoidf_(g0), o1 = acc[et][ct][1] * rstd * gg.y * g1 * sigmoidf_(g1);
            const float o2 = acc[et][ct][2] * rstd * gg.z * g2 * sigmoidf_(g2), o3 = acc[et][ct][3] * rstd * gg.w * g3 * sigmoidf_(g3);
            if (!dry) *(u32x2*)(grow + e) = (u32x2){cvt_pk_bf16(o0, o1), cvt_pk_bf16(o2, o3)};
        }
    }
    __syncthreads();
}

constexpr int SKP = 72, SVP = 264;
__device__ __forceinline__ void swa_item(bf16_t* proj, const float* sinks, int item, LAS unsigned char* lds, int tid, int dry) {
    const int wave = tid >> 6, lane = tid & 63, fr = lane & 15, fq = lane >> 4;
    const int kh = item & 1, n = (item >> 1) & 31, bl = item >> 6;
    const size_t tok0 = (size_t)bl * SEQ + n * 128;
    LAS bf16_t* Ks = (LAS bf16_t*)lds;
    LAS bf16_t* Vt = (LAS bf16_t*)(lds + 256 * SKP * 2);
#pragma unroll
    for (int i = 0; i < 4; ++i) {
        const int ch = tid + 512 * i, key = ch >> 3, part = ch & 7;
        u32x4 kv = (u32x4){0u, 0u, 0u, 0u}, vv = (u32x4){0u, 0u, 0u, 0u};
        if (n > 0 || key >= 128) { const bf16_t* r = proj + (tok0 + key - 128) * INW; kv = *(const u32x4*)(r + C_SK + kh * 64 + part * 8); vv = *(const u32x4*)(r + C_SV + kh * 64 + part * 8); }
        *(LAS u32x4*)(Ks + key * SKP + part * 8) = kv;
        const unsigned vw[4] = {vv.x, vv.y, vv.z, vv.w};
#pragma unroll
        for (int k = 0; k < 4; ++k) { const int d = part * 8 + 2 * k; Vt[d * SVP + key] = (bf16_t)(vw[k] & 0xffffu); Vt[(d + 1) * SVP + key] = (bf16_t)(vw[k] >> 16); }
    }
    __syncthreads();
    const int h = kh * 8 + wave; const float sink = sinks[h];
    for (int qt = 0; qt < 8; ++qt) {
        bf16_t* qrow = proj + (tok0 + 16 * qt + fr) * INW + C_SQ + h * 64;
        bf16x8 qf[2];
        qf[0] = *(const bf16x8*)(qrow + 8 * fq); qf[1] = *(const bf16x8*)(qrow + 32 + 8 * fq);
        f32x4 s[16];
#pragma unroll
        for (int t = 0; t < 16; ++t) { s[t] = (f32x4){0.f, 0.f, 0.f, 0.f};
#pragma unroll
            for (int ks = 0; ks < 2; ++ks) { const bf16x8 a = *(const LAS bf16x8*)(Ks + (16 * t + fr) * SKP + 32 * ks + 8 * fq); s[t] = mfma16(a, qf[ks], s[t]); } }
        const int c = 16 * qt + fr; float mx = sink;
#pragma unroll
        for (int t = 0; t < 16; ++t)
#pragma unroll
            for (int j = 0; j < 4; ++j) { const int kpos = 16 * t + 4 * fq + j; const bool valid = (kpos > c) && (kpos <= c + 128) && (n > 0 || kpos >= 128);
                const float v = valid ? s[t][j] * 0.125f : -1e30f; s[t][j] = v; mx = fmaxf(mx, v); }
        mx = fmaxf(mx, __shfl_xor(mx, 16)); mx = fmaxf(mx, __shfl_xor(mx, 32));
        float sum = 0.f;
#pragma unroll
        for (int t = 0; t < 16; ++t)
#pragma unroll
            for (int j = 0; j < 4; ++j) { const float pv = __expf(s[t][j] - mx); s[t][j] = pv; sum += pv; }
        sum += __shfl_xor(sum, 16); sum += __shfl_xor(sum, 32);
        sum += __expf(sink - mx);
        const float inv = 1.0f / sum;
        f32x4 o[4];
#pragma unroll
        for (int dt = 0; dt < 4; ++dt) o[dt] = (f32x4){0.f, 0.f, 0.f, 0.f};
#pragma unroll
        for (int k2 = 0; k2 < 8; ++k2) {
            u32x4 pw; pw.x = cvt_pk_bf16(s[2 * k2][0], s[2 * k2][1]); pw.y = cvt_pk_bf16(s[2 * k2][2], s[2 * k2][3]); pw.z = cvt_pk_bf16(s[2 * k2 + 1][0], s[2 * k2 + 1][1]); pw.w = cvt_pk_bf16(s[2 * k2 + 1][2], s[2 * k2 + 1][3]);
            const bf16x8 pf = __builtin_bit_cast(bf16x8, pw);
#pragma unroll
            for (int dt = 0; dt < 4; ++dt) {
                const u32x2 v0 = *(const LAS u32x2*)(Vt + (16 * dt + fr) * SVP + 32 * k2 + 4 * fq), v1 = *(const LAS u32x2*)(Vt + (16 * dt + fr) * SVP + 32 * k2 + 16 + 4 * fq);
                const bf16x8 a = __builtin_bit_cast(bf16x8, ((u32x4){v0.x, v0.y, v1.x, v1.y}));
                o[dt] = mfma16(a, pf, o[dt]);
            }
        }
#pragma unroll
        for (int dt = 0; dt < 4; ++dt) if (!dry) *(u32x2*)(qrow + 16 * dt + 4 * fq) = (u32x2){cvt_pk_bf16(o[dt][0] * inv, o[dt][1] * inv), cvt_pk_bf16(o[dt][2] * inv, o[dt][3] * inv)};
    }
    __syncthreads();
}

constexpr int MP = 264;
__device__ __forceinline__ void mem_item(bf16_t* proj, const bf16_t* mk, const bf16_t* mvT, int bglob0, int item, LAS unsigned char* lds, int tid, int dry) {
    const int wave = tid >> 6, lane = tid & 63, fr = lane & 15, fq = lane >> 4;
    const int qt = item & 31, h = (item >> 5) & 3, bl = item >> 7, b = bglob0 + bl;
    const size_t tok0 = (size_t)bl * SEQ + qt * 128;
    LAS bf16_t* Ms = (LAS bf16_t*)lds;
    {
        const bf16_t* src = mk + (size_t)b * 256 * 1024 + h * 256;
#pragma unroll 4
        for (int i = 0; i < 16; ++i) { const int ch = tid + 512 * i, row = ch >> 5, part = ch & 31; *(LAS u32x4*)(Ms + row * MP + part * 8) = *(const u32x4*)(src + (size_t)row * 1024 + part * 8); }
    }
    bf16_t* qrow = proj + (tok0 + 16 * wave + fr) * INW + C_MQ + h * 256;
    bf16x8 qf[8];
#pragma unroll
    for (int ks = 0; ks < 8; ++ks) qf[ks] = *(const bf16x8*)(qrow + 32 * ks + 8 * fq);
    __syncthreads();
    f32x4 s[16];
#pragma unroll
    for (int t = 0; t < 16; ++t) { s[t] = (f32x4){0.f, 0.f, 0.f, 0.f};
#pragma unroll
        for (int ks = 0; ks < 8; ++ks) { const bf16x8 a = *(const LAS bf16x8*)(Ms + (16 * t + fr) * MP + 32 * ks + 8 * fq); s[t] = mfma16(a, qf[ks], s[t]); } }
    float mx = -1e30f;
#pragma unroll
    for (int t = 0; t < 16; ++t)
#pragma unroll
        for (int j = 0; j < 4; ++j) { const float v = s[t][j] * 0.0625f; s[t][j] = v; mx = fmaxf(mx, v); }
    mx = fmaxf(mx, __shfl_xor(mx, 16)); mx = fmaxf(mx, __shfl_xor(mx, 32));
    float sum = 0.f;
#pragma unroll
    for (int t = 0; t < 16; ++t)
#pragma unroll
        for (int j = 0; j < 4; ++j) { const float pv = __expf(s[t][j] - mx); s[t][j] = pv; sum += pv; }
    sum += __shfl_xor(sum, 16); sum += __shfl_xor(sum, 32);
    const float inv = 1.0f / sum;
    bf16x8 pf[8];
#pragma unroll
    for (int k2 = 0; k2 < 8; ++k2) { u32x4 pw; pw.x = cvt_pk_bf16(s[2 * k2][0], s[2 * k2][1]); pw.y = cvt_pk_bf16(s[2 * k2][2], s[2 * k2][3]); pw.z = cvt_pk_bf16(s[2 * k2 + 1][0], s[2 * k2 + 1][1]); pw.w = cvt_pk_bf16(s[2 * k2 + 1][2], s[2 * k2 + 1][3]);
        pf[k2] = __builtin_bit_cast(bf16x8, pw); }
    __syncthreads();
    {
        const bf16_t* src = mvT + ((size_t)b * 1024 + h * 256) * 256;
#pragma unroll 4
        for (int i = 0; i < 16; ++i) { const int ch = tid + 512 * i, row = ch >> 5, part = ch & 31; *(LAS u32x4*)(Ms + row * MP + part * 8) = *(const u32x4*)(src + (size_t)row * 256 + part * 8); }
    }
    __syncthreads();
#pragma unroll
    for (int dt = 0; dt < 16; ++dt) {
        f32x4 o = (f32x4){0.f, 0.f, 0.f, 0.f};
#pragma unroll
        for (int k2 = 0; k2 < 8; ++k2) {
            const u32x2 v0 = *(const LAS u32x2*)(Ms + (16 * dt + fr) * MP + 32 * k2 + 4 * fq), v1 = *(const LAS u32x2*)(Ms + (16 * dt + fr) * MP + 32 * k2 + 16 + 4 * fq);
            const bf16x8 a = __builtin_bit_cast(bf16x8, ((u32x4){v0.x, v0.y, v1.x, v1.y}));
            o = mfma16(a, pf[k2], o);
        }
        if (!dry) *(u32x2*)(qrow + 16 * dt + 4 * fq) = (u32x2){cvt_pk_bf16(o[0] * inv, o[1] * inv), cvt_pk_bf16(o[2] * inv, o[3] * inv)};
    }
    __syncthreads();
}


#define XB_TMO      128
#define XB_XCNT(j)  (256  + 64 * (j))
#define XB_XSUB(j)  (1280 + 64 * (j))
#define XB_XGEN(j)  (2304 + 64 * (j))
#define XB_TOP      3328
#define XB_TOPGEN   3392
#define XCD_BAR_WORDS 3456
#define XB_SPIN_CAP (1u << 18)
__device__ __forceinline__ unsigned xb_ld(unsigned* p)              { return __hip_atomic_load(p, __ATOMIC_RELAXED, __HIP_MEMORY_SCOPE_AGENT); }
__device__ __forceinline__ unsigned xb_add(unsigned* p, unsigned v) { return __hip_atomic_fetch_add(p, v, __ATOMIC_RELAXED, __HIP_MEMORY_SCOPE_AGENT); }
__device__ __forceinline__ unsigned xb_xcc_id() { return (unsigned)__builtin_amdgcn_s_getreg((3 << 11) | 20) & 0xFu; }
#define XB_SPIN(cond, bar) do { unsigned _sp = 0; while (cond) { __builtin_amdgcn_s_sleep(1); \
    if ((++_sp & 255u) == 0u) { if (xb_ld(&(bar)[XB_TMO])) break; if (_sp > XB_SPIN_CAP) { atomicAdd(&(bar)[XB_TMO], 1u); break; } } } } while (0)
struct XcdBarrier { unsigned* bar; unsigned x; volatile LAS unsigned* st; };
__device__ __forceinline__ XcdBarrier xcd_barrier_post(unsigned* bar, volatile LAS unsigned* st) {
    XcdBarrier b; b.bar = bar; b.x = xb_xcc_id(); b.st = st;
    if (threadIdx.x == 0) (void)xb_add(&bar[XB_XCNT(b.x)], 1u);
    return b;
}
__device__ __forceinline__ void xcd_barrier_complete(unsigned* bar, unsigned x, unsigned& nloc, unsigned& nx) {
    const unsigned G = gridDim.x * gridDim.y * gridDim.z;
    unsigned sum, cnt, mine, sp = 0u;
    for (;;) {
        sum = 0u; cnt = 0u; mine = 0u;
#pragma unroll
        for (unsigned j = 0; j < 16; ++j) { const unsigned c = xb_ld(&bar[XB_XCNT(j)]); sum += c; cnt += (c > 0u) ? 1u : 0u; mine = (j == x) ? c : mine; }
        if (sum == G) break;
        __builtin_amdgcn_s_sleep(1);
        if ((++sp & 255u) == 0u) { if (xb_ld(&bar[XB_TMO])) break; if (sp > XB_SPIN_CAP) { atomicAdd(&bar[XB_TMO], 1u); break; } }
    }
    nloc = mine > 0u ? mine : 1u; nx = cnt > 0u ? cnt : 1u;
}
__device__ __forceinline__ void xcd_barrier(const XcdBarrier& b) {
    asm volatile("s_waitcnt vmcnt(0)" ::: "memory");
    __syncthreads();
    if (threadIdx.x == 0) {
        unsigned* bar = b.bar;
        __builtin_amdgcn_s_waitcnt(0);
        unsigned nloc = b.st[0], nx = b.st[1];
        if (nloc == 0u) { xcd_barrier_complete(bar, b.x, nloc, nx); b.st[0] = nloc; b.st[1] = nx; }
        const unsigned old = xb_add(&bar[XB_XSUB(b.x)], 1u);
        const unsigned gen = old / nloc;
        if (old + 1u == (gen + 1u) * nloc) {
            __builtin_amdgcn_fence(__ATOMIC_RELEASE, "agent");
            asm volatile("s_waitcnt vmcnt(0)" ::: "memory");
            const unsigned og = xb_add(&bar[XB_TOP], 1u);
            const unsigned tg = og / nx;
            if (og + 1u == (tg + 1u) * nx) xb_add(&bar[XB_TOPGEN], 1u);
            else XB_SPIN(xb_ld(&bar[XB_TOPGEN]) == tg, bar);
            __builtin_amdgcn_fence(__ATOMIC_ACQUIRE, "agent");
            xb_add(&bar[XB_XGEN(b.x)], 1u);
            asm volatile("s_waitcnt vmcnt(0)" ::: "memory");
        } else {
            XB_SPIN(xb_ld(&bar[XB_XGEN(b.x)]) == gen, bar);
            __builtin_amdgcn_fence(__ATOMIC_ACQUIRE, "agent");
            asm volatile("s_waitcnt vmcnt(0)" ::: "memory");
        }
    }
    __syncthreads();
}

__device__ __forceinline__ void run_phase(const Params& p, int ph, LAS unsigned char* lds, int dry) {
    int tid = threadIdx.x; asm volatile("" : "+v"(tid));
    const int lane = tid & 63, wave = tid >> 6;
    int G = gridDim.x, cu = blockIdx.x; asm volatile("" : "+s"(G), "+s"(cu));
    const int gw = cu * 8 + wave, ngw = G * 8;
    unsigned char* ws = p.ws; asm volatile("" : "+s"(ws));
    float* X = p.out; asm volatile("" : "+s"(X));
    const float* xin = p.in[0]; asm volatile("" : "+s"(xin));
    bf16_t* Hb = (bf16_t*)(ws + WS_H);
    if ((PHMASK & 1) && ph == NPH - 1) {
        for (int r = gw; r < T_ALL; r += ngw) rms_row_f32(X + (size_t)r * DM, p.in[20], X + (size_t)r * DM, lane);
        return;
    }
    const int l = ph / NPL, k = ph - l * NPL;
    if ((PHMASK & 2) && k == 0) {
        const size_t oFF = (size_t)l * DM * FF, oDD = (size_t)l * DM * DM;
        constexpr int I_F = 16 * 88, I_IN = 16 * 264, I_MKV = 16 * 64, I_DD = 16 * 32;
        constexpr int NIT = 6 * I_F + I_IN + I_MKV + 4 * I_DD;
        LAS float* scr = (LAS float*)(lds + wave * 8704);
        for (int it = gw; it < NIT; it += ngw) {
            int r = it;
            if (r < I_F) { wt_item(p.in[3] + oFF, DM, FF, (bf16_t*)(ws + WS_W13A), 1, r, scr, lane); continue; } r -= I_F;
            if (r < I_F) { wt_item(p.in[4] + oFF, DM, FF, (bf16_t*)(ws + WS_W13A), 2, r, scr, lane); continue; } r -= I_F;
            if (r < I_F) { wt_item(p.in[5] + oFF, FF, DM, (bf16_t*)(ws + WS_W2A), 0, r, scr, lane); continue; } r -= I_F;
            if (r < I_F) { wt_item(p.in[17] + oFF, DM, FF, (bf16_t*)(ws + WS_W13B), 1, r, scr, lane); continue; } r -= I_F;
            if (r < I_F) { wt_item(p.in[18] + oFF, DM, FF, (bf16_t*)(ws + WS_W13B), 2, r, scr, lane); continue; } r -= I_F;
            if (r < I_F) { wt_item(p.in[19] + oFF, FF, DM, (bf16_t*)(ws + WS_W2B), 0, r, scr, lane); continue; } r -= I_F;
            if (r < I_IN) { wt_item(p.in[7] + (size_t)l * DM * INW, DM, INW, (bf16_t*)(ws + WS_WIN), 0, r, scr, lane); continue; } r -= I_IN;
            if (r < I_MKV) { wt_item(p.in[11] + (size_t)l * DM * 2048, DM, 2048, (bf16_t*)(ws + WS_WMKV), 0, r, scr, lane); continue; } r -= I_MKV;
            if (r < I_DD) { wt_item(p.in[12] + oDD, DM, DM, (bf16_t*)(ws + WS_WUP), 0, r, scr, lane); continue; } r -= I_DD;
            if (r < I_DD) { wt_item(p.in[13] + oDD, DM, DM, (bf16_t*)(ws + WS_WUP) + (size_t)DM * DM, 0, r, scr, lane); continue; } r -= I_DD;
            if (r < I_DD) { wt_item(p.in[14] + oDD, DM, DM, (bf16_t*)(ws + WS_WUP) + (size_t)2 * DM * DM, 0, r, scr, lane); continue; } r -= I_DD;
            wt_item(p.in[15] + oDD, DM, DM, (bf16_t*)(ws + WS_WO), 0, r, scr, lane);
        }
        const float* xs = (l == 0) ? xin : (const float*)X;
        for (int r = gw; r < T_ALL; r += ngw) rms_row_bf16(xs + (size_t)r * DM, p.in[2] + l * DM, Hb + (size_t)r * DM, lane);
        for (int r = gw; r < 2048; r += ngw) rms_row_bf16(p.in[1] + (size_t)r * DM, p.in[10] + l * DM, (bf16_t*)(ws + WS_MEMH) + (size_t)r * DM, lane);
        if (l == 0) {
            f32x2* tab = (f32x2*)(ws + WS_TAB);
            for (int i = cu * 512 + tid; i < SEQ * 64; i += G * 512) {
                const int pos = i >> 6, j = i & 63;
                const float inv = exp2f(-(float)j * (13.287712379549449f / 64.f));
                const float ang = (float)pos * inv;
                double rr = (double)ang * 0.15915494309189535; rr -= rint(rr);
                const float rf = (float)rr;
                tab[i] = (f32x2){__builtin_amdgcn_cosf(rf), __builtin_amdgcn_sinf(rf)};
            }
        }
        return;
    }
    if ((PHMASK & 4) && (k == 1 || k == 17)) {
        pg8::Gemm g; g.A = Hb; g.Bt = (const bf16_t*)(ws + (k == 1 ? WS_W13A : WS_W13B)); g.M = T_ALL; g.N = 2 * FF; g.K = DM; g.lda = DM; g.zoff0 = g.zoff1 = g.zoff2 = 0; g.zB = 0;
        pg8::Order S; S.init(g.M, g.N, G, cu, 1);
        pg8::EpiSwiglu E; E.U = (bf16_t*)(ws + WS_U); E.ldu = FF;
        pg8::gemm_phase(lds, g, S, E, tid);
        if ((PHMASK & 8) && k == 1) {
            pg8::Gemm g2; g2.A = (const bf16_t*)(ws + WS_MEMH); g2.Bt = (const bf16_t*)(ws + WS_WMKV); g2.M = 2048; g2.N = 2048; g2.K = DM; g2.lda = DM; g2.zoff0 = g2.zoff1 = g2.zoff2 = 0; g2.zB = 0;
            pg8::Order S2; S2.init(2048, 2048, G, (cu + 128) % G, 1);
            pg8::EpiMkv E2; E2.mk = (bf16_t*)(ws + WS_MK); E2.mvT = (bf16_t*)(ws + WS_MVT);
            pg8::gemm_phase(lds, g2, S2, E2, tid);
        }
        return;
    }
    if ((PHMASK & 16) && (k == 2 || k == 18 || k == 9 || k == 15)) {
        pg8::Gemm g; pg8::EpiResid E; g.zoff0 = g.zoff1 = g.zoff2 = 0; g.zB = 0; g.N = DM; E.ld = DM;
        if (k == 2 || k == 18) {
            g.A = (const bf16_t*)(ws + WS_U); g.Bt = (const bf16_t*)(ws + (k == 2 ? WS_W2A : WS_W2B)); g.M = T_ALL; g.K = FF; g.lda = FF;
            E.src = (l == 0 && k == 2 && !dry) ? xin : (const float*)X; E.dst = X; E.scale = dry ? 0.f : 0.5f;
        } else {
            const int half = (k == 9) ? 0 : 1;
            g.A = Hb + (size_t)half * T_HALF * DM; g.Bt = (const bf16_t*)(ws + WS_WO); g.M = T_HALF; g.K = DM; g.lda = DM;
            E.src = X + (size_t)half * T_HALF * DM; E.dst = X + (size_t)half * T_HALF * DM; E.scale = dry ? 0.f : 1.0f;
        }
        pg8::Order S; S.init(g.M, g.N, G, cu, 1);
        pg8::gemm_phase(lds, g, S, E, tid);
        return;
    }
    if ((PHMASK & 32) && (k == 3 || k == 16)) {
        const float* g3 = p.in[6]; asm volatile("" : "+s"(g3)); const float* g16 = p.in[16]; asm volatile("" : "+s"(g16));
        const float* gg = (k == 3 ? g3 : g16) + l * DM;
        for (int r = gw; r < T_ALL; r += ngw) rms_row_bf16(X + (size_t)r * DM, gg, Hb + (size_t)r * DM, lane);
        return;
    }
    const int half = (k - 4) / 6, s = (k - 4) - 6 * half;
    bf16_t* proj = (bf16_t*)(ws + WS_PROJ);
    float* states = (float*)(ws + WS_ST);
    const f32x2* tab = (const f32x2*)(ws + WS_TAB);
    if ((PHMASK & 64) && s == 0) {
        pg8::Gemm g; g.A = Hb + (size_t)half * T_HALF * DM; g.Bt = (const bf16_t*)(ws + WS_WIN); g.M = T_HALF; g.N = INW; g.K = DM; g.lda = DM; g.zoff0 = g.zoff1 = g.zoff2 = 0; g.zB = 0;
        pg8::Order S; S.init(g.M, g.N, G, cu, 1);
        pg8::EpiStore E; E.O = proj; E.ldc = INW;
        pg8::gemm_phase(lds, g, S, E, tid);
        return;
    }
    if (s == 1) {
        if (PHMASK & 128) for (int it = cu; it < 512; it += G) ret_state_item(proj, tab, states, it, lds, tid);
        if (PHMASK & 256) for (int it = cu; it < 256; it += G) swa_item(proj, p.in[9] + l * 16, it, lds, tid, dry);
        if (PHMASK & 512) for (int it = cu; it < 512; it += G) mem_item(proj, (const bf16_t*)(ws + WS_MK), (const bf16_t*)(ws + WS_MVT), half * 4, it, lds, tid, dry);
        return;
    }
    if ((PHMASK & 1024) && s == 2) { ret_scan(states, cu * 512 + tid, G * 512, dry); return; }
    if ((PHMASK & 2048) && s == 3) {
        for (int it = cu; it < 512; it += G) ret_out_item(proj, tab, states, p.in[8] + l * 1024, it, lds, tid, dry);
        return;
    }
    if ((PHMASK & 4096) && s == 4) {
        pg8::Gemm g; g.A = proj; g.Bt = (const bf16_t*)(ws + WS_WUP); g.M = T_HALF; g.N = DM; g.K = DM; g.lda = INW; g.zoff0 = C_RG; g.zoff1 = C_SQ; g.zoff2 = C_MQ; g.zB = (long)DM * DM;
        pg8::Order S; S.init(g.M, g.N, G, cu, 3);
        pg8::EpiGate E; E.Mg = Hb + (size_t)half * T_HALF * DM; E.gl = proj + C_GL; E.ldg = INW;
        pg8::gemm_phase(lds, g, S, E, tid);
        return;
    }
}

__global__ __launch_bounds__(512, 2) void mega(Params p, int ph_lo, int ph_hi) {
    extern __shared__ __attribute__((aligned(16))) unsigned char shm[];
    LAS unsigned char* lds = (LAS unsigned char*)shm;
    cg::grid_group grid = cg::this_grid();
    volatile LAS unsigned* st = (volatile LAS unsigned*)(lds + LDS_PHASE);
    if (threadIdx.x == 0) { st[0] = 0u; st[1] = 0u; st[2] = 0u; st[3] = 0u; }
    __syncthreads();
    const XcdBarrier xb = xcd_barrier_post((unsigned*)(p.ws + WS_BAR), st);
    for (int ph = ph_lo; ph < ph_hi; ++ph) {
        int nrep = 1;
#if DBL_MASK
        { const int kk = (ph == NPH - 1) ? 19 : ph % NPL; nrep += (DBL_MASK >> kk) & 1; }
#endif
        for (int rep = 0; rep < nrep; ++rep) { int dry = rep; asm volatile("" : "+s"(dry)); run_phase(p, ph, lds, dry); if (rep + 1 < nrep) __syncthreads(); }
        if (ph + 1 < ph_hi) { if (ph == ph_lo) grid.sync(); else xcd_barrier(xb); }
    }
}

extern "C" void kernel_launch(void* const* d_in, const int* in_sizes, int n_in, void* d_out, int out_size, void* d_ws, size_t ws_size, hipStream_t stream) {
    static int grid = 0;
    if (grid == 0) {
        if (n_in != 21 || out_size != T_ALL * DM || ws_size < WS_END) { fprintf(stderr, "kernel_launch: unexpected shapes (n_in %d out %d ws %zu need %zu)\n", n_in, out_size, ws_size, (size_t)WS_END); grid = -1; return; }
        int dev = 0, cus = 0, per_cu = 0;
        if (hipGetDevice(&dev) != hipSuccess || hipDeviceGetAttribute(&cus, hipDeviceAttributeMultiprocessorCount, dev) != hipSuccess) { grid = -1; return; }
        if (hipFuncSetAttribute((const void*)mega, hipFuncAttributeMaxDynamicSharedMemorySize, LDS_BYTES) != hipSuccess) { fprintf(stderr, "kernel_launch: hipFuncSetAttribute failed\n"); grid = -1; return; }
        if (hipOccupancyMaxActiveBlocksPerMultiprocessor(&per_cu, (const void*)mega, 512, LDS_BYTES) != hipSuccess || per_cu < 1) { fprintf(stderr, "kernel_launch: occupancy query says %d\n", per_cu); per_cu = 1; }
        (void)hipGetLastError();
        grid = cus;
    }
    if (grid <= 0) return;
    Params p{};
    for (int i = 0; i < 21; ++i) p.in[i] = (const float*)d_in[i];
    p.out = (float*)d_out; p.ws = (unsigned char*)d_ws;
    (void)hipMemsetAsync((unsigned char*)d_ws + WS_BAR, 0, 16384, stream);
#if MK_ONE_LAUNCH
    int lo = 0, hi = NPH;
    void* args[] = {&p, &lo, &hi};
    hipError_t e = hipLaunchCooperativeKernel((const void*)mega, dim3(grid), dim3(512), args, LDS_BYTES, stream);
    if (e != hipSuccess) fprintf(stderr, "cooperative launch failed: %s (grid %d)\n", hipGetErrorString(e), grid);
#else
    for (int ph = 0; ph < NPH; ++ph) hipLaunchKernelGGL(mega, dim3(grid), dim3(512), LDS_BYTES, stream, p, ph, ph + 1);
#endif
}
```

```cpp
#include <hip/hip_runtime.h>
#include <hip/hip_cooperative_groups.h>
#include <cstdio>
#include <cstdint>
namespace cg = cooperative_groups;

#ifndef MK_ONE_LAUNCH
#define MK_ONE_LAUNCH 1
#endif

#ifndef DBL_MASK
#define DBL_MASK 0
#endif
#ifndef PHMASK
#define PHMASK 0xffff
#endif
#define LAS __attribute__((address_space(3)))
typedef unsigned short bf16_t;
typedef short bf16x8 __attribute__((ext_vector_type(8)));
typedef short bf16x4 __attribute__((ext_vector_type(4)));
typedef float f32x4 __attribute__((ext_vector_type(4)));
typedef float f32x2 __attribute__((ext_vector_type(2)));
typedef unsigned u32x4 __attribute__((ext_vector_type(4)));
typedef unsigned u32x2 __attribute__((ext_vector_type(2)));

constexpr int T_ALL = 32768, DM = 1024, FF = 2816, INW = 8448, T_HALF = 16384, SEQ = 4096;
constexpr int C_RQ = 0, C_RK = 512, C_RV = 1024, C_RG = 2048, C_SQ = 3072, C_SK = 4096, C_SV = 4224, C_MQ = 4352, C_GL = 5376;
constexpr int LDS_PHASE = 143360, LDS_BYTES = LDS_PHASE + 16;
constexpr int NPL = 16, NPH = 2 * NPL + 1;

constexpr size_t SZ_W13 = (size_t)2 * FF * DM * 2, SZ_W2 = (size_t)DM * FF * 2;
constexpr size_t WS_W13A = 0, WS_W2A = WS_W13A + SZ_W13, WS_W13B = WS_W2A + SZ_W2, WS_W2B = WS_W13B + SZ_W13;
constexpr size_t WS_WIN = WS_W2B + SZ_W2, WS_WMKV = WS_WIN + (size_t)INW * DM * 2, WS_WUP = WS_WMKV + (size_t)2048 * DM * 2;
constexpr size_t WS_WO = WS_WUP + (size_t)3 * DM * DM * 2, WS_TAB = WS_WO + (size_t)DM * DM * 2;
constexpr size_t WS_MEMH = WS_TAB + (size_t)SEQ * 64 * 8, WS_MK = WS_MEMH + (size_t)2048 * DM * 2, WS_MVT = WS_MK + (size_t)2048 * DM * 2;
constexpr size_t WS_H = WS_MVT + (size_t)2048 * DM * 2, WS_TMP = WS_H + (size_t)T_ALL * DM * 2;
constexpr size_t WS_U = WS_TMP, WS_PROJ = WS_TMP, WS_ST = WS_PROJ + (size_t)T_HALF * INW * 2;
constexpr size_t WS_BAR = WS_ST + (size_t)512 * 32768 * 4;
constexpr size_t WS_SSQ = WS_BAR + 16384;
constexpr size_t WS_END = WS_SSQ + (size_t)3 * T_ALL * 16;
constexpr size_t WS_XB3 = WS_TMP + (size_t)192 * 1024 * 1024;

struct Params {
    const float* in[21];
    float* out;
    unsigned char* ws;
};

__device__ __forceinline__ unsigned cvt_pk_bf16(float lo, float hi) { unsigned r; asm volatile("v_cvt_pk_bf16_f32 %0, %1, %2" : "=v"(r) : "v"(lo), "v"(hi)); return r; }
__device__ __forceinline__ bf16_t f2bf(float f) { return (bf16_t)(cvt_pk_bf16(f, 0.f) & 0xffffu); }
__device__ __forceinline__ float bf2f(unsigned b) { return __uint_as_float(b << 16); }
__device__ __forceinline__ float bflo(unsigned w) { return __uint_as_float(w << 16); }
__device__ __forceinline__ float bfhi(unsigned w) { return __uint_as_float(w & 0xffff0000u); }
__device__ __forceinline__ float wave_sum(float v) {
#pragma unroll
    for (int o = 1; o < 64; o <<= 1) v += __shfl_xor(v, o);
    return v;
}
__device__ __forceinline__ f32x4 mfma16(bf16x8 a, bf16x8 b, f32x4 c) { return __builtin_amdgcn_mfma_f32_16x16x32_bf16(a, b, c, 0, 0, 0); }
__device__ __forceinline__ float sigmoidf_(float x) { return 1.0f / (1.0f + __expf(-x)); }
__device__ __forceinline__ float log2g(int h) { return h == 0 ? -0.04580368961312479f : h == 1 ? -0.02272007650008353f : h == 2 ? -0.011315313227834146f : -0.005646563141142063f; }

namespace pg8 {
constexpr int BM = 256, BK = 64, HALF = 128, HTB = HALF * BK * 2, STAGE_BYTES = 8 * HTB, NXCD = 8, WGM = 8;
__host__ __device__ __forceinline__ int lds_byte(int r, int c) { const int st = (r >> 4) * 2 + (c >> 5), rr = r & 15, cc = c & 31, ob = rr * 64 + cc * 2; return st * 1024 + (ob ^ (((ob >> 9) & 1) << 5)); }
__host__ __device__ __forceinline__ void stage_rc(int b, int& R, int& C) { const int st = b / 1024, sb = b % 1024, swz = sb ^ (((sb >> 9) & 1) << 5); R = (st >> 1) * 16 + swz / 64; C = (st & 1) * 32 + (swz % 64) / 2; }
__host__ __device__ __forceinline__ int perm32(int rho) { const int n = rho >> 4, i = rho & 15; return 8 * (i >> 2) + 4 * n + (i & 3); }

struct Unit { int pm, pn, z; };
struct Gemm { const bf16_t* A; const bf16_t* Bt; int M, N, K, lda; int zoff0, zoff1, zoff2; long zB; };

struct Order {
    int nM, nN, nwg, G, c, nZ;
    __device__ void init(int M, int N, int G_, int c_, int nZ_) { nM = M / BM; nN = N / BM; nwg = nM * nN; G = G_; c = c_; nZ = nZ_; }
    __device__ bool next(int i, Unit& u) const {
        int rnd = i, z = 0;
        if (nZ == 3) { rnd = i / 3; z = i - 3 * rnd; }
        u.z = z;
        const long L = (long)rnd * G + c; if (L >= nwg) return false;
        int wgid = (int)L; { const int q = nwg / NXCD, r = nwg % NXCD, xcd = wgid % NXCD, off = wgid / NXCD; wgid = (xcd < r ? xcd * (q + 1) : r * (q + 1) + (xcd - r) * q) + off; }
        const int nig = WGM * nN, gid = wgid / nig, fm = gid * WGM, gsz = (nM - fm) < WGM ? (nM - fm) : WGM;
        u.pm = fm + ((wgid % nig) % gsz); u.pn = (wgid % nig) / gsz; return true;
    }
};

struct EpiStore {
    static constexpr bool PERM = true;
    bf16_t* O; int ldc; const float* ssq;
    __device__ __forceinline__ void operator()(const f32x4 (&acc)[2][2][4][2], const Unit& u, int wr, int wc, int fr, int fq) const {
        const int row0 = u.pm * BM + wr * 64 + fr, col0 = u.pn * BM + wc * 32 + 8 * fq;
        f32x4 q4[2][4];
#pragma unroll
        for (int ai = 0; ai < 2; ++ai)
#pragma unroll
            for (int m = 0; m < 4; ++m) q4[ai][m] = *(const f32x4*)(ssq + (size_t)(row0 + ai * HALF + m * 16) * 4);
#pragma unroll
        for (int ai = 0; ai < 2; ++ai)
#pragma unroll
            for (int m = 0; m < 4; ++m) { bf16_t* rowp = O + (size_t)(row0 + ai * HALF + m * 16) * ldc + col0;
                const float rs = rsqrtf(((q4[ai][m].x + q4[ai][m].y) + (q4[ai][m].z + q4[ai][m].w)) * (1.f / 1024.f) + 1e-6f);
#pragma unroll
                for (int bj = 0; bj < 2; ++bj) { const f32x4 v0 = acc[ai][bj][m][0] * rs, v1 = acc[ai][bj][m][1] * rs;
                    u32x4 w; w.x = cvt_pk_bf16(v0[0], v0[1]); w.y = cvt_pk_bf16(v0[2], v0[3]); w.z = cvt_pk_bf16(v1[0], v1[1]); w.w = cvt_pk_bf16(v1[2], v1[3]);
                    *(u32x4*)(rowp + bj * HALF) = w; } }
    }
};
struct EpiSwiglu {
    static constexpr bool PERM = true;
    bf16_t* U; int ldu; const float* ssq;
    __device__ __forceinline__ void operator()(const f32x4 (&acc)[2][2][4][2], const Unit& u, int wr, int wc, int fr, int fq) const {
        const int row0 = u.pm * BM + wr * 64 + fr, col0 = u.pn * 128 + wc * 16 + 4 * fq;
        f32x4 q4[2][4];
#pragma unroll
        for (int ai = 0; ai < 2; ++ai)
#pragma unroll
            for (int m = 0; m < 4; ++m) q4[ai][m] = *(const f32x4*)(ssq + (size_t)(row0 + ai * HALF + m * 16) * 4);
#pragma unroll
        for (int ai = 0; ai < 2; ++ai)
#pragma unroll
            for (int m = 0; m < 4; ++m) { bf16_t* rowp = U + (size_t)(row0 + ai * HALF + m * 16) * ldu + col0;
                const float rs = rsqrtf(((q4[ai][m].x + q4[ai][m].y) + (q4[ai][m].z + q4[ai][m].w)) * (1.f / 1024.f) + 1e-6f);
#pragma unroll
                for (int bj = 0; bj < 2; ++bj) { const f32x4 a = acc[ai][bj][m][0] * rs, b = acc[ai][bj][m][1] * rs;
                    float r[4];
#pragma unroll
                    for (int j = 0; j < 4; ++j) r[j] = a[j] * sigmoidf_(a[j]) * b[j];
                    u32x2 w; w.x = cvt_pk_bf16(r[0], r[1]); w.y = cvt_pk_bf16(r[2], r[3]);
                    *(u32x2*)(rowp + bj * 64) = w; } }
    }
};
struct EpiResid {
    static constexpr bool PERM = false;
    const float* src; float* dst; bf16_t* xb; float* ssq; int ld; float scale; LAS float* red;
    __device__ __forceinline__ void operator()(const f32x4 (&acc)[2][2][4][2], const Unit& u, int wr, int wc, int fr, int fq) const {
        const int row0 = u.pm * BM + wr * 64 + fr, col0 = u.pn * BM + wc * 32 + 4 * fq;
#pragma unroll
        for (int ai = 0; ai < 2; ++ai)
#pragma unroll
            for (int m = 0; m < 4; ++m) { const int row = row0 + ai * HALF + m * 16; const size_t ro = (size_t)row * ld + col0; float ss = 0.f;
#pragma unroll
                for (int bj = 0; bj < 2; ++bj)
#pragma unroll
                    for (int n = 0; n < 2; ++n) { const f32x4 v = *(const f32x4*)(src + ro + bj * HALF + n * 16) + acc[ai][bj][m][n] * scale;
                        *(f32x4*)(dst + ro + bj * HALF + n * 16) = v;
                        *(u32x2*)(xb + ro + bj * HALF + n * 16) = (u32x2){cvt_pk_bf16(v[0], v[1]), cvt_pk_bf16(v[2], v[3])};
                        ss += (v[0] * v[0] + v[1] * v[1]) + (v[2] * v[2] + v[3] * v[3]); }
                ss += __shfl_xor(ss, 16); ss += __shfl_xor(ss, 32);
                if (fq == 0) red[(ai * HALF + wr * 64 + m * 16 + fr) * 4 + wc] = ss; }
        asm volatile("s_waitcnt lgkmcnt(0)" ::: "memory"); __builtin_amdgcn_s_barrier(); asm volatile("" ::: "memory");
        const int t = (wr * 4 + wc) * 64 + fq * 16 + fr;
        if (t < 256) { const f32x4 q = *(const LAS f32x4*)(red + t * 4); ssq[(size_t)(u.pm * BM + t) * 4 + u.pn] = (q.x + q.y) + (q.z + q.w); }
    }
};
struct EpiGate {
    static constexpr bool PERM = true;
    bf16_t* Mg; const bf16_t* gl; int ldg;
    __device__ __forceinline__ void operator()(const f32x4 (&acc)[2][2][4][2], const Unit& u, int wr, int wc, int fr, int fq) const {
        const int row0 = u.pm * BM + wr * 64 + fr, col0 = u.pn * BM + wc * 32 + 8 * fq;
#pragma unroll
        for (int ai = 0; ai < 2; ++ai)
#pragma unroll
            for (int m = 0; m < 4; ++m) { const int row = row0 + ai * HALF + m * 16;
                bf16_t* mp = Mg + (size_t)row * 1024 + col0; const bf16_t* gp = gl + (size_t)row * ldg + u.z * 1024 + col0;
#pragma unroll
                for (int bj = 0; bj < 2; ++bj) { const f32x4 v0 = acc[ai][bj][m][0], v1 = acc[ai][bj][m][1];
                    const u32x4 g = *(const u32x4*)(gp + bj * HALF);
                    u32x4 o = (u32x4){0u, 0u, 0u, 0u};
                    if (u.z > 0) o = *(const u32x4*)(mp + bj * HALF);
                    float r[8];
                    r[0] = bflo(o.x) + sigmoidf_(bflo(g.x)) * v0[0]; r[1] = bfhi(o.x) + sigmoidf_(bfhi(g.x)) * v0[1];
                    r[2] = bflo(o.y) + sigmoidf_(bflo(g.y)) * v0[2]; r[3] = bfhi(o.y) + sigmoidf_(bfhi(g.y)) * v0[3];
                    r[4] = bflo(o.z) + sigmoidf_(bflo(g.z)) * v1[0]; r[5] = bfhi(o.z) + sigmoidf_(bfhi(g.z)) * v1[1];
                    r[6] = bflo(o.w) + sigmoidf_(bflo(g.w)) * v1[2]; r[7] = bfhi(o.w) + sigmoidf_(bfhi(g.w)) * v1[3];
                    u32x4 w; w.x = cvt_pk_bf16(r[0], r[1]); w.y = cvt_pk_bf16(r[2], r[3]); w.z = cvt_pk_bf16(r[4], r[5]); w.w = cvt_pk_bf16(r[6], r[7]);
                    *(u32x4*)(mp + bj * HALF) = w; } }
    }
};
struct EpiMkv {
    static constexpr bool PERM = true;
    bf16_t* mk; bf16_t* mvT;
    __device__ __forceinline__ void operator()(const f32x4 (&acc)[2][2][4][2], const Unit& u, int wr, int wc, int fr, int fq) const {
        const int row0 = u.pm * BM + wr * 64 + fr, col0 = u.pn * BM + wc * 32 + 8 * fq;
#pragma unroll
        for (int ai = 0; ai < 2; ++ai)
#pragma unroll
            for (int m = 0; m < 4; ++m) { const int row = row0 + ai * HALF + m * 16;
#pragma unroll
                for (int bj = 0; bj < 2; ++bj) { const f32x4 v0 = acc[ai][bj][m][0], v1 = acc[ai][bj][m][1]; const int col = col0 + bj * HALF;
                    if (u.pn < 4) {
                        u32x4 w; w.x = cvt_pk_bf16(v0[0], v0[1]); w.y = cvt_pk_bf16(v0[2], v0[3]); w.z = cvt_pk_bf16(v1[0], v1[1]); w.w = cvt_pk_bf16(v1[2], v1[3]);
                        *(u32x4*)(mk + (size_t)row * 1024 + col) = w;
                    } else {
                        const int b = row >> 8, mem = row & 255; bf16_t* base = mvT + ((size_t)b * 1024 + (col - 1024)) * 256 + mem;
#pragma unroll
                        for (int j = 0; j < 4; ++j) { base[(size_t)j * 256] = f2bf(v0[j]); base[(size_t)(4 + j) * 256] = f2bf(v1[j]); }
                    } } }
    }
};

template <class Epi>
__device__ __forceinline__ void gemm_phase(LAS unsigned char* lds, const Gemm g, const Order& S, const Epi& E, const int tid) {
    const int wid = __builtin_amdgcn_readfirstlane(tid >> 6), lane = tid & 63, wr = wid >> 2, wc = wid & 3, fr = lane & 15, fq = lane >> 4;
    const int K = g.K, nt = K / BK, lda = g.lda;
    unsigned voffA[2], voffB[2];
#pragma unroll
    for (int i = 0; i < 2; ++i) { int R, C; stage_rc(tid * 16 + i * 8192, R, C); const int Rb = Epi::PERM ? ((R & ~31) + perm32(R & 31)) : R;
        voffA[i] = (unsigned)(R * lda + C) * 2u; voffB[i] = (unsigned)(Rb * K + C) * 2u; }
    const size_t kstep = (size_t)(BK * 2);
    const size_t hstepA = (size_t)HALF * lda * 2, hstepB = (size_t)HALF * K * 2;
    const size_t tstepA = 2 * hstepA, tstepB = 2 * hstepB;
    const unsigned ldsw = (unsigned)wid * 1024u;
    const int aoff = lds_byte(wr * 64 + fr, fq * 8), boff = lds_byte(wc * 32 + fr, fq * 8);
#define PG8_SA(b, h) (((b) * 2 + (h)) * HTB)
#define PG8_SB(b, h) ((4 + (b) * 2 + (h)) * HTB)
#define PG8_STAGE(bufoff, gbase, voff) do { _Pragma("unroll") for (int _i = 0; _i < 2; ++_i) \
        __builtin_amdgcn_global_load_lds((const unsigned*)((const char*)(gbase) + (voff)[_i]), (LAS unsigned*)(lds + (bufoff) + ldsw + _i * 8192), 16, 0, 0); } while (0)
#define PG8_LDA(dst, b, h) do { _Pragma("unroll") for (int m = 0; m < 4; ++m) _Pragma("unroll") for (int k = 0; k < 2; ++k) dst[m][k] = *(const LAS bf16x8*)(lds + PG8_SA(b, h) + aoff + m * 2048 + k * 1024); } while (0)
#define PG8_LDB(dst, b, h) do { _Pragma("unroll") for (int n = 0; n < 2; ++n) _Pragma("unroll") for (int k = 0; k < 2; ++k) dst[n][k] = *(const LAS bf16x8*)(lds + PG8_SB(b, h) + boff + n * 2048 + k * 1024); } while (0)
#define PG8_MMA(ai, bj, At, Bt) do { __builtin_amdgcn_s_setprio(1); _Pragma("unroll") for (int m = 0; m < 4; ++m) _Pragma("unroll") for (int n = 0; n < 2; ++n) _Pragma("unroll") for (int k = 0; k < 2; ++k) \
        acc[ai][bj][m][n] = __builtin_amdgcn_mfma_f32_16x16x32_bf16(Bt[n][k], At[m][k], acc[ai][bj][m][n], 0, 0, 0); __builtin_amdgcn_s_setprio(0); } while (0)
#define PG8_WAIT_V(n) asm volatile("s_waitcnt vmcnt(" #n ")" ::: "memory")
#define PG8_WAIT_L(n) asm volatile("s_waitcnt lgkmcnt(" #n ")" ::: "memory")
#define PG8_BAR __builtin_amdgcn_s_barrier()
#define PG8_SCHED __builtin_amdgcn_sched_barrier(0)
#define PG8_ABASE(u) ((const char*)g.A + (size_t)((u).z == 0 ? g.zoff0 : (u).z == 1 ? g.zoff1 : g.zoff2) * 2 + (size_t)(u).pm * tstepA)
#define PG8_BBASE(u) ((const char*)g.Bt + (size_t)((u).z * g.zB) * 2 + (size_t)(u).pn * tstepB)
    Unit cur, nxt; int ui = 0;
    if (!S.next(0, cur)) return;
    f32x4 acc[2][2][4][2];
#pragma unroll
    for (int a = 0; a < 2; ++a)
#pragma unroll
        for (int b = 0; b < 2; ++b)
#pragma unroll
            for (int m = 0; m < 4; ++m)
#pragma unroll
                for (int n = 0; n < 2; ++n) acc[a][b][m][n] = (f32x4){0.f, 0.f, 0.f, 0.f};
    bf16x8 At[4][2], B0[2][2], B1[2][2];
    const char* cA = PG8_ABASE(cur); const char* cB = PG8_BBASE(cur);
    PG8_STAGE(PG8_SB(0, 0), cB, voffB); PG8_STAGE(PG8_SB(0, 1), cB + hstepB, voffB); PG8_STAGE(PG8_SA(0, 0), cA, voffA); PG8_STAGE(PG8_SA(0, 1), cA + hstepA, voffA);
    if (wr == 1) PG8_BAR;
    PG8_WAIT_V(2); PG8_BAR;
    PG8_STAGE(PG8_SB(1, 0), cB + kstep, voffB); PG8_STAGE(PG8_SA(1, 0), cA + kstep, voffA); PG8_STAGE(PG8_SB(1, 1), cB + hstepB + kstep, voffB);
    PG8_WAIT_V(6); PG8_BAR;
    for (;;) {
        const bool has_next = S.next(ui + 1, nxt);
        const char* nA = has_next ? PG8_ABASE(nxt) : cA; const char* nB = has_next ? PG8_BBASE(nxt) : cB;
        for (int t = 0; t < nt; t += 2) {
            const bool last = (t == nt - 2);
            const char* a1 = cA + (size_t)(t + 1) * kstep;
            const char* a2 = last ? nA : cA + (size_t)(t + 2) * kstep; const char* b2 = last ? nB : cB + (size_t)(t + 2) * kstep;
            const char* a3 = a2 + kstep; const char* b3 = b2 + kstep;
            PG8_LDB(B0, 0, 0); PG8_LDB(B1, 0, 1); PG8_SCHED; PG8_LDA(At, 0, 0); PG8_STAGE(PG8_SA(1, 1), a1 + hstepA, voffA);
            PG8_WAIT_V(8); PG8_WAIT_L(0); PG8_BAR; PG8_MMA(0, 0, At, B0); PG8_MMA(0, 1, At, B1); PG8_BAR; PG8_SCHED;
            PG8_LDA(At, 0, 1); PG8_STAGE(PG8_SB(0, 0), b2, voffB); PG8_STAGE(PG8_SB(0, 1), b2 + hstepB, voffB); PG8_STAGE(PG8_SA(0, 0), a2, voffA);
            PG8_WAIT_V(8); PG8_WAIT_L(0); PG8_BAR; PG8_MMA(1, 0, At, B0); PG8_MMA(1, 1, At, B1); PG8_BAR; PG8_SCHED;
            PG8_LDB(B0, 1, 0); PG8_LDB(B1, 1, 1); PG8_SCHED; PG8_LDA(At, 1, 0); PG8_STAGE(PG8_SA(0, 1), a2 + hstepA, voffA);
            PG8_WAIT_V(8); PG8_WAIT_L(0); PG8_BAR; PG8_MMA(0, 0, At, B0); PG8_MMA(0, 1, At, B1); PG8_BAR; PG8_SCHED;
            PG8_LDA(At, 1, 1); PG8_STAGE(PG8_SB(1, 0), b3, voffB); PG8_STAGE(PG8_SB(1, 1), b3 + hstepB, voffB); PG8_STAGE(PG8_SA(1, 0), a3, voffA);
            PG8_WAIT_V(8); PG8_WAIT_L(0); PG8_BAR; PG8_MMA(1, 0, At, B0); PG8_MMA(1, 1, At, B1); PG8_BAR; PG8_SCHED;
        }
        if (wr == 0) PG8_BAR;
        E(acc, cur, wr, wc, fr, fq);
        if (!has_next) break;
#pragma unroll
        for (int a = 0; a < 2; ++a)
#pragma unroll
            for (int b = 0; b < 2; ++b)
#pragma unroll
                for (int m = 0; m < 4; ++m)
#pragma unroll
                    for (int n = 0; n < 2; ++n) acc[a][b][m][n] = (f32x4){0.f, 0.f, 0.f, 0.f};
        cur = nxt; cA = nA; cB = nB; ++ui;
        if (wr == 1) PG8_BAR;
    }
    PG8_WAIT_V(0);
    PG8_BAR;
#undef PG8_SA
#undef PG8_SB
#undef PG8_STAGE
#undef PG8_LDA
#undef PG8_LDB
#undef PG8_MMA
#undef PG8_WAIT_V
#undef PG8_WAIT_L
#undef PG8_BAR
#undef PG8_SCHED
#undef PG8_ABASE
#undef PG8_BBASE
}
}

__device__ __forceinline__ void rms_row_bf16(const float* xrow, const float* g, bf16_t* orow, int lane) {
    const f32x4* xr = (const f32x4*)xrow + lane; const f32x4* gr = (const f32x4*)g + lane;
    f32x4 v[4]; float s = 0.f;
#pragma unroll
    for (int j = 0; j < 4; ++j) { v[j] = xr[64 * j]; s += (v[j].x * v[j].x + v[j].y * v[j].y) + (v[j].z * v[j].z + v[j].w * v[j].w); }
    const float rstd = rsqrtf(wave_sum(s) * (1.f / 1024.f) + 1e-6f);
    u32x2* o8 = (u32x2*)orow + lane;
#pragma unroll
    for (int j = 0; j < 4; ++j) { const f32x4 gg = gr[64 * j]; u32x2 w; w.x = cvt_pk_bf16(v[j].x * rstd * gg.x, v[j].y * rstd * gg.y); w.y = cvt_pk_bf16(v[j].z * rstd * gg.z, v[j].w * rstd * gg.w); o8[64 * j] = w; }
}
__device__ __forceinline__ void rms_row_f32(const float* xrow, const float* g, float* orow, int lane) {
    const f32x4* xr = (const f32x4*)xrow + lane; const f32x4* gr = (const f32x4*)g + lane;
    f32x4 v[4]; float s = 0.f;
#pragma unroll
    for (int j = 0; j < 4; ++j) { v[j] = xr[64 * j]; s += (v[j].x * v[j].x + v[j].y * v[j].y) + (v[j].z * v[j].z + v[j].w * v[j].w); }
    const float rstd = rsqrtf(wave_sum(s) * (1.f / 1024.f) + 1e-6f);
    f32x4* o = (f32x4*)orow + lane;
#pragma unroll
    for (int j = 0; j < 4; ++j) { const f32x4 gg = gr[64 * j]; o[64 * j] = v[j] * rstd * gg; }
}

__device__ __forceinline__ void wt_item(const float* W, int K, int N, bf16_t* WT, int mode, int item, LAS float* scr, int lane, const float* gain) {
    const int nblk = N >> 5, kb = item / nblk, nb = item - kb * nblk, k0 = kb * 64, n0 = nb * 32;
#pragma unroll 16
    for (int i = 0; i < 32; ++i) { const int kk = 2 * i + (lane >> 5); scr[kk * 33 + (lane & 31)] = W[(size_t)(k0 + kk) * N + n0 + (lane & 31)]; }
    asm volatile("s_waitcnt lgkmcnt(0)" ::: "memory");
    const int c = lane & 7;
    f32x4 ga = (f32x4){1.f, 1.f, 1.f, 1.f}, gb = ga;
    if (gain) { ga = *(const f32x4*)(gain + k0 + 8 * c); gb = *(const f32x4*)(gain + k0 + 8 * c + 4); }
#pragma unroll
    for (int j = 0; j < 4; ++j) { const int n = (lane >> 3) + 8 * j, sn = n0 + n; const LAS float* q = scr + (8 * c) * 33 + n;
        const int dr = mode == 0 ? sn : (8 * (sn >> 2) + (sn & 3) + (mode == 2 ? 4 : 0));
        u32x4 o; o.x = cvt_pk_bf16(q[0 * 33] * ga.x, q[1 * 33] * ga.y); o.y = cvt_pk_bf16(q[2 * 33] * ga.z, q[3 * 33] * ga.w); o.z = cvt_pk_bf16(q[4 * 33] * gb.x, q[5 * 33] * gb.y); o.w = cvt_pk_bf16(q[6 * 33] * gb.z, q[7 * 33] * gb.w);
        *(u32x4*)(WT + (size_t)dr * K + k0 + 8 * c) = o; }
    asm volatile("s_waitcnt lgkmcnt(0)" ::: "memory");
}

__device__ __forceinline__ void rot16(const bf16_t* row, const f32x2* tabrow, int jg, float sc, unsigned (&y1)[8], unsigned (&y2)[8]) {
    const u32x4 a0 = *(const u32x4*)(row + jg * 16), a1 = *(const u32x4*)(row + jg * 16 + 8);
    const u32x4 b0 = *(const u32x4*)(row + 64 + jg * 16), b1 = *(const u32x4*)(row + 64 + jg * 16 + 8);
    const unsigned aw[8] = {a0.x, a0.y, a0.z, a0.w, a1.x, a1.y, a1.z, a1.w};
    const unsigned bw[8] = {b0.x, b0.y, b0.z, b0.w, b1.x, b1.y, b1.z, b1.w};
    const f32x4* tp = (const f32x4*)(tabrow + jg * 16);
#pragma unroll
    for (int i = 0; i < 8; ++i) {
        const f32x4 cs = tp[i];
        const float x1a = bflo(aw[i]), x1b = bfhi(aw[i]), x2a = bflo(bw[i]), x2b = bfhi(bw[i]);
        y1[i] = cvt_pk_bf16((x1a * cs.x - x2a * cs.y) * sc, (x1b * cs.z - x2b * cs.w) * sc);
        y2[i] = cvt_pk_bf16((x1a * cs.y + x2a * cs.x) * sc, (x1b * cs.w + x2b * cs.z) * sc);
    }
}

constexpr int RP = 136;

__device__ __forceinline__ void ret_state_item(const bf16_t* proj, const f32x2* tab, float* states, int item, LAS unsigned char* lds, int tid) {
    const int wave = tid >> 6, lane = tid & 63, fr = lane & 15, fq = lane >> 4;
    const int h = item & 3, n = (item >> 2) & 31, bl = item >> 7;
    const size_t tok0 = (size_t)bl * SEQ + n * 128;
    LAS bf16_t* KT = (LAS bf16_t*)lds;
    LAS bf16_t* VT = (LAS bf16_t*)(lds + 128 * RP * 2);
    const float lg = log2g(h);
    {
        const int c = tid >> 2, jg = tid & 3;
        const bf16_t* row = proj + (tok0 + c) * INW + C_RK + h * 128;
        unsigned y1[8], y2[8];
        rot16(row, tab + (size_t)(n * 128 + c) * 64, jg, 0.08838834764831845f * exp2f(-(float)(c + 1) * lg), y1, y2);
#pragma unroll
        for (int i = 0; i < 8; ++i) {
            const int j = jg * 16 + 2 * i;
            KT[(j) * RP + c] = (bf16_t)(y1[i] & 0xffffu); KT[(j + 1) * RP + c] = (bf16_t)(y1[i] >> 16);
            KT[(j + 64) * RP + c] = (bf16_t)(y2[i] & 0xffffu); KT[(j + 65) * RP + c] = (bf16_t)(y2[i] >> 16);
        }
        const bf16_t* vrow = proj + (tok0 + c) * INW + C_RV + h * 256 + jg * 64;
#pragma unroll
        for (int i = 0; i < 8; ++i) {
            const u32x4 v = *(const u32x4*)(vrow + i * 8);
            const unsigned vw[4] = {v.x, v.y, v.z, v.w};
#pragma unroll
            for (int k = 0; k < 4; ++k) { const int e = jg * 64 + i * 8 + 2 * k; VT[e * RP + c] = (bf16_t)(vw[k] & 0xffffu); VT[(e + 1) * RP + c] = (bf16_t)(vw[k] >> 16); }
        }
    }
    __syncthreads();
    f32x4 acc[8][2];
#pragma unroll
    for (int dt = 0; dt < 8; ++dt) { acc[dt][0] = (f32x4){0.f, 0.f, 0.f, 0.f}; acc[dt][1] = (f32x4){0.f, 0.f, 0.f, 0.f}; }
#pragma unroll
    for (int ks = 0; ks < 4; ++ks) {
        bf16x8 bfr[2];
#pragma unroll
        for (int et = 0; et < 2; ++et) bfr[et] = *(const LAS bf16x8*)(VT + (32 * wave + 16 * et + fr) * RP + 32 * ks + 8 * fq);
#pragma unroll
        for (int dt = 0; dt < 8; ++dt) {
            const bf16x8 a = *(const LAS bf16x8*)(KT + (16 * dt + fr) * RP + 32 * ks + 8 * fq);
            acc[dt][0] = mfma16(a, bfr[0], acc[dt][0]); acc[dt][1] = mfma16(a, bfr[1], acc[dt][1]);
        }
    }
    const float gch = exp2f(128.f * lg);
    float* sp = states + (size_t)item * 32768;
#pragma unroll
    for (int et = 0; et < 2; ++et)
#pragma unroll
        for (int dt = 0; dt < 8; ++dt) *(f32x4*)(sp + (size_t)(32 * wave + 16 * et + fr) * 128 + 16 * dt + 4 * fq) = acc[dt][et] * gch;
    __syncthreads();
}

__device__ __forceinline__ void ret_scan(float* states, int gtid, int nthreads, int dry) {
    for (int i = gtid; i < 16 * 8192; i += nthreads) {
        const int bh = i >> 13, off = i & 8191, bl = bh >> 2, h = bh & 3;
        const float g = exp2f(128.f * log2g(h));
        f32x4* p = (f32x4*)(states + ((size_t)(bl * 32) * 4 + h) * 32768) + off;
        f32x4 R = (f32x4){0.f, 0.f, 0.f, 0.f};
        for (int n0 = 0; n0 < 32; n0 += 8) {
            f32x4 s[8];
#pragma unroll
            for (int k = 0; k < 8; ++k) s[k] = p[(size_t)(n0 + k) * 32768];
#pragma unroll
            for (int k = 0; k < 8; ++k) { if (!dry) p[(size_t)(n0 + k) * 32768] = R; R = R * g + s[k]; }
        }
    }
}

__device__ __forceinline__ void ret_out_item(bf16_t* proj, const f32x2* tab, const float* states, const float* gn, int item, LAS unsigned char* lds, int tid, int dry) {
    const int wave = tid >> 6, lane = tid & 63, fr = lane & 15, fq = lane >> 4;
    const int h = item & 3, n = (item >> 2) & 31, bl = item >> 7;
    const size_t tok0 = (size_t)bl * SEQ + n * 128;
    LAS bf16_t* QS = (LAS bf16_t*)lds;
    LAS bf16_t* KS = (LAS bf16_t*)(lds + 128 * RP * 2);
    LAS bf16_t* VT = (LAS bf16_t*)(lds + 2 * 128 * RP * 2);
    LAS float* red = (LAS float*)(lds + 4 * 128 * RP * 2);
    const float lg = log2g(h);
    {
        const int c = tid >> 2, jg = tid & 3;
        const f32x2* tr = tab + (size_t)(n * 128 + c) * 64;
        unsigned y1[8], y2[8];
        rot16(proj + (tok0 + c) * INW + C_RQ + h * 128, tr, jg, exp2f((float)(c + 1) * lg), y1, y2);
        *(LAS u32x4*)(QS + c * RP + jg * 16) = (u32x4){y1[0], y1[1], y1[2], y1[3]}; *(LAS u32x4*)(QS + c * RP + jg * 16 + 8) = (u32x4){y1[4], y1[5], y1[6], y1[7]};
        *(LAS u32x4*)(QS + c * RP + 64 + jg * 16) = (u32x4){y2[0], y2[1], y2[2], y2[3]}; *(LAS u32x4*)(QS + c * RP + 64 + jg * 16 + 8) = (u32x4){y2[4], y2[5], y2[6], y2[7]};
        rot16(proj + (tok0 + c) * INW + C_RK + h * 128, tr, jg, 0.08838834764831845f * exp2f(-(float)(c + 1) * lg), y1, y2);
        *(LAS u32x4*)(KS + c * RP + jg * 16) = (u32x4){y1[0], y1[1], y1[2], y1[3]}; *(LAS u32x4*)(KS + c * RP + jg * 16 + 8) = (u32x4){y1[4], y1[5], y1[6], y1[7]};
        *(LAS u32x4*)(KS + c * RP + 64 + jg * 16) = (u32x4){y2[0], y2[1], y2[2], y2[3]}; *(LAS u32x4*)(KS + c * RP + 64 + jg * 16 + 8) = (u32x4){y2[4], y2[5], y2[6], y2[7]};
        const bf16_t* vrow = proj + (tok0 + c) * INW + C_RV + h * 256 + jg * 64;
#pragma unroll
        for (int i = 0; i < 8; ++i) {
            const u32x4 v = *(const u32x4*)(vrow + i * 8);
            const unsigned vw[4] = {v.x, v.y, v.z, v.w};
#pragma unroll
            for (int k = 0; k < 4; ++k) { const int e = jg * 64 + i * 8 + 2 * k; VT[e * RP + c] = (bf16_t)(vw[k] & 0xffffu); VT[(e + 1) * RP + c] = (bf16_t)(vw[k] >> 16); }
        }
    }
    __syncthreads();
    unsigned pk[8][2];
    {
        f32x4 pacc[8];
#pragma unroll
        for (int st = 0; st < 8; ++st) pacc[st] = (f32x4){0.f, 0.f, 0.f, 0.f};
#pragma unroll
        for (int ks = 0; ks < 4; ++ks) {
            const bf16x8 b = *(const LAS bf16x8*)(QS + (16 * wave + fr) * RP + 32 * ks + 8 * fq);
#pragma unroll
            for (int st = 0; st < 8; ++st) { const bf16x8 a = *(const LAS bf16x8*)(KS + (16 * st + fr) * RP + 32 * ks + 8 * fq); pacc[st] = mfma16(a, b, pacc[st]); }
        }
        const int c = 16 * wave + fr;
#pragma unroll
        for (int st = 0; st < 8; ++st) { float v[4];
#pragma unroll
            for (int j = 0; j < 4; ++j) { const int s = 16 * st + 4 * fq + j; v[j] = (s <= c) ? pacc[st][j] : 0.f; }
            pk[st][0] = cvt_pk_bf16(v[0], v[1]); pk[st][1] = cvt_pk_bf16(v[2], v[3]); }
    }
    __syncthreads();
    {
        const int c = 16 * wave + fr;
#pragma unroll
        for (int st = 0; st < 8; ++st) *(LAS u32x2*)(KS + c * RP + 16 * st + 4 * fq) = (u32x2){pk[st][0], pk[st][1]};
    }
    __syncthreads();
    f32x4 acc[2][8];
#pragma unroll
    for (int et = 0; et < 2; ++et)
#pragma unroll
        for (int ct = 0; ct < 8; ++ct) acc[et][ct] = (f32x4){0.f, 0.f, 0.f, 0.f};
    const float* sp = states + (size_t)item * 32768;
#pragma unroll
    for (int ks = 0; ks < 4; ++ks) {
        bf16x8 av[2], ar[2];
#pragma unroll
        for (int et = 0; et < 2; ++et) {
            const int e = 32 * wave + 16 * et + fr;
            av[et] = *(const LAS bf16x8*)(VT + e * RP + 32 * ks + 8 * fq);
            const f32x4 r0 = *(const f32x4*)(sp + (size_t)e * 128 + 32 * ks + 8 * fq), r1 = *(const f32x4*)(sp + (size_t)e * 128 + 32 * ks + 8 * fq + 4);
            u32x4 w; w.x = cvt_pk_bf16(r0.x, r0.y); w.y = cvt_pk_bf16(r0.z, r0.w); w.z = cvt_pk_bf16(r1.x, r1.y); w.w = cvt_pk_bf16(r1.z, r1.w);
            ar[et] = __builtin_bit_cast(bf16x8, w);
        }
#pragma unroll
        for (int ct = 0; ct < 8; ++ct) {
            const bf16x8 bp = *(const LAS bf16x8*)(KS + (16 * ct + fr) * RP + 32 * ks + 8 * fq);
            const bf16x8 bq = *(const LAS bf16x8*)(QS + (16 * ct + fr) * RP + 32 * ks + 8 * fq);
#pragma unroll
            for (int et = 0; et < 2; ++et) { acc[et][ct] = mfma16(av[et], bp, acc[et][ct]); acc[et][ct] = mfma16(ar[et], bq, acc[et][ct]); }
        }
    }
#pragma unroll
    for (int ct = 0; ct < 8; ++ct) {
        float s = 0.f;
#pragma unroll
        for (int et = 0; et < 2; ++et) s += (acc[et][ct][0] * acc[et][ct][0] + acc[et][ct][1] * acc[et][ct][1]) + (acc[et][ct][2] * acc[et][ct][2] + acc[et][ct][3] * acc[et][ct][3]);
        s += __shfl_xor(s, 16); s += __shfl_xor(s, 32);
        if (fq == 0) red[wave * 128 + 16 * ct + fr] = s;
    }
    __syncthreads();
#pragma unroll
    for (int ct = 0; ct < 8; ++ct) {
        const int c = 16 * ct + fr;
        float s = 0.f;
#pragma unroll
        for (int w = 0; w < 8; ++w) s += red[w * 128 + c];
        const float rstd = rsqrtf(s * (1.f / 256.f) + 1e-6f);
        bf16_t* grow = proj + (tok0 + c) * INW + C_RG + h * 256;
#pragma unroll
        for (int et = 0; et < 2; ++et) {
            const int e = 32 * wave + 16 * et + 4 * fq;
            const u32x2 gw = *(const u32x2*)(grow + e);
            const f32x4 gg = *(const f32x4*)(gn + h * 256 + e);
            const float g0 = bflo(gw.x), g1 = bfhi(gw.x), g2 = bflo(gw.y), g3 = bfhi(gw.y);
            const float o0 = acc[et][ct][0] * rstd * gg.x * g0 * sigmoidf_(g0), o1 = acc[et][ct][1] * rstd * gg.y * g1 * sigmoidf_(g1);
            const float o2 = acc[et][ct][2] * rstd * gg.z * g2 * sigmoidf_(g2), o3 = acc[et][ct][3] * rstd * gg.w * g3 * sigmoidf_(g3);
            if (!dry) *(u32x2*)(grow + e) = (u32x2){cvt_pk_bf16(o0, o1), cvt_pk_bf16(o2, o3)};
        }
    }
    __syncthreads();
}

constexpr int SKP = 72, SVP = 264;
__device__ __forceinline__ void swa_item(bf16_t* proj, const float* sinks, int item, LAS unsigned char* lds, int tid, int dry) {
    const int wave = tid >> 6, lane = tid & 63, fr = lane & 15, fq = lane >> 4;
    const int kh = item & 1, n = (item >> 1) & 31, bl = item >> 6;
    const size_t tok0 = (size_t)bl * SEQ + n * 128;
    LAS bf16_t* Ks = (LAS bf16_t*)lds;
    LAS bf16_t* Vt = (LAS bf16_t*)(lds + 256 * SKP * 2);
#pragma unroll
    for (int i = 0; i < 4; ++i) {
        const int ch = tid + 512 * i, key = ch >> 3, part = ch & 7;
        u32x4 kv = (u32x4){0u, 0u, 0u, 0u}, vv = (u32x4){0u, 0u, 0u, 0u};
        if (n > 0 || key >= 128) { const bf16_t* r = proj + (tok0 + key - 128) * INW; kv = *(const u32x4*)(r + C_SK + kh * 64 + part * 8); vv = *(const u32x4*)(r + C_SV + kh * 64 + part * 8); }
        *(LAS u32x4*)(Ks + key * SKP + part * 8) = kv;
        const unsigned vw[4] = {vv.x, vv.y, vv.z, vv.w};
#pragma unroll
        for (int k = 0; k < 4; ++k) { const int d = part * 8 + 2 * k; Vt[d * SVP + key] = (bf16_t)(vw[k] & 0xffffu); Vt[(d + 1) * SVP + key] = (bf16_t)(vw[k] >> 16); }
    }
    __syncthreads();
    const int h = kh * 8 + wave; const float sink = sinks[h];
    for (int qt = 0; qt < 8; ++qt) {
        bf16_t* qrow = proj + (tok0 + 16 * qt + fr) * INW + C_SQ + h * 64;
        bf16x8 qf[2];
        qf[0] = *(const bf16x8*)(qrow + 8 * fq); qf[1] = *(const bf16x8*)(qrow + 32 + 8 * fq);
        f32x4 s[10];
#pragma unroll
        for (int r = 0; r < 9; ++r) { s[r] = (f32x4){0.f, 0.f, 0.f, 0.f};
#pragma unroll
            for (int ks = 0; ks < 2; ++ks) { const bf16x8 a = *(const LAS bf16x8*)(Ks + (16 * (qt + r) + fr) * SKP + 32 * ks + 8 * fq); s[r] = mfma16(a, qf[ks], s[r]); } }
        s[9] = (f32x4){0.f, 0.f, 0.f, 0.f};
        const int c = 16 * qt + fr; float mx = sink;
#pragma unroll
        for (int r = 0; r < 9; ++r) {
            const bool tile_ok = (n > 0) || (qt + r >= 8);
#pragma unroll
            for (int j = 0; j < 4; ++j) { const int kpos = 16 * (qt + r) + 4 * fq + j;
                bool valid = tile_ok;
                if (r == 0) valid = valid && (kpos > c);
                if (r == 8) valid = valid && (kpos <= c + 128);
                const float v = valid ? s[r][j] * 0.125f : -1e30f; s[r][j] = v; mx = fmaxf(mx, v); } }
        mx = fmaxf(mx, __shfl_xor(mx, 16)); mx = fmaxf(mx, __shfl_xor(mx, 32));
        float sum = 0.f;
#pragma unroll
        for (int r = 0; r < 9; ++r)
#pragma unroll
            for (int j = 0; j < 4; ++j) { const float pv = __expf(s[r][j] - mx); s[r][j] = pv; sum += pv; }
        sum += __shfl_xor(sum, 16); sum += __shfl_xor(sum, 32);
        sum += __expf(sink - mx);
        const float inv = 1.0f / sum;
        f32x4 o[4];
#pragma unroll
        for (int dt = 0; dt < 4; ++dt) o[dt] = (f32x4){0.f, 0.f, 0.f, 0.f};
#pragma unroll
        for (int k2 = 0; k2 < 5; ++k2) {
            u32x4 pw; pw.x = cvt_pk_bf16(s[2 * k2][0], s[2 * k2][1]); pw.y = cvt_pk_bf16(s[2 * k2][2], s[2 * k2][3]); pw.z = cvt_pk_bf16(s[2 * k2 + 1][0], s[2 * k2 + 1][1]); pw.w = cvt_pk_bf16(s[2 * k2 + 1][2], s[2 * k2 + 1][3]);
            const bf16x8 pf = __builtin_bit_cast(bf16x8, pw);
            const int kb = 16 * (qt + 2 * k2);
#pragma unroll
            for (int dt = 0; dt < 4; ++dt) {
                const u32x2 v0 = *(const LAS u32x2*)(Vt + (16 * dt + fr) * SVP + kb + 4 * fq), v1 = *(const LAS u32x2*)(Vt + (16 * dt + fr) * SVP + kb + (k2 == 4 ? 0 : 16) + 4 * fq);
                const bf16x8 a = __builtin_bit_cast(bf16x8, ((u32x4){v0.x, v0.y, v1.x, v1.y}));
                o[dt] = mfma16(a, pf, o[dt]);
            }
        }
#pragma unroll
        for (int dt = 0; dt < 4; ++dt) if (!dry) *(u32x2*)(qrow + 16 * dt + 4 * fq) = (u32x2){cvt_pk_bf16(o[dt][0] * inv, o[dt][1] * inv), cvt_pk_bf16(o[dt][2] * inv, o[dt][3] * inv)};
    }
    __syncthreads();
}

constexpr int MP = 264;
__device__ __forceinline__ void mem_item(bf16_t* proj, const bf16_t* mk, const bf16_t* mvT, int bglob0, int item, LAS unsigned char* lds, int tid, int dry) {
    const int wave = tid >> 6, lane = tid & 63, fr = lane & 15, fq = lane >> 4;
    const int qt = item & 31, h = (item >> 5) & 3, bl = item >> 7, b = bglob0 + bl;
    const size_t tok0 = (size_t)bl * SEQ + qt * 128;
    LAS bf16_t* Ms = (LAS bf16_t*)lds;
    {
        const bf16_t* src = mk + (size_t)b * 256 * 1024 + h * 256;
#pragma unroll 4
        for (int i = 0; i < 16; ++i) { const int ch = tid + 512 * i, row = ch >> 5, part = ch & 31; *(LAS u32x4*)(Ms + row * MP + part * 8) = *(const u32x4*)(src + (size_t)row * 1024 + part * 8); }
    }
    bf16_t* qrow = proj + (tok0 + 16 * wave + fr) * INW + C_MQ + h * 256;
    bf16x8 qf[8];
#pragma unroll
    for (int ks = 0; ks < 8; ++ks) qf[ks] = *(const bf16x8*)(qrow + 32 * ks + 8 * fq);
    __syncthreads();
    f32x4 s[16];
#pragma unroll
    for (int t = 0; t < 16; ++t) { s[t] = (f32x4){0.f, 0.f, 0.f, 0.f};
#pragma unroll
        for (int ks = 0; ks < 8; ++ks) { const bf16x8 a = *(const LAS bf16x8*)(Ms + (16 * t + fr) * MP + 32 * ks + 8 * fq); s[t] = mfma16(a, qf[ks], s[t]); } }
    float mx = -1e30f;
#pragma unroll
    for (int t = 0; t < 16; ++t)
#pragma unroll
        for (int j = 0; j < 4; ++j) { const float v = s[t][j] * 0.0625f; s[t][j] = v; mx = fmaxf(mx, v); }
    mx = fmaxf(mx, __shfl_xor(mx, 16)); mx = fmaxf(mx, __shfl_xor(mx, 32));
    float sum = 0.f;
#pragma unroll
    for (int t = 0; t < 16; ++t)
#pragma unroll
        for (int j = 0; j < 4; ++j) { const float pv = __expf(s[t][j] - mx); s[t][j] = pv; sum += pv; }
    sum += __shfl_xor(sum, 16); sum += __shfl_xor(sum, 32);
    const float inv = 1.0f / sum;
    bf16x8 pf[8];
#pragma unroll
    for (int k2 = 0; k2 < 8; ++k2) { u32x4 pw; pw.x = cvt_pk_bf16(s[2 * k2][0], s[2 * k2][1]); pw.y = cvt_pk_bf16(s[2 * k2][2], s[2 * k2][3]); pw.z = cvt_pk_bf16(s[2 * k2 + 1][0], s[2 * k2 + 1][1]); pw.w = cvt_pk_bf16(s[2 * k2 + 1][2], s[2 * k2 + 1][3]);
        pf[k2] = __builtin_bit_cast(bf16x8, pw); }
    __syncthreads();
    {
        const bf16_t* src = mvT + ((size_t)b * 1024 + h * 256) * 256;
#pragma unroll 4
        for (int i = 0; i < 16; ++i) { const int ch = tid + 512 * i, row = ch >> 5, part = ch & 31; *(LAS u32x4*)(Ms + row * MP + part * 8) = *(const u32x4*)(src + (size_t)row * 256 + part * 8); }
    }
    __syncthreads();
#pragma unroll
    for (int dt = 0; dt < 16; ++dt) {
        f32x4 o = (f32x4){0.f, 0.f, 0.f, 0.f};
#pragma unroll
        for (int k2 = 0; k2 < 8; ++k2) {
            const u32x2 v0 = *(const LAS u32x2*)(Ms + (16 * dt + fr) * MP + 32 * k2 + 4 * fq), v1 = *(const LAS u32x2*)(Ms + (16 * dt + fr) * MP + 32 * k2 + 16 + 4 * fq);
            const bf16x8 a = __builtin_bit_cast(bf16x8, ((u32x4){v0.x, v0.y, v1.x, v1.y}));
            o = mfma16(a, pf[k2], o);
        }
        if (!dry) *(u32x2*)(qrow + 16 * dt + 4 * fq) = (u32x2){cvt_pk_bf16(o[0] * inv, o[1] * inv), cvt_pk_bf16(o[2] * inv, o[3] * inv)};
    }
    __syncthreads();
}


#define XB_TMO      128
#define XB_XCNT(j)  (256  + 64 * (j))
#define XB_XSUB(j)  (1280 + 64 * (j))
#define XB_XGEN(j)  (2304 + 64 * (j))
#define XB_TOP      3328
#define XB_TOPGEN   3392
#define XCD_BAR_WORDS 3456
#define XB_SPIN_CAP (1u << 18)
__device__ __forceinline__ unsigned xb_ld(unsigned* p)              { return __hip_atomic_load(p, __ATOMIC_RELAXED, __HIP_MEMORY_SCOPE_AGENT); }
__device__ __forceinline__ unsigned xb_add(unsigned* p, unsigned v) { return __hip_atomic_fetch_add(p, v, __ATOMIC_RELAXED, __HIP_MEMORY_SCOPE_AGENT); }
__device__ __forceinline__ unsigned xb_xcc_id() { return (unsigned)__builtin_amdgcn_s_getreg((3 << 11) | 20) & 0xFu; }
#define XB_SPIN(cond, bar) do { unsigned _sp = 0; while (cond) { __builtin_amdgcn_s_sleep(1); \
    if ((++_sp & 255u) == 0u) { if (xb_ld(&(bar)[XB_TMO])) break; if (_sp > XB_SPIN_CAP) { atomicAdd(&(bar)[XB_TMO], 1u); break; } } } } while (0)
struct XcdBarrier { unsigned* bar; unsigned x; volatile LAS unsigned* st; };
__device__ __forceinline__ XcdBarrier xcd_barrier_post(unsigned* bar, volatile LAS unsigned* st) {
    XcdBarrier b; b.bar = bar; b.x = xb_xcc_id(); b.st = st;
    if (threadIdx.x == 0) (void)xb_add(&bar[XB_XCNT(b.x)], 1u);
    return b;
}
__device__ __forceinline__ void xcd_barrier_complete(unsigned* bar, unsigned x, unsigned& nloc, unsigned& nx) {
    const unsigned G = gridDim.x * gridDim.y * gridDim.z;
    unsigned sum, cnt, mine, sp = 0u;
    for (;;) {
        sum = 0u; cnt = 0u; mine = 0u;
#pragma unroll
        for (unsigned j = 0; j < 16; ++j) { const unsigned c = xb_ld(&bar[XB_XCNT(j)]); sum += c; cnt += (c > 0u) ? 1u : 0u; mine = (j == x) ? c : mine; }
        if (sum == G) break;
        __builtin_amdgcn_s_sleep(1);
        if ((++sp & 255u) == 0u) { if (xb_ld(&bar[XB_TMO])) break; if (sp > XB_SPIN_CAP) { atomicAdd(&bar[XB_TMO], 1u); break; } }
    }
    nloc = mine > 0u ? mine : 1u; nx = cnt > 0u ? cnt : 1u;
}
__device__ __forceinline__ void xcd_barrier(const XcdBarrier& b) {
    asm volatile("s_waitcnt vmcnt(0)" ::: "memory");
    __syncthreads();
    if (threadIdx.x == 0) {
        unsigned* bar = b.bar;
        __builtin_amdgcn_s_waitcnt(0);
        unsigned nloc = b.st[0], nx = b.st[1];
        if (nloc == 0u) { xcd_barrier_complete(bar, b.x, nloc, nx); b.st[0] = nloc; b.st[1] = nx; }
        const unsigned old = xb_add(&bar[XB_XSUB(b.x)], 1u);
        const unsigned gen = old / nloc;
        if (old + 1u == (gen + 1u) * nloc) {
            __builtin_amdgcn_fence(__ATOMIC_RELEASE, "agent");
            asm volatile("s_waitcnt vmcnt(0)" ::: "memory");
            const unsigned og = xb_add(&bar[XB_TOP], 1u);
            const unsigned tg = og / nx;
            if (og + 1u == (tg + 1u) * nx) xb_add(&bar[XB_TOPGEN], 1u);
            else XB_SPIN(xb_ld(&bar[XB_TOPGEN]) == tg, bar);
            __builtin_amdgcn_fence(__ATOMIC_ACQUIRE, "agent");
            xb_add(&bar[XB_XGEN(b.x)], 1u);
            asm volatile("s_waitcnt vmcnt(0)" ::: "memory");
        } else {
            XB_SPIN(xb_ld(&bar[XB_XGEN(b.x)]) == gen, bar);
            __builtin_amdgcn_fence(__ATOMIC_ACQUIRE, "agent");
            asm volatile("s_waitcnt vmcnt(0)" ::: "memory");
        }
    }
    __syncthreads();
}

__device__ __forceinline__ void run_phase(const Params& p, int ph, LAS unsigned char* lds, int dry) {
    int tid = threadIdx.x; asm volatile("" : "+v"(tid));
    const int lane = tid & 63, wave = tid >> 6;
    int G = gridDim.x, cu = blockIdx.x; asm volatile("" : "+s"(G), "+s"(cu));
    const int gw = cu * 8 + wave, ngw = G * 8;
    unsigned char* ws = p.ws; asm volatile("" : "+s"(ws));
    float* X = p.out; asm volatile("" : "+s"(X));
    const float* xin = p.in[0]; asm volatile("" : "+s"(xin));
    bf16_t* Hb = (bf16_t*)(ws + WS_H);
    if ((PHMASK & 1) && ph == NPH - 1) {
        for (int r = gw; r < T_ALL; r += ngw) rms_row_f32(X + (size_t)r * DM, p.in[20], X + (size_t)r * DM, lane);
        return;
    }
    const int l = ph / NPL, k = ph - l * NPL;
    float* ssq1 = (float*)(ws + WS_SSQ); float* ssq2 = ssq1 + 4 * T_ALL; float* ssq3 = ssq2 + 4 * T_ALL;
    if (k == 0) {
        const size_t oFF = (size_t)l * DM * FF, oDD = (size_t)l * DM * DM;
        constexpr int I_F = 16 * 88, I_IN = 16 * 264, I_MKV = 16 * 64, I_DD = 16 * 32;
        constexpr int NIT = 6 * I_F + I_IN + I_MKV + 4 * I_DD;
        LAS float* scr = (LAS float*)(lds + wave * 8704);
        const float* g1 = p.in[2] + l * DM; const float* gm = p.in[6] + l * DM; const float* g2 = p.in[16] + l * DM; const float* gnone = nullptr;
        for (int it = gw; it < NIT; it += ngw) {
            int r = it;
            if (r < I_F) { wt_item(p.in[3] + oFF, DM, FF, (bf16_t*)(ws + WS_W13A), 1, r, scr, lane, g1); continue; } r -= I_F;
            if (r < I_F) { wt_item(p.in[4] + oFF, DM, FF, (bf16_t*)(ws + WS_W13A), 2, r, scr, lane, g1); continue; } r -= I_F;
            if (r < I_F) { wt_item(p.in[5] + oFF, FF, DM, (bf16_t*)(ws + WS_W2A), 0, r, scr, lane, gnone); continue; } r -= I_F;
            if (r < I_F) { wt_item(p.in[17] + oFF, DM, FF, (bf16_t*)(ws + WS_W13B), 1, r, scr, lane, g2); continue; } r -= I_F;
            if (r < I_F) { wt_item(p.in[18] + oFF, DM, FF, (bf16_t*)(ws + WS_W13B), 2, r, scr, lane, g2); continue; } r -= I_F;
            if (r < I_F) { wt_item(p.in[19] + oFF, FF, DM, (bf16_t*)(ws + WS_W2B), 0, r, scr, lane, gnone); continue; } r -= I_F;
            if (r < I_IN) { wt_item(p.in[7] + (size_t)l * DM * INW, DM, INW, (bf16_t*)(ws + WS_WIN), 0, r, scr, lane, gm); continue; } r -= I_IN;
            if (r < I_MKV) { wt_item(p.in[11] + (size_t)l * DM * 2048, DM, 2048, (bf16_t*)(ws + WS_WMKV), 0, r, scr, lane, gnone); continue; } r -= I_MKV;
            if (r < I_DD) { wt_item(p.in[12] + oDD, DM, DM, (bf16_t*)(ws + WS_WUP), 0, r, scr, lane, gnone); continue; } r -= I_DD;
            if (r < I_DD) { wt_item(p.in[13] + oDD, DM, DM, (bf16_t*)(ws + WS_WUP) + (size_t)DM * DM, 0, r, scr, lane, gnone); continue; } r -= I_DD;
            if (r < I_DD) { wt_item(p.in[14] + oDD, DM, DM, (bf16_t*)(ws + WS_WUP) + (size_t)2 * DM * DM, 0, r, scr, lane, gnone); continue; } r -= I_DD;
            wt_item(p.in[15] + oDD, DM, DM, (bf16_t*)(ws + WS_WO), 0, r, scr, lane, gnone);
        }
        for (int r = gw; r < 2048; r += ngw) rms_row_bf16(p.in[1] + (size_t)r * DM, p.in[10] + l * DM, (bf16_t*)(ws + WS_MEMH) + (size_t)r * DM, lane);
        if (l == 0) {
            for (int r = gw; r < T_ALL; r += ngw) {
                const f32x4* xr = (const f32x4*)(xin + (size_t)r * DM) + lane; u32x2* o8 = (u32x2*)(Hb + (size_t)r * DM) + lane; float sacc = 0.f;
#pragma unroll
                for (int j = 0; j < 4; ++j) { const f32x4 v = xr[64 * j]; sacc += (v.x * v.x + v.y * v.y) + (v.z * v.z + v.w * v.w); o8[64 * j] = (u32x2){cvt_pk_bf16(v.x, v.y), cvt_pk_bf16(v.z, v.w)}; }
                sacc = wave_sum(sacc); if (lane == 0) *(f32x4*)(ssq1 + (size_t)r * 4) = (f32x4){sacc, 0.f, 0.f, 0.f};
            }
            f32x2* tab = (f32x2*)(ws + WS_TAB);
            for (int i = cu * 512 + tid; i < SEQ * 64; i += G * 512) {
                const int pos = i >> 6, j = i & 63;
                const float inv = exp2f(-(float)j * (13.287712379549449f / 64.f));
                const float ang = (float)pos * inv;
                double rr = (double)ang * 0.15915494309189535; rr -= rint(rr);
                const float rf = (float)rr;
                tab[i] = (f32x2){__builtin_amdgcn_cosf(rf), __builtin_amdgcn_sinf(rf)};
            }
        }
        return;
    }
    if (k == 1 || k == 14) {
        pg8::Gemm g; g.A = (k == 1) ? Hb : (const bf16_t*)(ws + WS_XB3); g.Bt = (const bf16_t*)(ws + (k == 1 ? WS_W13A : WS_W13B)); g.M = T_ALL; g.N = 2 * FF; g.K = DM; g.lda = DM; g.zoff0 = g.zoff1 = g.zoff2 = 0; g.zB = 0;
        pg8::Order S; S.init(g.M, g.N, G, cu, 1);
        pg8::EpiSwiglu E; E.U = (bf16_t*)(ws + WS_U); E.ldu = FF; E.ssq = (k == 1) ? ssq1 : ssq3;
        pg8::gemm_phase(lds, g, S, E, tid);
        return;
    }
    if (k == 2 || k == 15 || k == 13) {
        pg8::Gemm g; pg8::EpiResid E; E.red = (LAS float*)(lds + pg8::STAGE_BYTES); g.zoff0 = g.zoff1 = g.zoff2 = 0; g.zB = 0; g.N = DM; g.M = T_ALL; E.ld = DM; E.dst = X;
        if (k == 2 || k == 15) {
            g.A = (const bf16_t*)(ws + WS_U); g.Bt = (const bf16_t*)(ws + (k == 2 ? WS_W2A : WS_W2B)); g.K = FF; g.lda = FF;
            E.src = (l == 0 && k == 2) ? xin : (const float*)X; E.scale = 0.5f; E.xb = Hb; E.ssq = (k == 2) ? ssq2 : ssq1;
        } else {
            g.A = Hb; g.Bt = (const bf16_t*)(ws + WS_WO); g.K = DM; g.lda = DM;
            E.src = X; E.scale = 1.0f; E.xb = (bf16_t*)(ws + WS_XB3); E.ssq = ssq3;
        }
        pg8::Order S; S.init(g.M, g.N, G, cu, 1);
        pg8::gemm_phase(lds, g, S, E, tid);
        return;
    }
    const int half = (k - 3) / 5, s = (k - 3) - 5 * half;
    bf16_t* proj = (bf16_t*)(ws + WS_PROJ);
    float* states = (float*)(ws + WS_ST);
    const f32x2* tab = (const f32x2*)(ws + WS_TAB);
    if (s == 0) {
        pg8::Gemm g; g.A = Hb + (size_t)half * T_HALF * DM; g.Bt = (const bf16_t*)(ws + WS_WIN); g.M = T_HALF; g.N = INW; g.K = DM; g.lda = DM; g.zoff0 = g.zoff1 = g.zoff2 = 0; g.zB = 0;
        pg8::Order S; S.init(g.M, g.N, G, cu, 1);
        pg8::EpiStore E; E.O = proj; E.ldc = INW; E.ssq = ssq2 + (size_t)half * T_HALF * 4;
        pg8::gemm_phase(lds, g, S, E, tid);
        if (half == 0) {
            pg8::Gemm g2; g2.A = (const bf16_t*)(ws + WS_MEMH); g2.Bt = (const bf16_t*)(ws + WS_WMKV); g2.M = 2048; g2.N = 2048; g2.K = DM; g2.lda = DM; g2.zoff0 = g2.zoff1 = g2.zoff2 = 0; g2.zB = 0;
            pg8::Order S2; S2.init(2048, 2048, G, (cu >= 64 && cu < 128) ? cu - 64 : G, 1);
            pg8::EpiMkv E2; E2.mk = (bf16_t*)(ws + WS_MK); E2.mvT = (bf16_t*)(ws + WS_MVT);
            pg8::gemm_phase(lds, g2, S2, E2, tid);
        }
        return;
    }
    if (s == 1) {
        for (int it = cu; it < 512; it += G) ret_state_item(proj, tab, states, it, lds, tid);
        for (int it = cu; it < 256; it += G) swa_item(proj, p.in[9] + l * 16, it, lds, tid, dry);
        for (int it = cu; it < 512; it += G) mem_item(proj, (const bf16_t*)(ws + WS_MK), (const bf16_t*)(ws + WS_MVT), half * 4, it, lds, tid, dry);
        return;
    }
    if (s == 2) { ret_scan(states, cu * 512 + tid, G * 512, dry); return; }
    if (s == 3) {
        for (int it = cu; it < 512; it += G) ret_out_item(proj, tab, states, p.in[8] + l * 1024, it, lds, tid, dry);
        return;
    }
    {
        pg8::Gemm g; g.A = proj; g.Bt = (const bf16_t*)(ws + WS_WUP); g.M = T_HALF; g.N = DM; g.K = DM; g.lda = INW; g.zoff0 = C_RG; g.zoff1 = C_SQ; g.zoff2 = C_MQ; g.zB = (long)DM * DM;
        pg8::Order S; S.init(g.M, g.N, G, cu, 3);
        pg8::EpiGate E; E.Mg = Hb + (size_t)half * T_HALF * DM; E.gl = proj + C_GL; E.ldg = INW;
        pg8::gemm_phase(lds, g, S, E, tid);
    }
}

__global__ __launch_bounds__(512, 2) void mega(Params p, int ph_lo, int ph_hi) {
    extern __shared__ __attribute__((aligned(16))) unsigned char shm[];
    LAS unsigned char* lds = (LAS unsigned char*)shm;
    cg::grid_group grid = cg::this_grid();
    volatile LAS unsigned* st = (volatile LAS unsigned*)(lds + LDS_PHASE);
    if (threadIdx.x == 0) { st[0] = 0u; st[1] = 0u; st[2] = 0u; st[3] = 0u; }
    __syncthreads();
    const XcdBarrier xb = xcd_barrier_post((unsigned*)(p.ws + WS_BAR), st);
    for (int ph = ph_lo; ph < ph_hi; ++ph) {
        run_phase(p, ph, lds, 0);
        if (ph + 1 < ph_hi) { if (ph_hi < 0) grid.sync(); else xcd_barrier(xb); }
    }
}

extern "C" void kernel_launch(void* const* d_in, const int* in_sizes, int n_in, void* d_out, int out_size, void* d_ws, size_t ws_size, hipStream_t stream) {
    static int grid = 0;
    if (grid == 0) {
        if (n_in != 21 || out_size != T_ALL * DM || ws_size < WS_END) { fprintf(stderr, "kernel_launch: unexpected shapes (n_in %d out %d ws %zu need %zu)\n", n_in, out_size, ws_size, (size_t)WS_END); grid = -1; return; }
        int dev = 0, cus = 0, per_cu = 0;
        if (hipGetDevice(&dev) != hipSuccess || hipDeviceGetAttribute(&cus, hipDeviceAttributeMultiprocessorCount, dev) != hipSuccess) { grid = -1; return; }
        if (hipFuncSetAttribute((const void*)mega, hipFuncAttributeMaxDynamicSharedMemorySize, LDS_BYTES) != hipSuccess) { fprintf(stderr, "kernel_launch: hipFuncSetAttribute failed\n"); grid = -1; return; }
        if (hipOccupancyMaxActiveBlocksPerMultiprocessor(&per_cu, (const void*)mega, 512, LDS_BYTES) != hipSuccess || per_cu < 1) { fprintf(stderr, "kernel_launch: occupancy query says %d\n", per_cu); per_cu = 1; }
        (void)hipGetLastError();
        grid = cus;
    }
    if (grid <= 0) return;
    Params p{};
    for (int i = 0; i < 21; ++i) p.in[i] = (const float*)d_in[i];
    p.out = (float*)d_out; p.ws = (unsigned char*)d_ws;
    (void)hipMemsetAsync((unsigned char*)d_ws + WS_BAR, 0, 16384, stream);
#if MK_ONE_LAUNCH
    int lo = 0, hi = NPH;
    void* args[] = {&p, &lo, &hi};
    hipError_t e = hipLaunchCooperativeKernel((const void*)mega, dim3(grid), dim3(512), args, LDS_BYTES, stream);
    if (e != hipSuccess) fprintf(stderr, "cooperative launch failed: %s (grid %d)\n", hipGetErrorString(e), grid);
#else
    for (int ph = 0; ph < NPH; ++ph) hipLaunchKernelGGL(mega, dim3(grid), dim3(512), LDS_BYTES, stream, p, ph, ph + 1);
#endif
}
```

```cpp
#include <hip/hip_runtime.h>
#include <hip/hip_cooperative_groups.h>
#include <cstdio>
#include <cstdint>
namespace cg = cooperative_groups;

#ifndef MK_ONE_LAUNCH
#define MK_ONE_LAUNCH 1
#endif

#ifndef DBL_MASK
#define DBL_MASK 0
#endif
#ifndef PHMASK
#define PHMASK 0xffff
#endif
#define LAS __attribute__((address_space(3)))
typedef unsigned short bf16_t;
typedef short bf16x8 __attribute__((ext_vector_type(8)));
typedef short bf16x4 __attribute__((ext_vector_type(4)));
typedef float f32x4 __attribute__((ext_vector_type(4)));
typedef float f32x2 __attribute__((ext_vector_type(2)));
typedef unsigned u32x4 __attribute__((ext_vector_type(4)));
typedef unsigned u32x2 __attribute__((ext_vector_type(2)));

constexpr int T_ALL = 32768, DM = 1024, FF = 2816, INW = 8448, T_HALF = 16384, SEQ = 4096;
constexpr int C_RQ = 0, C_RK = 512, C_RV = 1024, C_RG = 2048, C_SQ = 3072, C_SK = 4096, C_SV = 4224, C_MQ = 4352, C_GL = 5376;
constexpr int LDS_PHASE = 143360, LDS_BYTES = LDS_PHASE + 16;
constexpr int NPL = 16, NPH = 2 * NPL + 1;

constexpr size_t SZ_W13 = (size_t)2 * FF * DM * 2, SZ_W2 = (size_t)DM * FF * 2;
constexpr size_t WS_W13A = 0, WS_W2A = WS_W13A + SZ_W13, WS_W13B = WS_W2A + SZ_W2, WS_W2B = WS_W13B + SZ_W13;
constexpr size_t WS_WIN = WS_W2B + SZ_W2, WS_WMKV = WS_WIN + (size_t)INW * DM * 2, WS_WUP = WS_WMKV + (size_t)2048 * DM * 2;
constexpr size_t WS_WO = WS_WUP + (size_t)3 * DM * DM * 2, WS_TAB = WS_WO + (size_t)DM * DM * 2;
constexpr size_t WS_MEMH = WS_TAB + (size_t)SEQ * 64 * 8, WS_MK = WS_MEMH + (size_t)2048 * DM * 2, WS_MVT = WS_MK + (size_t)2048 * DM * 2;
constexpr size_t WS_H = WS_MVT + (size_t)2048 * DM * 2, WS_TMP = WS_H + (size_t)T_ALL * DM * 2;
constexpr size_t WS_U = WS_TMP, WS_PROJ = WS_TMP, WS_ST = WS_PROJ + (size_t)T_HALF * INW * 2;
constexpr size_t WS_BAR = WS_ST + (size_t)512 * 32768 * 4;
constexpr size_t WS_SSQ = WS_BAR + 16384;
constexpr size_t WS_END = WS_SSQ + (size_t)3 * T_ALL * 16;
constexpr size_t WS_XB3 = WS_TMP + (size_t)192 * 1024 * 1024;

struct Params {
    const float* in[21];
    float* out;
    unsigned char* ws;
};

__device__ __forceinline__ unsigned cvt_pk_bf16(float lo, float hi) { unsigned r; asm volatile("v_cvt_pk_bf16_f32 %0, %1, %2" : "=v"(r) : "v"(lo), "v"(hi)); return r; }
__device__ __forceinline__ bf16_t f2bf(float f) { return (bf16_t)(cvt_pk_bf16(f, 0.f) & 0xffffu); }
__device__ __forceinline__ float bf2f(unsigned b) { return __uint_as_float(b << 16); }
__device__ __forceinline__ float bflo(unsigned w) { return __uint_as_float(w << 16); }
__device__ __forceinline__ float bfhi(unsigned w) { return __uint_as_float(w & 0xffff0000u); }
__device__ __forceinline__ float wave_sum(float v) {
#pragma unroll
    for (int o = 1; o < 64; o <<= 1) v += __shfl_xor(v, o);
    return v;
}
__device__ __forceinline__ f32x4 mfma16(bf16x8 a, bf16x8 b, f32x4 c) { return __builtin_amdgcn_mfma_f32_16x16x32_bf16(a, b, c, 0, 0, 0); }
__device__ __forceinline__ float sigmoidf_(float x) { return 1.0f / (1.0f + __expf(-x)); }
__device__ __forceinline__ float log2g(int h) { return h == 0 ? -0.04580368961312479f : h == 1 ? -0.02272007650008353f : h == 2 ? -0.011315313227834146f : -0.005646563141142063f; }

namespace pg8 {
constexpr int BM = 256, BK = 64, HALF = 128, HTB = HALF * BK * 2, STAGE_BYTES = 8 * HTB, NXCD = 8, WGM = 8;
__host__ __device__ __forceinline__ int lds_byte(int r, int c) { const int st = (r >> 4) * 2 + (c >> 5), rr = r & 15, cc = c & 31, ob = rr * 64 + cc * 2; return st * 1024 + (ob ^ (((ob >> 9) & 1) << 5)); }
__host__ __device__ __forceinline__ void stage_rc(int b, int& R, int& C) { const int st = b / 1024, sb = b % 1024, swz = sb ^ (((sb >> 9) & 1) << 5); R = (st >> 1) * 16 + swz / 64; C = (st & 1) * 32 + (swz % 64) / 2; }
__host__ __device__ __forceinline__ int perm32(int rho) { const int n = rho >> 4, i = rho & 15; return 8 * (i >> 2) + 4 * n + (i & 3); }

struct Unit { int pm, pn, z; };
struct Gemm { const bf16_t* A; const bf16_t* Bt; int M, N, K, lda; int zoff0, zoff1, zoff2; long zB; };

struct Order {
    int nM, nN, nwg, G, c, nZ;
    __device__ void init(int M, int N, int G_, int c_, int nZ_) { nM = M / BM; nN = N / BM; nwg = nM * nN; G = G_; c = c_; nZ = nZ_; }
    __device__ bool next(int i, Unit& u) const {
        int rnd = i, z = 0;
        if (nZ == 3) { rnd = i / 3; z = i - 3 * rnd; }
        u.z = z;
        const long L = (long)rnd * G + c; if (L >= nwg) return false;
        int wgid = (int)L; { const int q = nwg / NXCD, r = nwg % NXCD, xcd = wgid % NXCD, off = wgid / NXCD; wgid = (xcd < r ? xcd * (q + 1) : r * (q + 1) + (xcd - r) * q) + off; }
        const int nig = WGM * nN, gid = wgid / nig, fm = gid * WGM, gsz = (nM - fm) < WGM ? (nM - fm) : WGM;
        u.pm = fm + ((wgid % nig) % gsz); u.pn = (wgid % nig) / gsz; return true;
    }
};

struct EpiStore {
    static constexpr bool PERM = true;
    bf16_t* O; int ldc; const float* ssq;
    __device__ __forceinline__ void operator()(const f32x4 (&acc)[2][2][4][2], const Unit& u, int wr, int wc, int fr, int fq) const {
        const int row0 = u.pm * BM + wr * 64 + fr, col0 = u.pn * BM + wc * 32 + 8 * fq;
        f32x4 q4[2][4];
#pragma unroll
        for (int ai = 0; ai < 2; ++ai)
#pragma unroll
            for (int m = 0; m < 4; ++m) q4[ai][m] = *(const f32x4*)(ssq + (size_t)(row0 + ai * HALF + m * 16) * 4);
#pragma unroll
        for (int ai = 0; ai < 2; ++ai)
#pragma unroll
            for (int m = 0; m < 4; ++m) { bf16_t* rowp = O + (size_t)(row0 + ai * HALF + m * 16) * ldc + col0;
                const float rs = rsqrtf(((q4[ai][m].x + q4[ai][m].y) + (q4[ai][m].z + q4[ai][m].w)) * (1.f / 1024.f) + 1e-6f);
#pragma unroll
                for (int bj = 0; bj < 2; ++bj) { const f32x4 v0 = acc[ai][bj][m][0] * rs, v1 = acc[ai][bj][m][1] * rs;
                    u32x4 w; w.x = cvt_pk_bf16(v0[0], v0[1]); w.y = cvt_pk_bf16(v0[2], v0[3]); w.z = cvt_pk_bf16(v1[0], v1[1]); w.w = cvt_pk_bf16(v1[2], v1[3]);
                    *(u32x4*)(rowp + bj * HALF) = w; } }
    }
};
struct EpiSwiglu {
    static constexpr bool PERM = true;
    bf16_t* U; int ldu; const float* ssq;
    __device__ __forceinline__ void operator()(const f32x4 (&acc)[2][2][4][2], const Unit& u, int wr, int wc, int fr, int fq) const {
        const int row0 = u.pm * BM + wr * 64 + fr, col0 = u.pn * 128 + wc * 16 + 4 * fq;
        f32x4 q4[2][4];
#pragma unroll
        for (int ai = 0; ai < 2; ++ai)
#pragma unroll
            for (int m = 0; m < 4; ++m) q4[ai][m] = *(const f32x4*)(ssq + (size_t)(row0 + ai * HALF + m * 16) * 4);
#pragma unroll
        for (int ai = 0; ai < 2; ++ai)
#pragma unroll
            for (int m = 0; m < 4; ++m) { bf16_t* rowp = U + (size_t)(row0 + ai * HALF + m * 16) * ldu + col0;
                const float rs = rsqrtf(((q4[ai][m].x + q4[ai][m].y) + (q4[ai][m].z + q4[ai][m].w)) * (1.f / 1024.f) + 1e-6f);
#pragma unroll
                for (int bj = 0; bj < 2; ++bj) { const f32x4 a = acc[ai][bj][m][0] * rs, b = acc[ai][bj][m][1] * rs;
                    float r[4];
#pragma unroll
                    for (int j = 0; j < 4; ++j) r[j] = a[j] * sigmoidf_(a[j]) * b[j];
                    u32x2 w; w.x = cvt_pk_bf16(r[0], r[1]); w.y = cvt_pk_bf16(r[2], r[3]);
                    *(u32x2*)(rowp + bj * 64) = w; } }
    }
};
struct EpiResid {
    static constexpr bool PERM = true;
    const bf16_t* src; bf16_t* dst; float* ssq; int ld; float scale; LAS float* red;
    __device__ __forceinline__ void operator()(const f32x4 (&acc)[2][2][4][2], const Unit& u, int wr, int wc, int fr, int fq) const {
        const int row0 = u.pm * BM + wr * 64 + fr, col0 = u.pn * BM + wc * 32 + 8 * fq;
        u32x4 sv[2][4][2];
#pragma unroll
        for (int ai = 0; ai < 2; ++ai)
#pragma unroll
            for (int m = 0; m < 4; ++m)
#pragma unroll
                for (int bj = 0; bj < 2; ++bj) sv[ai][m][bj] = *(const u32x4*)(src + (size_t)(row0 + ai * HALF + m * 16) * ld + col0 + bj * HALF);
#pragma unroll
        for (int ai = 0; ai < 2; ++ai)
#pragma unroll
            for (int m = 0; m < 4; ++m) { const size_t ro = (size_t)(row0 + ai * HALF + m * 16) * ld + col0; float ss = 0.f;
#pragma unroll
                for (int bj = 0; bj < 2; ++bj) { const u32x4 w = sv[ai][m][bj]; const f32x4 a0 = acc[ai][bj][m][0], a1 = acc[ai][bj][m][1];
                    const float v0 = bflo(w.x) + a0[0] * scale, v1 = bfhi(w.x) + a0[1] * scale, v2 = bflo(w.y) + a0[2] * scale, v3 = bfhi(w.y) + a0[3] * scale;
                    const float v4 = bflo(w.z) + a1[0] * scale, v5 = bfhi(w.z) + a1[1] * scale, v6 = bflo(w.w) + a1[2] * scale, v7 = bfhi(w.w) + a1[3] * scale;
                    *(u32x4*)(dst + ro + bj * HALF) = (u32x4){cvt_pk_bf16(v0, v1), cvt_pk_bf16(v2, v3), cvt_pk_bf16(v4, v5), cvt_pk_bf16(v6, v7)};
                    ss += ((v0 * v0 + v1 * v1) + (v2 * v2 + v3 * v3)) + ((v4 * v4 + v5 * v5) + (v6 * v6 + v7 * v7)); }
                ss += __shfl_xor(ss, 16); ss += __shfl_xor(ss, 32);
                if (fq == 0) red[(ai * HALF + wr * 64 + m * 16 + fr) * 4 + wc] = ss; }
        asm volatile("s_waitcnt lgkmcnt(0)" ::: "memory"); __builtin_amdgcn_s_barrier(); asm volatile("" ::: "memory");
        const int t = (wr * 4 + wc) * 64 + fq * 16 + fr;
        if (t < 256) { const f32x4 q = *(const LAS f32x4*)(red + t * 4); ssq[(size_t)(u.pm * BM + t) * 4 + u.pn] = (q.x + q.y) + (q.z + q.w); }
    }
};
struct EpiGate {
    static constexpr bool PERM = true;
    bf16_t* Mg; const bf16_t* gl; int ldg;
    __device__ __forceinline__ void operator()(const f32x4 (&acc)[2][2][4][2], const Unit& u, int wr, int wc, int fr, int fq) const {
        const int row0 = u.pm * BM + wr * 64 + fr, col0 = u.pn * BM + wc * 32 + 8 * fq;
#pragma unroll
        for (int ai = 0; ai < 2; ++ai)
#pragma unroll
            for (int m = 0; m < 4; ++m) { const int row = row0 + ai * HALF + m * 16;
                bf16_t* mp = Mg + (size_t)row * 1024 + col0; const bf16_t* gp = gl + (size_t)row * ldg + u.z * 1024 + col0;
#pragma unroll
                for (int bj = 0; bj < 2; ++bj) { const f32x4 v0 = acc[ai][bj][m][0], v1 = acc[ai][bj][m][1];
                    const u32x4 g = *(const u32x4*)(gp + bj * HALF);
                    u32x4 o = (u32x4){0u, 0u, 0u, 0u};
                    if (u.z > 0) o = *(const u32x4*)(mp + bj * HALF);
                    float r[8];
                    r[0] = bflo(o.x) + sigmoidf_(bflo(g.x)) * v0[0]; r[1] = bfhi(o.x) + sigmoidf_(bfhi(g.x)) * v0[1];
                    r[2] = bflo(o.y) + sigmoidf_(bflo(g.y)) * v0[2]; r[3] = bfhi(o.y) + sigmoidf_(bfhi(g.y)) * v0[3];
                    r[4] = bflo(o.z) + sigmoidf_(bflo(g.z)) * v1[0]; r[5] = bfhi(o.z) + sigmoidf_(bfhi(g.z)) * v1[1];
                    r[6] = bflo(o.w) + sigmoidf_(bflo(g.w)) * v1[2]; r[7] = bfhi(o.w) + sigmoidf_(bfhi(g.w)) * v1[3];
                    u32x4 w; w.x = cvt_pk_bf16(r[0], r[1]); w.y = cvt_pk_bf16(r[2], r[3]); w.z = cvt_pk_bf16(r[4], r[5]); w.w = cvt_pk_bf16(r[6], r[7]);
                    *(u32x4*)(mp + bj * HALF) = w; } }
    }
};
struct EpiMkv {
    static constexpr bool PERM = true;
    bf16_t* mk; bf16_t* mvT;
    __device__ __forceinline__ void operator()(const f32x4 (&acc)[2][2][4][2], const Unit& u, int wr, int wc, int fr, int fq) const {
        const int row0 = u.pm * BM + wr * 64 + fr, col0 = u.pn * BM + wc * 32 + 8 * fq;
#pragma unroll
        for (int ai = 0; ai < 2; ++ai)
#pragma unroll
            for (int m = 0; m < 4; ++m) { const int row = row0 + ai * HALF + m * 16;
#pragma unroll
                for (int bj = 0; bj < 2; ++bj) { const f32x4 v0 = acc[ai][bj][m][0], v1 = acc[ai][bj][m][1]; const int col = col0 + bj * HALF;
                    if (u.pn < 4) {
                        u32x4 w; w.x = cvt_pk_bf16(v0[0], v0[1]); w.y = cvt_pk_bf16(v0[2], v0[3]); w.z = cvt_pk_bf16(v1[0], v1[1]); w.w = cvt_pk_bf16(v1[2], v1[3]);
                        *(u32x4*)(mk + (size_t)row * 1024 + col) = w;
                    } else {
                        const int b = row >> 8, mem = row & 255; bf16_t* base = mvT + ((size_t)b * 1024 + (col - 1024)) * 256 + mem;
#pragma unroll
                        for (int j = 0; j < 4; ++j) { base[(size_t)j * 256] = f2bf(v0[j]); base[(size_t)(4 + j) * 256] = f2bf(v1[j]); }
                    } } }
    }
};

template <class Epi>
__device__ __forceinline__ void gemm_phase(LAS unsigned char* lds, const Gemm g, const Order& S, const Epi& E, const int tid) {
    const int wid = __builtin_amdgcn_readfirstlane(tid >> 6), lane = tid & 63, wr = wid >> 2, wc = wid & 3, fr = lane & 15, fq = lane >> 4;
    const int K = g.K, nt = K / BK, lda = g.lda;
    unsigned voffA[2], voffB[2];
#pragma unroll
    for (int i = 0; i < 2; ++i) { int R, C; stage_rc(tid * 16 + i * 8192, R, C); const int Rb = Epi::PERM ? ((R & ~31) + perm32(R & 31)) : R;
        voffA[i] = (unsigned)(R * lda + C) * 2u; voffB[i] = (unsigned)(Rb * K + C) * 2u; }
    const size_t kstep = (size_t)(BK * 2);
    const size_t hstepA = (size_t)HALF * lda * 2, hstepB = (size_t)HALF * K * 2;
    const size_t tstepA = 2 * hstepA, tstepB = 2 * hstepB;
    const unsigned ldsw = (unsigned)wid * 1024u;
    const int aoff = lds_byte(wr * 64 + fr, fq * 8), boff = lds_byte(wc * 32 + fr, fq * 8);
#define PG8_SA(b, h) (((b) * 2 + (h)) * HTB)
#define PG8_SB(b, h) ((4 + (b) * 2 + (h)) * HTB)
#define PG8_STAGE(bufoff, gbase, voff) do { _Pragma("unroll") for (int _i = 0; _i < 2; ++_i) \
        __builtin_amdgcn_global_load_lds((const unsigned*)((const char*)(gbase) + (voff)[_i]), (LAS unsigned*)(lds + (bufoff) + ldsw + _i * 8192), 16, 0, 0); } while (0)
#define PG8_LDA(dst, b, h) do { _Pragma("unroll") for (int m = 0; m < 4; ++m) _Pragma("unroll") for (int k = 0; k < 2; ++k) dst[m][k] = *(const LAS bf16x8*)(lds + PG8_SA(b, h) + aoff + m * 2048 + k * 1024); } while (0)
#define PG8_LDB(dst, b, h) do { _Pragma("unroll") for (int n = 0; n < 2; ++n) _Pragma("unroll") for (int k = 0; k < 2; ++k) dst[n][k] = *(const LAS bf16x8*)(lds + PG8_SB(b, h) + boff + n * 2048 + k * 1024); } while (0)
#define PG8_MMA(ai, bj, At, Bt) do { __builtin_amdgcn_s_setprio(1); _Pragma("unroll") for (int m = 0; m < 4; ++m) _Pragma("unroll") for (int n = 0; n < 2; ++n) _Pragma("unroll") for (int k = 0; k < 2; ++k) \
        acc[ai][bj][m][n] = __builtin_amdgcn_mfma_f32_16x16x32_bf16(Bt[n][k], At[m][k], acc[ai][bj][m][n], 0, 0, 0); __builtin_amdgcn_s_setprio(0); } while (0)
#define PG8_WAIT_V(n) asm volatile("s_waitcnt vmcnt(" #n ")" ::: "memory")
#define PG8_WAIT_L(n) asm volatile("s_waitcnt lgkmcnt(" #n ")" ::: "memory")
#define PG8_BAR __builtin_amdgcn_s_barrier()
#define PG8_SCHED __builtin_amdgcn_sched_barrier(0)
#define PG8_ABASE(u) ((const char*)g.A + (size_t)((u).z == 0 ? g.zoff0 : (u).z == 1 ? g.zoff1 : g.zoff2) * 2 + (size_t)(u).pm * tstepA)
#define PG8_BBASE(u) ((const char*)g.Bt + (size_t)((u).z * g.zB) * 2 + (size_t)(u).pn * tstepB)
    Unit cur, nxt; int ui = 0;
    if (!S.next(0, cur)) return;
    f32x4 acc[2][2][4][2];
#pragma unroll
    for (int a = 0; a < 2; ++a)
#pragma unroll
        for (int b = 0; b < 2; ++b)
#pragma unroll
            for (int m = 0; m < 4; ++m)
#pragma unroll
                for (int n = 0; n < 2; ++n) acc[a][b][m][n] = (f32x4){0.f, 0.f, 0.f, 0.f};
    bf16x8 At[4][2], B0[2][2], B1[2][2];
    const char* cA = PG8_ABASE(cur); const char* cB = PG8_BBASE(cur);
    PG8_STAGE(PG8_SB(0, 0), cB, voffB); PG8_STAGE(PG8_SB(0, 1), cB + hstepB, voffB); PG8_STAGE(PG8_SA(0, 0), cA, voffA); PG8_STAGE(PG8_SA(0, 1), cA + hstepA, voffA);
    if (wr == 1) PG8_BAR;
    PG8_WAIT_V(2); PG8_BAR;
    PG8_STAGE(PG8_SB(1, 0), cB + kstep, voffB); PG8_STAGE(PG8_SA(1, 0), cA + kstep, voffA); PG8_STAGE(PG8_SB(1, 1), cB + hstepB + kstep, voffB);
    PG8_WAIT_V(6); PG8_BAR;
    for (;;) {
        const bool has_next = S.next(ui + 1, nxt);
        const char* nA = has_next ? PG8_ABASE(nxt) : cA; const char* nB = has_next ? PG8_BBASE(nxt) : cB;
        for (int t = 0; t < nt; t += 2) {
            const bool last = (t == nt - 2);
            const char* a1 = cA + (size_t)(t + 1) * kstep;
            const char* a2 = last ? nA : cA + (size_t)(t + 2) * kstep; const char* b2 = last ? nB : cB + (size_t)(t + 2) * kstep;
            const char* a3 = a2 + kstep; const char* b3 = b2 + kstep;
            PG8_LDB(B0, 0, 0); PG8_LDB(B1, 0, 1); PG8_SCHED; PG8_LDA(At, 0, 0); PG8_STAGE(PG8_SA(1, 1), a1 + hstepA, voffA);
            PG8_WAIT_V(8); PG8_WAIT_L(0); PG8_BAR; PG8_MMA(0, 0, At, B0); PG8_MMA(0, 1, At, B1); PG8_BAR; PG8_SCHED;
            PG8_LDA(At, 0, 1); PG8_STAGE(PG8_SB(0, 0), b2, voffB); PG8_STAGE(PG8_SB(0, 1), b2 + hstepB, voffB); PG8_STAGE(PG8_SA(0, 0), a2, voffA);
            PG8_WAIT_V(8); PG8_WAIT_L(0); PG8_BAR; PG8_MMA(1, 0, At, B0); PG8_MMA(1, 1, At, B1); PG8_BAR; PG8_SCHED;
            PG8_LDB(B0, 1, 0); PG8_LDB(B1, 1, 1); PG8_SCHED; PG8_LDA(At, 1, 0); PG8_STAGE(PG8_SA(0, 1), a2 + hstepA, voffA);
            PG8_WAIT_V(8); PG8_WAIT_L(0); PG8_BAR; PG8_MMA(0, 0, At, B0); PG8_MMA(0, 1, At, B1); PG8_BAR; PG8_SCHED;
            PG8_LDA(At, 1, 1); PG8_STAGE(PG8_SB(1, 0), b3, voffB); PG8_STAGE(PG8_SB(1, 1), b3 + hstepB, voffB); PG8_STAGE(PG8_SA(1, 0), a3, voffA);
            PG8_WAIT_V(8); PG8_WAIT_L(0); PG8_BAR; PG8_MMA(1, 0, At, B0); PG8_MMA(1, 1, At, B1); PG8_BAR; PG8_SCHED;
        }
        if (wr == 0) PG8_BAR;
        E(acc, cur, wr, wc, fr, fq);
        if (!has_next) break;
#pragma unroll
        for (int a = 0; a < 2; ++a)
#pragma unroll
            for (int b = 0; b < 2; ++b)
#pragma unroll
                for (int m = 0; m < 4; ++m)
#pragma unroll
                    for (int n = 0; n < 2; ++n) acc[a][b][m][n] = (f32x4){0.f, 0.f, 0.f, 0.f};
        cur = nxt; cA = nA; cB = nB; ++ui;
        if (wr == 1) PG8_BAR;
    }
    PG8_WAIT_V(0);
    PG8_BAR;
#undef PG8_SA
#undef PG8_SB
#undef PG8_STAGE
#undef PG8_LDA
#undef PG8_LDB
#undef PG8_MMA
#undef PG8_WAIT_V
#undef PG8_WAIT_L
#undef PG8_BAR
#undef PG8_SCHED
#undef PG8_ABASE
#undef PG8_BBASE
}
}

__device__ __forceinline__ void rms_row_bf16(const float* xrow, const float* g, bf16_t* orow, int lane) {
    const f32x4* xr = (const f32x4*)xrow + lane; const f32x4* gr = (const f32x4*)g + lane;
    f32x4 v[4]; float s = 0.f;
#pragma unroll
    for (int j = 0; j < 4; ++j) { v[j] = xr[64 * j]; s += (v[j].x * v[j].x + v[j].y * v[j].y) + (v[j].z * v[j].z + v[j].w * v[j].w); }
    const float rstd = rsqrtf(wave_sum(s) * (1.f / 1024.f) + 1e-6f);
    u32x2* o8 = (u32x2*)orow + lane;
#pragma unroll
    for (int j = 0; j < 4; ++j) { const f32x4 gg = gr[64 * j]; u32x2 w; w.x = cvt_pk_bf16(v[j].x * rstd * gg.x, v[j].y * rstd * gg.y); w.y = cvt_pk_bf16(v[j].z * rstd * gg.z, v[j].w * rstd * gg.w); o8[64 * j] = w; }
}
__device__ __forceinline__ void rms_row_final(const bf16_t* xrow, const float* g, float* orow, int lane) {
    const u32x4 a = *((const u32x4*)xrow + lane), b = *((const u32x4*)xrow + 64 + lane);
    float v[16] = {bflo(a.x), bfhi(a.x), bflo(a.y), bfhi(a.y), bflo(a.z), bfhi(a.z), bflo(a.w), bfhi(a.w), bflo(b.x), bfhi(b.x), bflo(b.y), bfhi(b.y), bflo(b.z), bfhi(b.z), bflo(b.w), bfhi(b.w)};
    float s = 0.f;
#pragma unroll
    for (int j = 0; j < 16; ++j) s += v[j] * v[j];
    const float rstd = rsqrtf(wave_sum(s) * (1.f / 1024.f) + 1e-6f);
#pragma unroll
    for (int hh = 0; hh < 2; ++hh)
#pragma unroll
        for (int q = 0; q < 2; ++q) { const int e = hh * 512 + lane * 8 + q * 4; const f32x4 gg = *(const f32x4*)(g + e);
            *(f32x4*)(orow + e) = (f32x4){v[hh * 8 + q * 4 + 0] * rstd * gg.x, v[hh * 8 + q * 4 + 1] * rstd * gg.y, v[hh * 8 + q * 4 + 2] * rstd * gg.z, v[hh * 8 + q * 4 + 3] * rstd * gg.w}; }
}

__device__ __forceinline__ void wt_item(const float* W, int K, int N, bf16_t* WT, int mode, int item, LAS float* scr, int lane, const float* gain) {
    const int nblk = N >> 5, kb = item / nblk, nb = item - kb * nblk, k0 = kb * 64, n0 = nb * 32;
#pragma unroll 16
    for (int i = 0; i < 32; ++i) { const int kk = 2 * i + (lane >> 5); scr[kk * 33 + (lane & 31)] = W[(size_t)(k0 + kk) * N + n0 + (lane & 31)]; }
    asm volatile("s_waitcnt lgkmcnt(0)" ::: "memory");
    const int c = lane & 7;
    f32x4 ga = (f32x4){1.f, 1.f, 1.f, 1.f}, gb = ga;
    if (gain) { ga = *(const f32x4*)(gain + k0 + 8 * c); gb = *(const f32x4*)(gain + k0 + 8 * c + 4); }
#pragma unroll
    for (int j = 0; j < 4; ++j) { const int n = (lane >> 3) + 8 * j, sn = n0 + n; const LAS float* q = scr + (8 * c) * 33 + n;
        const int dr = mode == 0 ? sn : (8 * (sn >> 2) + (sn & 3) + (mode == 2 ? 4 : 0));
        u32x4 o; o.x = cvt_pk_bf16(q[0 * 33] * ga.x, q[1 * 33] * ga.y); o.y = cvt_pk_bf16(q[2 * 33] * ga.z, q[3 * 33] * ga.w); o.z = cvt_pk_bf16(q[4 * 33] * gb.x, q[5 * 33] * gb.y); o.w = cvt_pk_bf16(q[6 * 33] * gb.z, q[7 * 33] * gb.w);
        *(u32x4*)(WT + (size_t)dr * K + k0 + 8 * c) = o; }
    asm volatile("s_waitcnt lgkmcnt(0)" ::: "memory");
}

__device__ __forceinline__ void rot16(const bf16_t* row, const f32x2* tabrow, int jg, float sc, unsigned (&y1)[8], unsigned (&y2)[8]) {
    const u32x4 a0 = *(const u32x4*)(row + jg * 16), a1 = *(const u32x4*)(row + jg * 16 + 8);
    const u32x4 b0 = *(const u32x4*)(row + 64 + jg * 16), b1 = *(const u32x4*)(row + 64 + jg * 16 + 8);
    const unsigned aw[8] = {a0.x, a0.y, a0.z, a0.w, a1.x, a1.y, a1.z, a1.w};
    const unsigned bw[8] = {b0.x, b0.y, b0.z, b0.w, b1.x, b1.y, b1.z, b1.w};
    const f32x4* tp = (const f32x4*)(tabrow + jg * 16);
#pragma unroll
    for (int i = 0; i < 8; ++i) {
        const f32x4 cs = tp[i];
        const float x1a = bflo(aw[i]), x1b = bfhi(aw[i]), x2a = bflo(bw[i]), x2b = bfhi(bw[i]);
        y1[i] = cvt_pk_bf16((x1a * cs.x - x2a * cs.y) * sc, (x1b * cs.z - x2b * cs.w) * sc);
        y2[i] = cvt_pk_bf16((x1a * cs.y + x2a * cs.x) * sc, (x1b * cs.w + x2b * cs.z) * sc);
    }
}

constexpr int RP = 136;

__device__ __forceinline__ void ret_state_item(const bf16_t* proj, const f32x2* tab, bf16_t* states, int item, LAS unsigned char* lds, int tid) {
    const int wave = tid >> 6, lane = tid & 63, fr = lane & 15, fq = lane >> 4;
    const int h = item & 3, n = (item >> 2) & 31, bl = item >> 7;
    const size_t tok0 = (size_t)bl * SEQ + n * 128;
    LAS bf16_t* KT = (LAS bf16_t*)lds;
    LAS bf16_t* VT = (LAS bf16_t*)(lds + 128 * RP * 2);
    const float lg = log2g(h);
    {
        const int c = tid >> 2, jg = tid & 3;
        const bf16_t* row = proj + (tok0 + c) * INW + C_RK + h * 128;
        unsigned y1[8], y2[8];
        rot16(row, tab + (size_t)(n * 128 + c) * 64, jg, 0.08838834764831845f * exp2f(-(float)(c + 1) * lg), y1, y2);
#pragma unroll
        for (int i = 0; i < 8; ++i) {
            const int j = jg * 16 + 2 * i;
            KT[(j) * RP + c] = (bf16_t)(y1[i] & 0xffffu); KT[(j + 1) * RP + c] = (bf16_t)(y1[i] >> 16);
            KT[(j + 64) * RP + c] = (bf16_t)(y2[i] & 0xffffu); KT[(j + 65) * RP + c] = (bf16_t)(y2[i] >> 16);
        }
        const bf16_t* vrow = proj + (tok0 + c) * INW + C_RV + h * 256 + jg * 64;
#pragma unroll
        for (int i = 0; i < 8; ++i) {
            const u32x4 v = *(const u32x4*)(vrow + i * 8);
            const unsigned vw[4] = {v.x, v.y, v.z, v.w};
#pragma unroll
            for (int k = 0; k < 4; ++k) { const int e = jg * 64 + i * 8 + 2 * k; VT[e * RP + c] = (bf16_t)(vw[k] & 0xffffu); VT[(e + 1) * RP + c] = (bf16_t)(vw[k] >> 16); }
        }
    }
    __syncthreads();
    f32x4 acc[8][2];
#pragma unroll
    for (int dt = 0; dt < 8; ++dt) { acc[dt][0] = (f32x4){0.f, 0.f, 0.f, 0.f}; acc[dt][1] = (f32x4){0.f, 0.f, 0.f, 0.f}; }
#pragma unroll
    for (int ks = 0; ks < 4; ++ks) {
        bf16x8 bfr[2];
#pragma unroll
        for (int et = 0; et < 2; ++et) bfr[et] = *(const LAS bf16x8*)(VT + (32 * wave + 16 * et + fr) * RP + 32 * ks + 8 * fq);
#pragma unroll
        for (int dt = 0; dt < 8; ++dt) {
            const bf16x8 a = *(const LAS bf16x8*)(KT + (16 * dt + fr) * RP + 32 * ks + 8 * fq);
            acc[dt][0] = mfma16(a, bfr[0], acc[dt][0]); acc[dt][1] = mfma16(a, bfr[1], acc[dt][1]);
        }
    }
    const float gch = exp2f(128.f * lg);
    bf16_t* sp = states + (size_t)item * 32768;
#pragma unroll
    for (int et = 0; et < 2; ++et)
#pragma unroll
        for (int dt = 0; dt < 8; ++dt) { const f32x4 v = acc[dt][et] * gch; *(u32x2*)(sp + (size_t)(32 * wave + 16 * et + fr) * 128 + 16 * dt + 4 * fq) = (u32x2){cvt_pk_bf16(v[0], v[1]), cvt_pk_bf16(v[2], v[3])}; }
    __syncthreads();
}

__device__ __forceinline__ void ret_scan(bf16_t* states, int gtid, int nthreads, int dry) {
    for (int i = gtid; i < 16 * 8192; i += nthreads) {
        const int bh = i >> 13, off = i & 8191, bl = bh >> 2, h = bh & 3;
        const float g = exp2f(128.f * log2g(h));
        u32x2* p = (u32x2*)(states + ((size_t)(bl * 32) * 4 + h) * 32768) + off;
        f32x4 R = (f32x4){0.f, 0.f, 0.f, 0.f};
        for (int n0 = 0; n0 < 32; n0 += 8) {
            u32x2 sv[8];
#pragma unroll
            for (int k = 0; k < 8; ++k) sv[k] = p[(size_t)(n0 + k) * 32768];
#pragma unroll
            for (int k = 0; k < 8; ++k) { if (!dry) p[(size_t)(n0 + k) * 32768] = (u32x2){cvt_pk_bf16(R[0], R[1]), cvt_pk_bf16(R[2], R[3])};
                R = R * g + (f32x4){bflo(sv[k].x), bfhi(sv[k].x), bflo(sv[k].y), bfhi(sv[k].y)}; }
        }
    }
}

__device__ __forceinline__ void ret_out_item(bf16_t* proj, const f32x2* tab, const bf16_t* states, const float* gn, int item, LAS unsigned char* lds, int tid, int dry) {
    const int wave = tid >> 6, lane = tid & 63, fr = lane & 15, fq = lane >> 4;
    const int h = item & 3, n = (item >> 2) & 31, bl = item >> 7;
    const size_t tok0 = (size_t)bl * SEQ + n * 128;
    LAS bf16_t* QS = (LAS bf16_t*)lds;
    LAS bf16_t* KS = (LAS bf16_t*)(lds + 128 * RP * 2);
    LAS bf16_t* VT = (LAS bf16_t*)(lds + 2 * 128 * RP * 2);
    LAS float* red = (LAS float*)(lds + 4 * 128 * RP * 2);
    const float lg = log2g(h);
    {
        const int c = tid >> 2, jg = tid & 3;
        const f32x2* tr = tab + (size_t)(n * 128 + c) * 64;
        unsigned y1[8], y2[8];
        rot16(proj + (tok0 + c) * INW + C_RQ + h * 128, tr, jg, exp2f((float)(c + 1) * lg), y1, y2);
        *(LAS u32x4*)(QS + c * RP + jg * 16) = (u32x4){y1[0], y1[1], y1[2], y1[3]}; *(LAS u32x4*)(QS + c * RP + jg * 16 + 8) = (u32x4){y1[4], y1[5], y1[6], y1[7]};
        *(LAS u32x4*)(QS + c * RP + 64 + jg * 16) = (u32x4){y2[0], y2[1], y2[2], y2[3]}; *(LAS u32x4*)(QS + c * RP + 64 + jg * 16 + 8) = (u32x4){y2[4], y2[5], y2[6], y2[7]};
        rot16(proj + (tok0 + c) * INW + C_RK + h * 128, tr, jg, 0.08838834764831845f * exp2f(-(float)(c + 1) * lg), y1, y2);
        *(LAS u32x4*)(KS + c * RP + jg * 16) = (u32x4){y1[0], y1[1], y1[2], y1[3]}; *(LAS u32x4*)(KS + c * RP + jg * 16 + 8) = (u32x4){y1[4], y1[5], y1[6], y1[7]};
        *(LAS u32x4*)(KS + c * RP + 64 + jg * 16) = (u32x4){y2[0], y2[1], y2[2], y2[3]}; *(LAS u32x4*)(KS + c * RP + 64 + jg * 16 + 8) = (u32x4){y2[4], y2[5], y2[6], y2[7]};
        const bf16_t* vrow = proj + (tok0 + c) * INW + C_RV + h * 256 + jg * 64;
#pragma unroll
        for (int i = 0; i < 8; ++i) {
            const u32x4 v = *(const u32x4*)(vrow + i * 8);
            const unsigned vw[4] = {v.x, v.y, v.z, v.w};
#pragma unroll
            for (int k = 0; k < 4; ++k) { const int e = jg * 64 + i * 8 + 2 * k; VT[e * RP + c] = (bf16_t)(vw[k] & 0xffffu); VT[(e + 1) * RP + c] = (bf16_t)(vw[k] >> 16); }
        }
    }
    __syncthreads();
    unsigned pk[8][2];
    {
        f32x4 pacc[8];
#pragma unroll
        for (int st = 0; st < 8; ++st) pacc[st] = (f32x4){0.f, 0.f, 0.f, 0.f};
#pragma unroll
        for (int ks = 0; ks < 4; ++ks) {
            const bf16x8 b = *(const LAS bf16x8*)(QS + (16 * wave + fr) * RP + 32 * ks + 8 * fq);
#pragma unroll
            for (int st = 0; st < 8; ++st) { const bf16x8 a = *(const LAS bf16x8*)(KS + (16 * st + fr) * RP + 32 * ks + 8 * fq); pacc[st] = mfma16(a, b, pacc[st]); }
        }
        const int c = 16 * wave + fr;
#pragma unroll
        for (int st = 0; st < 8; ++st) { float v[4];
#pragma unroll
            for (int j = 0; j < 4; ++j) { const int s = 16 * st + 4 * fq + j; v[j] = (s <= c) ? pacc[st][j] : 0.f; }
            pk[st][0] = cvt_pk_bf16(v[0], v[1]); pk[st][1] = cvt_pk_bf16(v[2], v[3]); }
    }
    __syncthreads();
    {
        const int c = 16 * wave + fr;
#pragma unroll
        for (int st = 0; st < 8; ++st) *(LAS u32x2*)(KS + c * RP + 16 * st + 4 * fq) = (u32x2){pk[st][0], pk[st][1]};
    }
    __syncthreads();
    f32x4 acc[2][8];
#pragma unroll
    for (int et = 0; et < 2; ++et)
#pragma unroll
        for (int ct = 0; ct < 8; ++ct) acc[et][ct] = (f32x4){0.f, 0.f, 0.f, 0.f};
    const bf16_t* sp = states + (size_t)item * 32768;
#pragma unroll
    for (int ks = 0; ks < 4; ++ks) {
        bf16x8 av[2], ar[2];
#pragma unroll
        for (int et = 0; et < 2; ++et) {
            const int e = 32 * wave + 16 * et + fr;
            av[et] = *(const LAS bf16x8*)(VT + e * RP + 32 * ks + 8 * fq);
            ar[et] = *(const bf16x8*)(sp + (size_t)e * 128 + 32 * ks + 8 * fq);
        }
#pragma unroll
        for (int ct = 0; ct < 8; ++ct) {
            const bf16x8 bp = *(const LAS bf16x8*)(KS + (16 * ct + fr) * RP + 32 * ks + 8 * fq);
            const bf16x8 bq = *(const LAS bf16x8*)(QS + (16 * ct + fr) * RP + 32 * ks + 8 * fq);
#pragma unroll
            for (int et = 0; et < 2; ++et) { acc[et][ct] = mfma16(av[et], bp, acc[et][ct]); acc[et][ct] = mfma16(ar[et], bq, acc[et][ct]); }
        }
    }
#pragma unroll
    for (int ct = 0; ct < 8; ++ct) {
        float s = 0.f;
#pragma unroll
        for (int et = 0; et < 2; ++et) s += (acc[et][ct][0] * acc[et][ct][0] + acc[et][ct][1] * acc[et][ct][1]) + (acc[et][ct][2] * acc[et][ct][2] + acc[et][ct][3] * acc[et][ct][3]);
        s += __shfl_xor(s, 16); s += __shfl_xor(s, 32);
        if (fq == 0) red[wave * 128 + 16 * ct + fr] = s;
    }
    __syncthreads();
#pragma unroll
    for (int ct = 0; ct < 8; ++ct) {
        const int c = 16 * ct + fr;
        float s = 0.f;
#pragma unroll
        for (int w = 0; w < 8; ++w) s += red[w * 128 + c];
        const float rstd = rsqrtf(s * (1.f / 256.f) + 1e-6f);
        bf16_t* grow = proj + (tok0 + c) * INW + C_RG + h * 256;
#pragma unroll
        for (int et = 0; et < 2; ++et) {
            const int e = 32 * wave + 16 * et + 4 * fq;
            const u32x2 gw = *(const u32x2*)(grow + e);
            const f32x4 gg = *(const f32x4*)(gn + h * 256 + e);
            const float g0 = bflo(gw.x), g1 = bfhi(gw.x), g2 = bflo(gw.y), g3 = bfhi(gw.y);
            const float o0 = acc[et][ct][0] * rstd * gg.x * g0 * sigmoidf_(g0), o1 = acc[et][ct][1] * rstd * gg.y * g1 * sigmoidf_(g1);
            const float o2 = acc[et][ct][2] * rstd * gg.z * g2 * sigmoidf_(g2), o3 = acc[et][ct][3] * rstd * gg.w * g3 * sigmoidf_(g3);
            if (!dry) *(u32x2*)(grow + e) = (u32x2){cvt_pk_bf16(o0, o1), cvt_pk_bf16(o2, o3)};
        }
    }
    __syncthreads();
}

constexpr int SKP = 72, SVP = 264;
__device__ __forceinline__ void swa_item(bf16_t* proj, const float* sinks, int item, LAS unsigned char* lds, int tid, int dry) {
    const int wave = tid >> 6, lane = tid & 63, fr = lane & 15, fq = lane >> 4;
    const int kh = item & 1, n = (item >> 1) & 31, bl = item >> 6;
    const size_t tok0 = (size_t)bl * SEQ + n * 128;
    LAS bf16_t* Ks = (LAS bf16_t*)lds;
    LAS bf16_t* Vt = (LAS bf16_t*)(lds + 256 * SKP * 2);
#pragma unroll
    for (int i = 0; i < 4; ++i) {
        const int ch = tid + 512 * i, key = ch >> 3, part = ch & 7;
        u32x4 kv = (u32x4){0u, 0u, 0u, 0u}, vv = (u32x4){0u, 0u, 0u, 0u};
        if (n > 0 || key >= 128) { const bf16_t* r = proj + (tok0 + key - 128) * INW; kv = *(const u32x4*)(r + C_SK + kh * 64 + part * 8); vv = *(const u32x4*)(r + C_SV + kh * 64 + part * 8); }
        *(LAS u32x4*)(Ks + key * SKP + part * 8) = kv;
        const unsigned vw[4] = {vv.x, vv.y, vv.z, vv.w};
#pragma unroll
        for (int k = 0; k < 4; ++k) { const int d = part * 8 + 2 * k; Vt[d * SVP + key] = (bf16_t)(vw[k] & 0xffffu); Vt[(d + 1) * SVP + key] = (bf16_t)(vw[k] >> 16); }
    }
    __syncthreads();
    const int h = kh * 8 + wave; const float sink = sinks[h];
    for (int qt = 0; qt < 8; ++qt) {
        bf16_t* qrow = proj + (tok0 + 16 * qt + fr) * INW + C_SQ + h * 64;
        bf16x8 qf[2];
        qf[0] = *(const bf16x8*)(qrow + 8 * fq); qf[1] = *(const bf16x8*)(qrow + 32 + 8 * fq);
        f32x4 s[10];
#pragma unroll
        for (int r = 0; r < 9; ++r) { s[r] = (f32x4){0.f, 0.f, 0.f, 0.f};
#pragma unroll
            for (int ks = 0; ks < 2; ++ks) { const bf16x8 a = *(const LAS bf16x8*)(Ks + (16 * (qt + r) + fr) * SKP + 32 * ks + 8 * fq); s[r] = mfma16(a, qf[ks], s[r]); } }
        s[9] = (f32x4){0.f, 0.f, 0.f, 0.f};
        const int c = 16 * qt + fr; float mx = sink;
#pragma unroll
        for (int r = 0; r < 9; ++r) {
            const bool tile_ok = (n > 0) || (qt + r >= 8);
#pragma unroll
            for (int j = 0; j < 4; ++j) { const int kpos = 16 * (qt + r) + 4 * fq + j;
                bool valid = tile_ok;
                if (r == 0) valid = valid && (kpos > c);
                if (r == 8) valid = valid && (kpos <= c + 128);
                const float v = valid ? s[r][j] * 0.125f : -1e30f; s[r][j] = v; mx = fmaxf(mx, v); } }
        mx = fmaxf(mx, __shfl_xor(mx, 16)); mx = fmaxf(mx, __shfl_xor(mx, 32));
        float sum = 0.f;
#pragma unroll
        for (int r = 0; r < 9; ++r)
#pragma unroll
            for (int j = 0; j < 4; ++j) { const float pv = __expf(s[r][j] - mx); s[r][j] = pv; sum += pv; }
        sum += __shfl_xor(sum, 16); sum += __shfl_xor(sum, 32);
        sum += __expf(sink - mx);
        const float inv = 1.0f / sum;
        f32x4 o[4];
#pragma unroll
        for (int dt = 0; dt < 4; ++dt) o[dt] = (f32x4){0.f, 0.f, 0.f, 0.f};
#pragma unroll
        for (int k2 = 0; k2 < 5; ++k2) {
            u32x4 pw; pw.x = cvt_pk_bf16(s[2 * k2][0], s[2 * k2][1]); pw.y = cvt_pk_bf16(s[2 * k2][2], s[2 * k2][3]); pw.z = cvt_pk_bf16(s[2 * k2 + 1][0], s[2 * k2 + 1][1]); pw.w = cvt_pk_bf16(s[2 * k2 + 1][2], s[2 * k2 + 1][3]);
            const bf16x8 pf = __builtin_bit_cast(bf16x8, pw);
            const int kb = 16 * (qt + 2 * k2);
#pragma unroll
            for (int dt = 0; dt < 4; ++dt) {
                const u32x2 v0 = *(const LAS u32x2*)(Vt + (16 * dt + fr) * SVP + kb + 4 * fq), v1 = *(const LAS u32x2*)(Vt + (16 * dt + fr) * SVP + kb + (k2 == 4 ? 0 : 16) + 4 * fq);
                const bf16x8 a = __builtin_bit_cast(bf16x8, ((u32x4){v0.x, v0.y, v1.x, v1.y}));
                o[dt] = mfma16(a, pf, o[dt]);
            }
        }
#pragma unroll
        for (int dt = 0; dt < 4; ++dt) if (!dry) *(u32x2*)(qrow + 16 * dt + 4 * fq) = (u32x2){cvt_pk_bf16(o[dt][0] * inv, o[dt][1] * inv), cvt_pk_bf16(o[dt][2] * inv, o[dt][3] * inv)};
    }
    __syncthreads();
}

constexpr int MP = 264;
__device__ __forceinline__ void mem_item(bf16_t* proj, const bf16_t* mk, const bf16_t* mvT, int bglob0, int item, LAS unsigned char* lds, int tid, int dry) {
    const int wave = tid >> 6, lane = tid & 63, fr = lane & 15, fq = lane >> 4;
    const int qt = item & 31, h = (item >> 5) & 3, bl = item >> 7, b = bglob0 + bl;
    const size_t tok0 = (size_t)bl * SEQ + qt * 128;
    LAS bf16_t* Ms = (LAS bf16_t*)lds;
    {
        const bf16_t* src = mk + (size_t)b * 256 * 1024 + h * 256;
#pragma unroll 4
        for (int i = 0; i < 16; ++i) { const int ch = tid + 512 * i, row = ch >> 5, part = ch & 31; *(LAS u32x4*)(Ms + row * MP + part * 8) = *(const u32x4*)(src + (size_t)row * 1024 + part * 8); }
    }
    bf16_t* qrow = proj + (tok0 + 16 * wave + fr) * INW + C_MQ + h * 256;
    bf16x8 qf[8];
#pragma unroll
    for (int ks = 0; ks < 8; ++ks) qf[ks] = *(const bf16x8*)(qrow + 32 * ks + 8 * fq);
    __syncthreads();
    f32x4 s[16];
#pragma unroll
    for (int t = 0; t < 16; ++t) { s[t] = (f32x4){0.f, 0.f, 0.f, 0.f};
#pragma unroll
        for (int ks = 0; ks < 8; ++ks) { const bf16x8 a = *(const LAS bf16x8*)(Ms + (16 * t + fr) * MP + 32 * ks + 8 * fq); s[t] = mfma16(a, qf[ks], s[t]); } }
    float mx = -1e30f;
#pragma unroll
    for (int t = 0; t < 16; ++t)
#pragma unroll
        for (int j = 0; j < 4; ++j) { const float v = s[t][j] * 0.0625f; s[t][j] = v; mx = fmaxf(mx, v); }
    mx = fmaxf(mx, __shfl_xor(mx, 16)); mx = fmaxf(mx, __shfl_xor(mx, 32));
    float sum = 0.f;
#pragma unroll
    for (int t = 0; t < 16; ++t)
#pragma unroll
        for (int j = 0; j < 4; ++j) { const float pv = __expf(s[t][j] - mx); s[t][j] = pv; sum += pv; }
    sum += __shfl_xor(sum, 16); sum += __shfl_xor(sum, 32);
    const float inv = 1.0f / sum;
    bf16x8 pf[8];
#pragma unroll
    for (int k2 = 0; k2 < 8; ++k2) { u32x4 pw; pw.x = cvt_pk_bf16(s[2 * k2][0], s[2 * k2][1]); pw.y = cvt_pk_bf16(s[2 * k2][2], s[2 * k2][3]); pw.z = cvt_pk_bf16(s[2 * k2 + 1][0], s[2 * k2 + 1][1]); pw.w = cvt_pk_bf16(s[2 * k2 + 1][2], s[2 * k2 + 1][3]);
        pf[k2] = __builtin_bit_cast(bf16x8, pw); }
    __syncthreads();
    {
        const bf16_t* src = mvT + ((size_t)b * 1024 + h * 256) * 256;
#pragma unroll 4
        for (int i = 0; i < 16; ++i) { const int ch = tid + 512 * i, row = ch >> 5, part = ch & 31; *(LAS u32x4*)(Ms + row * MP + part * 8) = *(const u32x4*)(src + (size_t)row * 256 + part * 8); }
    }
    __syncthreads();
#pragma unroll
    for (int dt = 0; dt < 16; ++dt) {
        f32x4 o = (f32x4){0.f, 0.f, 0.f, 0.f};
#pragma unroll
        for (int k2 = 0; k2 < 8; ++k2) {
            const u32x2 v0 = *(const LAS u32x2*)(Ms + (16 * dt + fr) * MP + 32 * k2 + 4 * fq), v1 = *(const LAS u32x2*)(Ms + (16 * dt + fr) * MP + 32 * k2 + 16 + 4 * fq);
            const bf16x8 a = __builtin_bit_cast(bf16x8, ((u32x4){v0.x, v0.y, v1.x, v1.y}));
            o = mfma16(a, pf[k2], o);
        }
        if (!dry) *(u32x2*)(qrow + 16 * dt + 4 * fq) = (u32x2){cvt_pk_bf16(o[0] * inv, o[1] * inv), cvt_pk_bf16(o[2] * inv, o[3] * inv)};
    }
    __syncthreads();
}


#define XB_TMO      128
#define XB_XCNT(j)  (256  + 64 * (j))
#define XB_XSUB(j)  (1280 + 64 * (j))
#define XB_XGEN(j)  (2304 + 64 * (j))
#define XB_TOP      3328
#define XB_TOPGEN   3392
#define XCD_BAR_WORDS 3456
#define XB_SPIN_CAP (1u << 18)
__device__ __forceinline__ unsigned xb_ld(unsigned* p)              { return __hip_atomic_load(p, __ATOMIC_RELAXED, __HIP_MEMORY_SCOPE_AGENT); }
__device__ __forceinline__ unsigned xb_add(unsigned* p, unsigned v) { return __hip_atomic_fetch_add(p, v, __ATOMIC_RELAXED, __HIP_MEMORY_SCOPE_AGENT); }
__device__ __forceinline__ unsigned xb_xcc_id() { return (unsigned)__builtin_amdgcn_s_getreg((3 << 11) | 20) & 0xFu; }
#define XB_SPIN(cond, bar) do { unsigned _sp = 0; while (cond) { __builtin_amdgcn_s_sleep(1); \
    if ((++_sp & 255u) == 0u) { if (xb_ld(&(bar)[XB_TMO])) break; if (_sp > XB_SPIN_CAP) { atomicAdd(&(bar)[XB_TMO], 1u); break; } } } } while (0)
struct XcdBarrier { unsigned* bar; unsigned x; volatile LAS unsigned* st; };
__device__ __forceinline__ XcdBarrier xcd_barrier_post(unsigned* bar, volatile LAS unsigned* st) {
    XcdBarrier b; b.bar = bar; b.x = xb_xcc_id(); b.st = st;
    if (threadIdx.x == 0) (void)xb_add(&bar[XB_XCNT(b.x)], 1u);
    return b;
}
__device__ __forceinline__ void xcd_barrier_complete(unsigned* bar, unsigned x, unsigned& nloc, unsigned& nx) {
    const unsigned G = gridDim.x * gridDim.y * gridDim.z;
    unsigned sum, cnt, mine, sp = 0u;
    for (;;) {
        sum = 0u; cnt = 0u; mine = 0u;
#pragma unroll
        for (unsigned j = 0; j < 16; ++j) { const unsigned c = xb_ld(&bar[XB_XCNT(j)]); sum += c; cnt += (c > 0u) ? 1u : 0u; mine = (j == x) ? c : mine; }
        if (sum == G) break;
        __builtin_amdgcn_s_sleep(1);
        if ((++sp & 255u) == 0u) { if (xb_ld(&bar[XB_TMO])) break; if (sp > XB_SPIN_CAP) { atomicAdd(&bar[XB_TMO], 1u); break; } }
    }
    nloc = mine > 0u ? mine : 1u; nx = cnt > 0u ? cnt : 1u;
}
__device__ __forceinline__ void xcd_barrier(const XcdBarrier& b) {
    asm volatile("s_waitcnt vmcnt(0)" ::: "memory");
    __syncthreads();
    if (threadIdx.x == 0) {
        unsigned* bar = b.bar;
        __builtin_amdgcn_s_waitcnt(0);
        unsigned nloc = b.st[0], nx = b.st[1];
        if (nloc == 0u) { xcd_barrier_complete(bar, b.x, nloc, nx); b.st[0] = nloc; b.st[1] = nx; }
        const unsigned old = xb_add(&bar[XB_XSUB(b.x)], 1u);
        const unsigned gen = old / nloc;
        if (old + 1u == (gen + 1u) * nloc) {
            __builtin_amdgcn_fence(__ATOMIC_RELEASE, "agent");
            asm volatile("s_waitcnt vmcnt(0)" ::: "memory");
            const unsigned og = xb_add(&bar[XB_TOP], 1u);
            const unsigned tg = og / nx;
            if (og + 1u == (tg + 1u) * nx) xb_add(&bar[XB_TOPGEN], 1u);
            else XB_SPIN(xb_ld(&bar[XB_TOPGEN]) == tg, bar);
            __builtin_amdgcn_fence(__ATOMIC_ACQUIRE, "agent");
            xb_add(&bar[XB_XGEN(b.x)], 1u);
            asm volatile("s_waitcnt vmcnt(0)" ::: "memory");
        } else {
            XB_SPIN(xb_ld(&bar[XB_XGEN(b.x)]) == gen, bar);
            __builtin_amdgcn_fence(__ATOMIC_ACQUIRE, "agent");
            asm volatile("s_waitcnt vmcnt(0)" ::: "memory");
        }
    }
    __syncthreads();
}

__device__ __forceinline__ void run_phase(const Params& p, int ph, LAS unsigned char* lds, int dry) {
    int tid = threadIdx.x; asm volatile("" : "+v"(tid));
    const int lane = tid & 63, wave = tid >> 6;
    int G = gridDim.x, cu = blockIdx.x; asm volatile("" : "+s"(G), "+s"(cu));
    const int gw = cu * 8 + wave, ngw = G * 8;
    unsigned char* ws = p.ws; asm volatile("" : "+s"(ws));
    bf16_t* XB = (bf16_t*)p.out; asm volatile("" : "+s"(XB));
    const float* xin = p.in[0]; asm volatile("" : "+s"(xin));
    bf16_t* Hb = (bf16_t*)(ws + WS_H);
    if ((PHMASK & 1) && ph == NPH - 1) {
        for (int r = gw; r < T_ALL; r += ngw) rms_row_final(Hb + (size_t)r * DM, p.in[20], p.out + (size_t)r * DM, lane);
        return;
    }
    const int l = ph / NPL, k = ph - l * NPL;
    float* ssq1 = (float*)(ws + WS_SSQ); float* ssq2 = ssq1 + 4 * T_ALL; float* ssq3 = ssq2 + 4 * T_ALL;
    if (k == 0) {
        const size_t oFF = (size_t)l * DM * FF, oDD = (size_t)l * DM * DM;
        constexpr int I_F = 16 * 88, I_IN = 16 * 264, I_MKV = 16 * 64, I_DD = 16 * 32;
        constexpr int NIT = 6 * I_F + I_IN + I_MKV + 4 * I_DD;
        LAS float* scr = (LAS float*)(lds + wave * 8704);
        const float* g1 = p.in[2] + l * DM; const float* gm = p.in[6] + l * DM; const float* g2 = p.in[16] + l * DM; const float* gnone = nullptr;
        for (int it = gw; it < NIT; it += ngw) {
            int r = it;
            if (r < I_F) { wt_item(p.in[3] + oFF, DM, FF, (bf16_t*)(ws + WS_W13A), 1, r, scr, lane, g1); continue; } r -= I_F;
            if (r < I_F) { wt_item(p.in[4] + oFF, DM, FF, (bf16_t*)(ws + WS_W13A), 2, r, scr, lane, g1); continue; } r -= I_F;
            if (r < I_F) { wt_item(p.in[5] + oFF, FF, DM, (bf16_t*)(ws + WS_W2A), 0, r, scr, lane, gnone); continue; } r -= I_F;
            if (r < I_F) { wt_item(p.in[17] + oFF, DM, FF, (bf16_t*)(ws + WS_W13B), 1, r, scr, lane, g2); continue; } r -= I_F;
            if (r < I_F) { wt_item(p.in[18] + oFF, DM, FF, (bf16_t*)(ws + WS_W13B), 2, r, scr, lane, g2); continue; } r -= I_F;
            if (r < I_F) { wt_item(p.in[19] + oFF, FF, DM, (bf16_t*)(ws + WS_W2B), 0, r, scr, lane, gnone); continue; } r -= I_F;
            if (r < I_IN) { wt_item(p.in[7] + (size_t)l * DM * INW, DM, INW, (bf16_t*)(ws + WS_WIN), 0, r, scr, lane, gm); continue; } r -= I_IN;
            if (r < I_MKV) { wt_item(p.in[11] + (size_t)l * DM * 2048, DM, 2048, (bf16_t*)(ws + WS_WMKV), 0, r, scr, lane, gnone); continue; } r -= I_MKV;
            if (r < I_DD) { wt_item(p.in[12] + oDD, DM, DM, (bf16_t*)(ws + WS_WUP), 0, r, scr, lane, gnone); continue; } r -= I_DD;
            if (r < I_DD) { wt_item(p.in[13] + oDD, DM, DM, (bf16_t*)(ws + WS_WUP) + (size_t)DM * DM, 0, r, scr, lane, gnone); continue; } r -= I_DD;
            if (r < I_DD) { wt_item(p.in[14] + oDD, DM, DM, (bf16_t*)(ws + WS_WUP) + (size_t)2 * DM * DM, 0, r, scr, lane, gnone); continue; } r -= I_DD;
            wt_item(p.in[15] + oDD, DM, DM, (bf16_t*)(ws + WS_WO), 0, r, scr, lane, gnone);
        }
        for (int r = gw; r < 2048; r += ngw) rms_row_bf16(p.in[1] + (size_t)r * DM, p.in[10] + l * DM, (bf16_t*)(ws + WS_MEMH) + (size_t)r * DM, lane);
        if (l == 0) {
            for (int r = gw; r < T_ALL; r += ngw) {
                const f32x4* xr = (const f32x4*)(xin + (size_t)r * DM) + lane; u32x2* o8 = (u32x2*)(XB + (size_t)r * DM) + lane; float sacc = 0.f;
#pragma unroll
                for (int j = 0; j < 4; ++j) { const f32x4 v = xr[64 * j]; sacc += (v.x * v.x + v.y * v.y) + (v.z * v.z + v.w * v.w); o8[64 * j] = (u32x2){cvt_pk_bf16(v.x, v.y), cvt_pk_bf16(v.z, v.w)}; }
                sacc = wave_sum(sacc); if (lane == 0) *(f32x4*)(ssq1 + (size_t)r * 4) = (f32x4){sacc, 0.f, 0.f, 0.f};
            }
            f32x2* tab = (f32x2*)(ws + WS_TAB);
            for (int i = cu * 512 + tid; i < SEQ * 64; i += G * 512) {
                const int pos = i >> 6, j = i & 63;
                const float inv = exp2f(-(float)j * (13.287712379549449f / 64.f));
                const float ang = (float)pos * inv;
                double rr = (double)ang * 0.15915494309189535; rr -= rint(rr);
                const float rf = (float)rr;
                tab[i] = (f32x2){__builtin_amdgcn_cosf(rf), __builtin_amdgcn_sinf(rf)};
            }
        }
        return;
    }
    if (k == 1 || k == 14) {
        pg8::Gemm g; g.A = XB; g.Bt = (const bf16_t*)(ws + (k == 1 ? WS_W13A : WS_W13B)); g.M = T_ALL; g.N = 2 * FF; g.K = DM; g.lda = DM; g.zoff0 = g.zoff1 = g.zoff2 = 0; g.zB = 0;
        pg8::Order S; S.init(g.M, g.N, G, cu, 1);
        pg8::EpiSwiglu E; E.U = (bf16_t*)(ws + WS_U); E.ldu = FF; E.ssq = (k == 1) ? ssq1 : ssq3;
        pg8::gemm_phase(lds, g, S, E, tid);
        return;
    }
    if (k == 2 || k == 15 || k == 13) {
        pg8::Gemm g; pg8::EpiResid E; E.red = (LAS float*)(lds + pg8::STAGE_BYTES); g.zoff0 = g.zoff1 = g.zoff2 = 0; g.zB = 0; g.N = DM; g.M = T_ALL; E.ld = DM; E.src = XB; E.dst = XB;
        if (k == 2 || k == 15) {
            g.A = (const bf16_t*)(ws + WS_U); g.Bt = (const bf16_t*)(ws + (k == 2 ? WS_W2A : WS_W2B)); g.K = FF; g.lda = FF;
            E.scale = dry ? 0.f : 0.5f; E.ssq = (k == 2) ? ssq2 : ssq1;
            if (k == 15 && l == 1) E.dst = Hb;
        } else {
            g.A = Hb; g.Bt = (const bf16_t*)(ws + WS_WO); g.K = DM; g.lda = DM;
            E.scale = dry ? 0.f : 1.0f; E.ssq = ssq3;
        }
        pg8::Order S; S.init(g.M, g.N, G, cu, 1);
        pg8::gemm_phase(lds, g, S, E, tid);
        return;
    }
    const int half = (k - 3) / 5, s = (k - 3) - 5 * half;
    bf16_t* proj = (bf16_t*)(ws + WS_PROJ);
    bf16_t* states = (bf16_t*)(ws + WS_ST);
    const f32x2* tab = (const f32x2*)(ws + WS_TAB);
    if (s == 0) {
        pg8::Gemm g; g.A = XB + (size_t)half * T_HALF * DM; g.Bt = (const bf16_t*)(ws + WS_WIN); g.M = T_HALF; g.N = INW; g.K = DM; g.lda = DM; g.zoff0 = g.zoff1 = g.zoff2 = 0; g.zB = 0;
        pg8::Order S; S.init(g.M, g.N, G, cu, 1);
        pg8::EpiStore E; E.O = proj; E.ldc = INW; E.ssq = ssq2 + (size_t)half * T_HALF * 4;
        pg8::gemm_phase(lds, g, S, E, tid);
        if (half == 0) {
            pg8::Gemm g2; g2.A = (const bf16_t*)(ws + WS_MEMH); g2.Bt = (const bf16_t*)(ws + WS_WMKV); g2.M = 2048; g2.N = 2048; g2.K = DM; g2.lda = DM; g2.zoff0 = g2.zoff1 = g2.zoff2 = 0; g2.zB = 0;
            pg8::Order S2; S2.init(2048, 2048, G, (cu >= 64 && cu < 128) ? cu - 64 : G, 1);
            pg8::EpiMkv E2; E2.mk = (bf16_t*)(ws + WS_MK); E2.mvT = (bf16_t*)(ws + WS_MVT);
            pg8::gemm_phase(lds, g2, S2, E2, tid);
        }
        return;
    }
    if (s == 1) {
        for (int it = cu; it < 512; it += G) ret_state_item(proj, tab, states, it, lds, tid);
        for (int it = cu; it < 256; it += G) swa_item(proj, p.in[9] + l * 16, it, lds, tid, dry);
        for (int it = cu; it < 512; it += G) mem_item(proj, (const bf16_t*)(ws + WS_MK), (const bf16_t*)(ws + WS_MVT), half * 4, it, lds, tid, dry);
        return;
    }
    if (s == 2) { ret_scan(states, cu * 512 + tid, G * 512, dry); return; }
    if (s == 3) {
        for (int it = cu; it < 512; it += G) ret_out_item(proj, tab, states, p.in[8] + l * 1024, it, lds, tid, dry);
        return;
    }
    {
        pg8::Gemm g; g.A = proj; g.Bt = (const bf16_t*)(ws + WS_WUP); g.M = T_HALF; g.N = DM; g.K = DM; g.lda = INW; g.zoff0 = C_RG; g.zoff1 = C_SQ; g.zoff2 = C_MQ; g.zB = (long)DM * DM;
        pg8::Order S; S.init(g.M, g.N, G, cu, 3);
        pg8::EpiGate E; E.Mg = Hb + (size_t)half * T_HALF * DM; E.gl = proj + C_GL; E.ldg = INW;
        pg8::gemm_phase(lds, g, S, E, tid);
    }
}

__global__ __launch_bounds__(512, 2) void mega(Params p, int ph_lo, int ph_hi) {
    extern __shared__ __attribute__((aligned(16))) unsigned char shm[];
    LAS unsigned char* lds = (LAS unsigned char*)shm;
    cg::grid_group grid = cg::this_grid();
    volatile LAS unsigned* st = (volatile LAS unsigned*)(lds + LDS_PHASE);
    if (threadIdx.x == 0) { st[0] = 0u; st[1] = 0u; st[2] = 0u; st[3] = 0u; }
    __syncthreads();
    const XcdBarrier xb = xcd_barrier_post((unsigned*)(p.ws + WS_BAR), st);
    for (int ph = ph_lo; ph < ph_hi; ++ph) {
        int nrep = 1;
#if DBL_MASK
        { const int kk = (ph == NPH - 1) ? 16 : ph % NPL; nrep += (DBL_MASK >> kk) & 1; }
#endif
        for (int rep = 0; rep < nrep; ++rep) { int dry = rep; asm volatile("" : "+s"(dry)); run_phase(p, ph, lds, dry); if (rep + 1 < nrep) __syncthreads(); }
        if (ph + 1 < ph_hi) { if (ph_hi < 0) grid.sync(); else xcd_barrier(xb); }
    }
}

extern "C" void kernel_launch(void* const* d_in, const int* in_sizes, int n_in, void* d_out, int out_size, void* d_ws, size_t ws_size, hipStream_t stream) {
    static int grid = 0;
    if (grid == 0) {
        if (n_in != 21 || out_size != T_ALL * DM || ws_size < WS_END) { fprintf(stderr, "kernel_launch: unexpected shapes (n_in %d out %d ws %zu need %zu)\n", n_in, out_size, ws_size, (size_t)WS_END); grid = -1; return; }
        int dev = 0, cus = 0, per_cu = 0;
        if (hipGetDevice(&dev) != hipSuccess || hipDeviceGetAttribute(&cus, hipDeviceAttributeMultiprocessorCount, dev) != hipSuccess) { grid = -1; return; }
        if (hipFuncSetAttribute((const void*)mega, hipFuncAttributeMaxDynamicSharedMemorySize, LDS_BYTES) != hipSuccess) { fprintf(stderr, "kernel_launch: hipFuncSetAttribute failed\n"); grid = -1; return; }
        if (hipOccupancyMaxActiveBlocksPerMultiprocessor(&per_cu, (const void*)mega, 512, LDS_BYTES) != hipSuccess || per_cu < 1) { fprintf(stderr, "kernel_launch: occupancy query says %d\n", per_cu); per_cu = 1; }
        (void)hipGetLastError();
        grid = cus;
    }
    if (grid <= 0) return;
    Params p{};
    for (int i = 0; i < 21; ++i) p.in[i] = (const float*)d_in[i];
    p.out = (float*)d_out; p.ws = (unsigned char*)d_ws;
    (void)hipMemsetAsync((unsigned char*)d_ws + WS_BAR, 0, 16384, stream);
#if MK_ONE_LAUNCH
    int lo = 0, hi = NPH;
    void* args[] = {&p, &lo, &hi};
    hipError_t e = hipLaunchCooperativeKernel((const void*)mega, dim3(grid), dim3(512), args, LDS_BYTES, stream);
    if (e != hipSuccess) fprintf(stderr, "cooperative launch failed: %s (grid %d)\n", hipGetErrorString(e), grid);
#else
    for (int ph = 0; ph < NPH; ++ph) hipLaunchKernelGGL(mega, dim3(grid), dim3(512), LDS_BYTES, stream, p, ph, ph + 1);
#endif
}
```

```cpp
#include <hip/hip_runtime.h>
#include <hip/hip_cooperative_groups.h>
#include <cstdio>
#include <cstdint>
namespace cg = cooperative_groups;

#ifndef MK_ONE_LAUNCH
#define MK_ONE_LAUNCH 1
#endif

#ifndef DBL_MASK
#define DBL_MASK 0
#endif
#ifndef PHMASK
#define PHMASK 0xffff
#endif
#define LAS __attribute__((address_space(3)))
typedef unsigned short bf16_t;
typedef short bf16x8 __attribute__((ext_vector_type(8)));
typedef short bf16x4 __attribute__((ext_vector_type(4)));
typedef float f32x4 __attribute__((ext_vector_type(4)));
typedef float f32x2 __attribute__((ext_vector_type(2)));
typedef unsigned u32x4 __attribute__((ext_vector_type(4)));
typedef unsigned u32x2 __attribute__((ext_vector_type(2)));

constexpr int T_ALL = 32768, DM = 1024, FF = 2816, INW = 8448, T_HALF = 16384, SEQ = 4096;
constexpr int C_RQ = 0, C_RK = 512, C_RV = 1024, C_RG = 2048, C_SQ = 3072, C_SK = 4096, C_SV = 4224, C_MQ = 4352, C_GL = 5376;
constexpr int LDS_PHASE = 143360, LDS_BYTES = LDS_PHASE + 16;
constexpr int NPL = 16, NPH = 2 * NPL + 1;

constexpr size_t SZ_W13 = (size_t)2 * FF * DM * 2, SZ_W2 = (size_t)DM * FF * 2;
constexpr size_t WS_W13A = 0, WS_W2A = WS_W13A + SZ_W13, WS_W13B = WS_W2A + SZ_W2, WS_W2B = WS_W13B + SZ_W13;
constexpr size_t WS_WIN = WS_W2B + SZ_W2, WS_WMKV = WS_WIN + (size_t)INW * DM * 2, WS_WUP = WS_WMKV + (size_t)2048 * DM * 2;
constexpr size_t WS_WO = WS_WUP + (size_t)3 * DM * DM * 2, WS_TAB = WS_WO + (size_t)DM * DM * 2;
constexpr size_t WS_MEMH = WS_TAB + (size_t)SEQ * 64 * 8, WS_MK = WS_MEMH + (size_t)2048 * DM * 2, WS_MVT = WS_MK + (size_t)2048 * DM * 2;
constexpr size_t WS_H = WS_MVT + (size_t)2048 * DM * 2, WS_TMP = WS_H + (size_t)T_ALL * DM * 2;
constexpr size_t WS_U = WS_TMP, WS_PROJ = WS_TMP, WS_ST = WS_PROJ + (size_t)T_HALF * INW * 2;
constexpr size_t WS_BAR = WS_ST + (size_t)512 * 32768 * 4;
constexpr size_t WS_SSQ = WS_BAR + 16384;
constexpr size_t WS_END = WS_SSQ + (size_t)3 * T_ALL * 16;
constexpr size_t WS_GL2 = WS_END;
constexpr size_t WS_END2 = WS_GL2 + (size_t)T_ALL * 256 * 2;
constexpr size_t WS_XB3 = WS_TMP + (size_t)192 * 1024 * 1024;

struct Params {
    const float* in[21];
    float* out;
    unsigned char* ws;
};

__device__ __forceinline__ unsigned cvt_pk_bf16(float lo, float hi) { unsigned r; asm volatile("v_cvt_pk_bf16_f32 %0, %1, %2" : "=v"(r) : "v"(lo), "v"(hi)); return r; }
__device__ __forceinline__ bf16_t f2bf(float f) { return (bf16_t)(cvt_pk_bf16(f, 0.f) & 0xffffu); }
__device__ __forceinline__ float bf2f(unsigned b) { return __uint_as_float(b << 16); }
__device__ __forceinline__ float bflo(unsigned w) { return __uint_as_float(w << 16); }
__device__ __forceinline__ float bfhi(unsigned w) { return __uint_as_float(w & 0xffff0000u); }
__device__ __forceinline__ float wave_sum(float v) {
#pragma unroll
    for (int o = 1; o < 64; o <<= 1) v += __shfl_xor(v, o);
    return v;
}
__device__ __forceinline__ f32x4 zero4() {
    typedef double f64x2 __attribute__((ext_vector_type(2)));
    double lo, hi;
    asm volatile("v_mov_b64 %0, 0" : "=v"(lo));
    asm volatile("v_mov_b64 %0, 0" : "=v"(hi));
    return __builtin_bit_cast(f32x4, ((f64x2){lo, hi}));
}
__device__ __forceinline__ f32x4 mfma16(bf16x8 a, bf16x8 b, f32x4 c) { return __builtin_amdgcn_mfma_f32_16x16x32_bf16(a, b, c, 0, 0, 0); }
__device__ __forceinline__ float sigmoidf_(float x) { return __builtin_amdgcn_rcpf(1.0f + __builtin_amdgcn_exp2f(x * -1.4426950408889634f)); }
__device__ __forceinline__ float log2g(int h) { return h == 0 ? -0.04580368961312479f : h == 1 ? -0.02272007650008353f : h == 2 ? -0.011315313227834146f : -0.005646563141142063f; }

namespace pg8 {
constexpr int BM = 256, BK = 64, HALF = 128, HTB = HALF * BK * 2, STAGE_BYTES = 8 * HTB, NXCD = 8, WGM = 8;
__host__ __device__ __forceinline__ int lds_byte(int r, int c) { const int st = (r >> 4) * 2 + (c >> 5), rr = r & 15, cc = c & 31, ob = rr * 64 + cc * 2; return st * 1024 + (ob ^ (((ob >> 9) & 1) << 5)); }
__host__ __device__ __forceinline__ void stage_rc(int b, int& R, int& C) { const int st = b / 1024, sb = b % 1024, swz = sb ^ (((sb >> 9) & 1) << 5); R = (st >> 1) * 16 + swz / 64; C = (st & 1) * 32 + (swz % 64) / 2; }
__host__ __device__ __forceinline__ int perm32(int rho) { const int n = rho >> 4, i = rho & 15; return 8 * (i >> 2) + 4 * n + (i & 3); }

struct Unit { int pm, pn, z, idx; };
struct Gemm { const bf16_t* A; const bf16_t* Bt; int M, N, K, lda; int zoff0, zoff1, zoff2; long zB; };

struct Order {
    int nM, nN, nwg, G, c, nZ, rev;
    __device__ void init(int M, int N, int G_, int c_, int nZ_, int rev_ = 0) { nM = M / BM; nN = N / BM; nwg = nM * nN; G = G_; c = c_; nZ = nZ_; rev = rev_; }
    __device__ bool next(int i, Unit& u) const {
        int rnd = i, z = 0;
        if (nZ == 3) { rnd = i / 3; z = i - 3 * rnd; }
        u.z = z; u.idx = i;
        const long L = (long)rnd * G + c; if (L >= nwg) return false;
        int wgid = (int)L; { const int q = nwg / NXCD, r = nwg % NXCD, xcd = wgid % NXCD, off = wgid / NXCD; wgid = (xcd < r ? xcd * (q + 1) : r * (q + 1) + (xcd - r) * q) + off; }
        const int nig = WGM * nN, gid = wgid / nig, fm = gid * WGM, gsz = (nM - fm) < WGM ? (nM - fm) : WGM;
        u.pm = fm + ((wgid % nig) % gsz); u.pn = (wgid % nig) / gsz;
        if (rev & 1) u.pm = nM - 1 - u.pm;
        if (rev & 2) u.pn = nN - 1 - u.pn;
        return true;
    }
};

struct EpiStore {
    static constexpr bool PERM = true; static constexpr int NST = 16;
    bf16_t* O; int ldc; const LAS float* rtab;
    __device__ __forceinline__ void operator()(const f32x4 (&acc)[2][2][4][2], const Unit& u, int wr, int wc, int fr, int fq) const {
        const int row0 = u.pm * BM + wr * 64 + fr, col0 = u.pn * BM + wc * 32 + 8 * fq;
        const LAS float* rt = rtab + u.idx * 256 + wr * 64 + fr;
#pragma unroll
        for (int ai = 0; ai < 2; ++ai)
#pragma unroll
            for (int m = 0; m < 4; ++m) { bf16_t* rowp = O + (size_t)(row0 + ai * HALF + m * 16) * ldc + col0;
                const float rs = rt[ai * HALF + m * 16];
#pragma unroll
                for (int bj = 0; bj < 2; ++bj) { const f32x4 v0 = acc[ai][bj][m][0] * rs, v1 = acc[ai][bj][m][1] * rs;
                    u32x4 w; w.x = cvt_pk_bf16(v0[0], v0[1]); w.y = cvt_pk_bf16(v0[2], v0[3]); w.z = cvt_pk_bf16(v1[0], v1[1]); w.w = cvt_pk_bf16(v1[2], v1[3]);
                    *(u32x4*)(rowp + bj * HALF) = w; } }
    }
};
struct EpiSwiglu {
    static constexpr bool PERM = true; static constexpr int NST = 8;
    bf16_t* U; int ldu; const LAS float* rtab;
    __device__ __forceinline__ void operator()(const f32x4 (&acc)[2][2][4][2], const Unit& u, int wr, int wc, int fr, int fq) const {
        const int row0 = u.pm * BM + wr * 64 + fr, col0 = u.pn * 128 + wc * 32 + 8 * fq;
        const LAS float* rt = rtab + u.idx * 256 + wr * 64 + fr;
#pragma unroll
        for (int ai = 0; ai < 2; ++ai)
#pragma unroll
            for (int m = 0; m < 4; ++m) { bf16_t* rowp = U + (size_t)(row0 + ai * HALF + m * 16) * ldu + col0;
                const float rs = rt[ai * HALF + m * 16];
                const float ke = rs * -1.4426950408889634f, rs2 = rs * rs;
                float r[8];
#pragma unroll
                for (int n = 0; n < 2; ++n) { const f32x4 a = acc[ai][0][m][n], b = acc[ai][1][m][n];
                    const f32x4 ab = a * b * rs2, ea = a * ke;
#pragma unroll
                    for (int j = 0; j < 4; ++j) r[4 * n + j] = ab[j] * __builtin_amdgcn_rcpf(1.0f + __builtin_amdgcn_exp2f(ea[j])); }
                *(u32x4*)rowp = (u32x4){cvt_pk_bf16(r[0], r[1]), cvt_pk_bf16(r[2], r[3]), cvt_pk_bf16(r[4], r[5]), cvt_pk_bf16(r[6], r[7])}; }
    }
};
struct EpiResid {
    static constexpr bool PERM = true; static constexpr int NST = 16;
    const bf16_t* src; bf16_t* dst; float* ssq; int ld; float scale; LAS float* red;
    __device__ __forceinline__ void operator()(const f32x4 (&acc)[2][2][4][2], const Unit& u, int wr, int wc, int fr, int fq) const {
        const int row0 = u.pm * BM + wr * 64 + fr, col0 = u.pn * BM + wc * 32 + 8 * fq;
        float ssr[2][4];
#pragma unroll
        for (int ai = 0; ai < 2; ++ai) {
            u32x4 sv[4][2];
#pragma unroll
            for (int m = 0; m < 4; ++m)
#pragma unroll
                for (int bj = 0; bj < 2; ++bj) sv[m][bj] = *(const u32x4*)(src + (size_t)(row0 + ai * HALF + m * 16) * ld + col0 + bj * HALF);
#pragma unroll
            for (int m = 0; m < 4; ++m) { const size_t ro = (size_t)(row0 + ai * HALF + m * 16) * ld + col0; float ss = 0.f;
#pragma unroll
                for (int bj = 0; bj < 2; ++bj) { const u32x4 w = sv[m][bj]; const f32x4 a0 = acc[ai][bj][m][0], a1 = acc[ai][bj][m][1];
                    const float v0 = bflo(w.x) + a0[0] * scale, v1 = bfhi(w.x) + a0[1] * scale, v2 = bflo(w.y) + a0[2] * scale, v3 = bfhi(w.y) + a0[3] * scale;
                    const float v4 = bflo(w.z) + a1[0] * scale, v5 = bfhi(w.z) + a1[1] * scale, v6 = bflo(w.w) + a1[2] * scale, v7 = bfhi(w.w) + a1[3] * scale;
                    *(u32x4*)(dst + ro + bj * HALF) = (u32x4){cvt_pk_bf16(v0, v1), cvt_pk_bf16(v2, v3), cvt_pk_bf16(v4, v5), cvt_pk_bf16(v6, v7)};
                    ss += ((v0 * v0 + v1 * v1) + (v2 * v2 + v3 * v3)) + ((v4 * v4 + v5 * v5) + (v6 * v6 + v7 * v7)); }
                ssr[ai][m] = ss; }
        }
        float t1[2][4];
#pragma unroll
        for (int ai = 0; ai < 2; ++ai)
#pragma unroll
            for (int m = 0; m < 4; ++m) t1[ai][m] = __shfl_xor(ssr[ai][m], 16);
#pragma unroll
        for (int ai = 0; ai < 2; ++ai)
#pragma unroll
            for (int m = 0; m < 4; ++m) ssr[ai][m] += t1[ai][m];
#pragma unroll
        for (int ai = 0; ai < 2; ++ai)
#pragma unroll
            for (int m = 0; m < 4; ++m) t1[ai][m] = __shfl_xor(ssr[ai][m], 32);
#pragma unroll
        for (int ai = 0; ai < 2; ++ai)
#pragma unroll
            for (int m = 0; m < 4; ++m) if (fq == 0) red[(ai * HALF + wr * 64 + m * 16 + fr) * 4 + wc] = ssr[ai][m] + t1[ai][m];
        asm volatile("s_waitcnt lgkmcnt(0)" ::: "memory"); __builtin_amdgcn_s_barrier(); asm volatile("" ::: "memory");
        const int t = (wr * 4 + wc) * 64 + fq * 16 + fr;
        if (t < 256) { const f32x4 q = *(const LAS f32x4*)(red + t * 4); ssq[(size_t)(u.pm * BM + t) * 4 + u.pn] = (q.x + q.y) + (q.z + q.w); }
    }
};
struct EpiGate {
    static constexpr bool PERM = true; static constexpr int NST = 16;
    bf16_t* Mg; const bf16_t* gl; int ldg; const bf16_t* gl2;
    __device__ __forceinline__ void operator()(const f32x4 (&acc)[2][2][4][2], const Unit& u, int wr, int wc, int fr, int fq) const {
        const int row0 = u.pm * BM + wr * 64 + fr, col0 = u.pn * BM + wc * 32 + 8 * fq;
#pragma unroll
        for (int ai = 0; ai < 2; ++ai)
#pragma unroll
            for (int m = 0; m < 4; ++m) { const int row = row0 + ai * HALF + m * 16;
                bf16_t* mp = Mg + (size_t)row * 1024 + col0;
                const bf16_t* gp = (u.z == 2 && u.pn == 3) ? gl2 + (size_t)row * 256 + (col0 - 768) : gl + (size_t)row * ldg + u.z * 1024 + col0;
#pragma unroll
                for (int bj = 0; bj < 2; ++bj) { const f32x4 v0 = acc[ai][bj][m][0], v1 = acc[ai][bj][m][1];
                    const u32x4 g = *(const u32x4*)(gp + bj * HALF);
                    u32x4 o = (u32x4){0u, 0u, 0u, 0u};
                    if (u.z > 0) o = *(const u32x4*)(mp + bj * HALF);
                    float r[8];
                    r[0] = bflo(o.x) + sigmoidf_(bflo(g.x)) * v0[0]; r[1] = bfhi(o.x) + sigmoidf_(bfhi(g.x)) * v0[1];
                    r[2] = bflo(o.y) + sigmoidf_(bflo(g.y)) * v0[2]; r[3] = bfhi(o.y) + sigmoidf_(bfhi(g.y)) * v0[3];
                    r[4] = bflo(o.z) + sigmoidf_(bflo(g.z)) * v1[0]; r[5] = bfhi(o.z) + sigmoidf_(bfhi(g.z)) * v1[1];
                    r[6] = bflo(o.w) + sigmoidf_(bflo(g.w)) * v1[2]; r[7] = bfhi(o.w) + sigmoidf_(bfhi(g.w)) * v1[3];
                    u32x4 w; w.x = cvt_pk_bf16(r[0], r[1]); w.y = cvt_pk_bf16(r[2], r[3]); w.z = cvt_pk_bf16(r[4], r[5]); w.w = cvt_pk_bf16(r[6], r[7]);
                    *(u32x4*)(mp + bj * HALF) = w; } }
    }
};
struct EpiMkv {
    static constexpr bool PERM = true; static constexpr int NST = 16;
    bf16_t* mk; bf16_t* mvT;
    __device__ __forceinline__ void operator()(const f32x4 (&acc)[2][2][4][2], const Unit& u, int wr, int wc, int fr, int fq) const {
        const int row0 = u.pm * BM + wr * 64 + fr, col0 = u.pn * BM + wc * 32 + 8 * fq;
#pragma unroll
        for (int ai = 0; ai < 2; ++ai)
#pragma unroll
            for (int m = 0; m < 4; ++m) { const int row = row0 + ai * HALF + m * 16;
#pragma unroll
                for (int bj = 0; bj < 2; ++bj) { const f32x4 v0 = acc[ai][bj][m][0], v1 = acc[ai][bj][m][1]; const int col = col0 + bj * HALF;
                    if (u.pn < 4) {
                        u32x4 w; w.x = cvt_pk_bf16(v0[0], v0[1]); w.y = cvt_pk_bf16(v0[2], v0[3]); w.z = cvt_pk_bf16(v1[0], v1[1]); w.w = cvt_pk_bf16(v1[2], v1[3]);
                        *(u32x4*)(mk + (size_t)row * 1024 + col) = w;
                    } else {
                        const int b = row >> 8, mem = row & 255; bf16_t* base = mvT + ((size_t)b * 1024 + (col - 1024)) * 256 + mem;
#pragma unroll
                        for (int j = 0; j < 4; ++j) { base[(size_t)j * 256] = f2bf(v0[j]); base[(size_t)(4 + j) * 256] = f2bf(v1[j]); }
                    } } }
    }
};

template <class Epi>
__device__ __forceinline__ void gemm_phase(LAS unsigned char* lds, const Gemm g, const Order& S, const Epi& E, const int tid) {
    const int wid = __builtin_amdgcn_readfirstlane(tid >> 6), lane = tid & 63, wr = wid >> 2, wc = wid & 3, fr = lane & 15, fq = lane >> 4;
    const int K = g.K, nt = K / BK, lda = g.lda;
    unsigned voffA[2], voffB[2];
#pragma unroll
    for (int i = 0; i < 2; ++i) { int R, C; stage_rc(tid * 16 + i * 8192, R, C); const int Rb = Epi::PERM ? ((R & ~31) + perm32(R & 31)) : R;
        voffA[i] = (unsigned)(R * lda + C) * 2u; voffB[i] = (unsigned)(Rb * K + C) * 2u; }
    const size_t kstep = (size_t)(BK * 2);
    const size_t hstepA = (size_t)HALF * lda * 2, hstepB = (size_t)HALF * K * 2;
    const size_t tstepA = 2 * hstepA, tstepB = 2 * hstepB;
    const unsigned ldsw = (unsigned)wid * 1024u;
    const int aoff = lds_byte(wr * 64 + fr, fq * 8), boff = lds_byte(wc * 32 + fr, fq * 8);
#define PG8_SA(b, h) (((b) * 2 + (h)) * HTB)
#define PG8_SB(b, h) ((4 + (b) * 2 + (h)) * HTB)
#define PG8_STAGE(bufoff, gbase, voff) do { _Pragma("unroll") for (int _i = 0; _i < 2; ++_i) \
        __builtin_amdgcn_global_load_lds((const unsigned*)((const char*)(gbase) + (voff)[_i]), (LAS unsigned*)(lds + (bufoff) + ldsw + _i * 8192), 16, 0, 0); } while (0)
#define PG8_LDA(dst, b, h) do { _Pragma("unroll") for (int m = 0; m < 4; ++m) _Pragma("unroll") for (int k = 0; k < 2; ++k) dst[m][k] = *(const LAS bf16x8*)(lds + PG8_SA(b, h) + aoff + m * 2048 + k * 1024); } while (0)
#define PG8_LDB(dst, b, h) do { _Pragma("unroll") for (int n = 0; n < 2; ++n) _Pragma("unroll") for (int k = 0; k < 2; ++k) dst[n][k] = *(const LAS bf16x8*)(lds + PG8_SB(b, h) + boff + n * 2048 + k * 1024); } while (0)
#define PG8_MMA(ai, bj, At, Bt) do { __builtin_amdgcn_s_setprio(1); _Pragma("unroll") for (int m = 0; m < 4; ++m) _Pragma("unroll") for (int n = 0; n < 2; ++n) _Pragma("unroll") for (int k = 0; k < 2; ++k) \
        acc[ai][bj][m][n] = __builtin_amdgcn_mfma_f32_16x16x32_bf16(Bt[n][k], At[m][k], acc[ai][bj][m][n], 0, 0, 0); __builtin_amdgcn_s_setprio(0); } while (0)
#define PG8_WAIT_V(n) asm volatile("s_waitcnt vmcnt(" #n ")" ::: "memory")
#define PG8_WAIT_L(n) asm volatile("s_waitcnt lgkmcnt(" #n ")" ::: "memory")
#define PG8_WAIT_V_RX(rx) do { if constexpr (Epi::NST >= 16) asm volatile("s_cmp_lg_u32 %0, 0\n\ts_cbranch_scc1 .Lrx_skip_%=\n\ts_waitcnt vmcnt(8)\n.Lrx_skip_%=:\n\ts_waitcnt vmcnt(24)" :: "s"(rx) : "memory", "scc"); \
        else asm volatile("s_cmp_lg_u32 %0, 0\n\ts_cbranch_scc1 .Lrx_skip_%=\n\ts_waitcnt vmcnt(8)\n.Lrx_skip_%=:\n\ts_waitcnt vmcnt(16)" :: "s"(rx) : "memory", "scc"); } while (0)
#define PG8_BAR __builtin_amdgcn_s_barrier()
#define PG8_SCHED __builtin_amdgcn_sched_barrier(0)
#define PG8_ABASE(u) ((const char*)g.A + (size_t)((u).z == 0 ? g.zoff0 : (u).z == 1 ? g.zoff1 : g.zoff2) * 2 + (size_t)(u).pm * tstepA)
#define PG8_BBASE(u) ((const char*)g.Bt + (size_t)((u).z * g.zB) * 2 + (size_t)(u).pn * tstepB)
    Unit cur, nxt; int ui = 0;
    if (!S.next(0, cur)) return;
    f32x4 acc[2][2][4][2];
#pragma unroll
    for (int a = 0; a < 2; ++a)
#pragma unroll
        for (int b = 0; b < 2; ++b)
#pragma unroll
            for (int m = 0; m < 4; ++m)
#pragma unroll
                for (int n = 0; n < 2; ++n) acc[a][b][m][n] = (f32x4){0.f, 0.f, 0.f, 0.f};
    bf16x8 At[4][2], B0[2][2], B1[2][2];
    const long klast = (long)(nt - 1) * (long)kstep;
    long cs = (cur.idx & 1) ? -(long)kstep : (long)kstep;
    const char* cA = PG8_ABASE(cur) + ((cur.idx & 1) ? klast : 0); const char* cB = PG8_BBASE(cur) + ((cur.idx & 1) ? klast : 0);
    PG8_STAGE(PG8_SB(0, 0), cB, voffB); PG8_STAGE(PG8_SB(0, 1), cB + hstepB, voffB); PG8_STAGE(PG8_SA(0, 0), cA, voffA); PG8_STAGE(PG8_SA(0, 1), cA + hstepA, voffA);
    if (wr == 1) PG8_BAR;
    PG8_WAIT_V(2); PG8_BAR;
    PG8_STAGE(PG8_SB(1, 0), cB + cs, voffB); PG8_STAGE(PG8_SA(1, 0), cA + cs, voffA); PG8_STAGE(PG8_SB(1, 1), cB + hstepB + cs, voffB);
    PG8_WAIT_V(6); PG8_BAR;
    for (;;) {
        const bool has_next = S.next(ui + 1, nxt);
        const bool nrev = has_next && (nxt.idx & 1);
        const long ns = has_next ? (nrev ? -(long)kstep : (long)kstep) : cs;
        const char* nA = has_next ? PG8_ABASE(nxt) + (nrev ? klast : 0) : cA; const char* nB = has_next ? PG8_BBASE(nxt) + (nrev ? klast : 0) : cB;
        for (int t = 0; t < nt; t += 2) {
            const bool last = (t == nt - 2);
            const char* a1 = cA + (long)(t + 1) * cs;
            const char* a2 = last ? nA : cA + (long)(t + 2) * cs; const char* b2 = last ? nB : cB + (long)(t + 2) * cs;
            const char* a3 = a2 + (last ? ns : cs); const char* b3 = b2 + (last ? ns : cs);
            const int rx = __builtin_amdgcn_readfirstlane(((t == 0) && (ui > 0)) ? 1 : 0);
            PG8_LDB(B0, 0, 0); PG8_LDB(B1, 0, 1); PG8_SCHED; PG8_LDA(At, 0, 0); PG8_STAGE(PG8_SA(1, 1), a1 + hstepA, voffA);
            PG8_WAIT_V_RX(rx);
            PG8_WAIT_L(0); PG8_BAR; PG8_MMA(0, 0, At, B0); PG8_MMA(0, 1, At, B1); PG8_BAR; PG8_SCHED;
            PG8_LDA(At, 0, 1); PG8_STAGE(PG8_SB(0, 0), b2, voffB); PG8_STAGE(PG8_SB(0, 1), b2 + hstepB, voffB); PG8_STAGE(PG8_SA(0, 0), a2, voffA);
            PG8_WAIT_V_RX(rx);
            PG8_WAIT_L(0); PG8_BAR; PG8_MMA(1, 0, At, B0); PG8_MMA(1, 1, At, B1); PG8_BAR; PG8_SCHED;
            PG8_LDB(B0, 1, 0); PG8_LDB(B1, 1, 1); PG8_SCHED; PG8_LDA(At, 1, 0); PG8_STAGE(PG8_SA(0, 1), a2 + hstepA, voffA);
            PG8_WAIT_V(8); PG8_WAIT_L(0); PG8_BAR; PG8_MMA(0, 0, At, B0); PG8_MMA(0, 1, At, B1); PG8_BAR; PG8_SCHED;
            PG8_LDA(At, 1, 1); PG8_STAGE(PG8_SB(1, 0), b3, voffB); PG8_STAGE(PG8_SB(1, 1), b3 + hstepB, voffB); PG8_STAGE(PG8_SA(1, 0), a3, voffA);
            PG8_WAIT_V(8); PG8_WAIT_L(0); PG8_BAR; PG8_MMA(1, 0, At, B0); PG8_MMA(1, 1, At, B1); PG8_BAR; PG8_SCHED;
        }
        if (wr == 0) PG8_BAR;
        E(acc, cur, wr, wc, fr, fq);
        if (!has_next) break;
#pragma unroll
        for (int a = 0; a < 2; ++a)
#pragma unroll
            for (int b = 0; b < 2; ++b)
#pragma unroll
                for (int m = 0; m < 4; ++m)
#pragma unroll
                    for (int n = 0; n < 2; ++n) acc[a][b][m][n] = zero4();
        cur = nxt; cA = nA; cB = nB; cs = ns; ++ui;
        if (wr == 1) PG8_BAR;
    }
    PG8_WAIT_V(0);
    PG8_BAR;
#undef PG8_SA
#undef PG8_SB
#undef PG8_STAGE
#undef PG8_LDA
#undef PG8_LDB
#undef PG8_MMA
#undef PG8_WAIT_V
#undef PG8_WAIT_L
#undef PG8_WAIT_V_RX
#undef PG8_BAR
#undef PG8_SCHED
#undef PG8_ABASE
#undef PG8_BBASE
}
}

__device__ __forceinline__ void rms_row_bf16(const float* xrow, const float* g, bf16_t* orow, int lane) {
    const f32x4* xr = (const f32x4*)xrow + lane; const f32x4* gr = (const f32x4*)g + lane;
    f32x4 v[4]; float s = 0.f;
#pragma unroll
    for (int j = 0; j < 4; ++j) { v[j] = xr[64 * j]; s += (v[j].x * v[j].x + v[j].y * v[j].y) + (v[j].z * v[j].z + v[j].w * v[j].w); }
    const float rstd = rsqrtf(wave_sum(s) * (1.f / 1024.f) + 1e-6f);
    u32x2* o8 = (u32x2*)orow + lane;
#pragma unroll
    for (int j = 0; j < 4; ++j) { const f32x4 gg = gr[64 * j]; u32x2 w; w.x = cvt_pk_bf16(v[j].x * rstd * gg.x, v[j].y * rstd * gg.y); w.y = cvt_pk_bf16(v[j].z * rstd * gg.z, v[j].w * rstd * gg.w); o8[64 * j] = w; }
}
__device__ __forceinline__ void rms_row_final(const bf16_t* xrow, const float* g, float* orow, int lane) {
    const u32x4 a = *((const u32x4*)xrow + lane), b = *((const u32x4*)xrow + 64 + lane);
    float v[16] = {bflo(a.x), bfhi(a.x), bflo(a.y), bfhi(a.y), bflo(a.z), bfhi(a.z), bflo(a.w), bfhi(a.w), bflo(b.x), bfhi(b.x), bflo(b.y), bfhi(b.y), bflo(b.z), bfhi(b.z), bflo(b.w), bfhi(b.w)};
    float s = 0.f;
#pragma unroll
    for (int j = 0; j < 16; ++j) s += v[j] * v[j];
    const float rstd = rsqrtf(wave_sum(s) * (1.f / 1024.f) + 1e-6f);
#pragma unroll
    for (int hh = 0; hh < 2; ++hh)
#pragma unroll
        for (int q = 0; q < 2; ++q) { const int e = hh * 512 + lane * 8 + q * 4; const f32x4 gg = *(const f32x4*)(g + e);
            *(f32x4*)(orow + e) = (f32x4){v[hh * 8 + q * 4 + 0] * rstd * gg.x, v[hh * 8 + q * 4 + 1] * rstd * gg.y, v[hh * 8 + q * 4 + 2] * rstd * gg.z, v[hh * 8 + q * 4 + 3] * rstd * gg.w}; }
}

__device__ __forceinline__ void wt_item(const float* W, int K, int N, bf16_t* WT, int mode, int item, LAS float* scr, int lane, const float* gain) {
    const int nblk = N >> 6, kb = item / nblk, nb = item - kb * nblk, k0 = kb * 64, n0 = nb * 64;
#pragma unroll 16
    for (int kk = 0; kk < 64; ++kk) scr[kk * 65 + lane] = __builtin_nontemporal_load(W + (size_t)(k0 + kk) * N + n0 + lane);
    asm volatile("s_waitcnt lgkmcnt(0)" ::: "memory");
    const int c = lane & 7;
    f32x4 ga = (f32x4){1.f, 1.f, 1.f, 1.f}, gb = ga;
    if (gain) { ga = *(const f32x4*)(gain + k0 + 8 * c); gb = *(const f32x4*)(gain + k0 + 8 * c + 4); }
#pragma unroll
    for (int j = 0; j < 8; ++j) { const int n = (lane >> 3) + 8 * j, sn = n0 + n; const LAS float* q = scr + (8 * c) * 65 + n;
        const int dr = mode == 0 ? sn : (256 * (sn >> 7) + (sn & 127) + (mode == 2 ? 128 : 0));
        u32x4 o; o.x = cvt_pk_bf16(q[0 * 65] * ga.x, q[1 * 65] * ga.y); o.y = cvt_pk_bf16(q[2 * 65] * ga.z, q[3 * 65] * ga.w); o.z = cvt_pk_bf16(q[4 * 65] * gb.x, q[5 * 65] * gb.y); o.w = cvt_pk_bf16(q[6 * 65] * gb.z, q[7 * 65] * gb.w);
        *(u32x4*)(WT + (size_t)dr * K + k0 + 8 * c) = o; }
    asm volatile("s_waitcnt lgkmcnt(0)" ::: "memory");
}

__device__ __forceinline__ void rot16(const bf16_t* row, const f32x2* tabrow, int jg, float sc, unsigned (&y1)[8], unsigned (&y2)[8]) {
    const u32x4 a0 = *(const u32x4*)(row + jg * 16), a1 = *(const u32x4*)(row + jg * 16 + 8);
    const u32x4 b0 = *(const u32x4*)(row + 64 + jg * 16), b1 = *(const u32x4*)(row + 64 + jg * 16 + 8);
    const unsigned aw[8] = {a0.x, a0.y, a0.z, a0.w, a1.x, a1.y, a1.z, a1.w};
    const unsigned bw[8] = {b0.x, b0.y, b0.z, b0.w, b1.x, b1.y, b1.z, b1.w};
    const f32x4* tp = (const f32x4*)(tabrow + jg * 16);
#pragma unroll
    for (int i = 0; i < 8; ++i) {
        const f32x4 cs = tp[i];
        const float x1a = bflo(aw[i]), x1b = bfhi(aw[i]), x2a = bflo(bw[i]), x2b = bfhi(bw[i]);
        y1[i] = cvt_pk_bf16((x1a * cs.x - x2a * cs.y) * sc, (x1b * cs.z - x2b * cs.w) * sc);
        y2[i] = cvt_pk_bf16((x1a * cs.y + x2a * cs.x) * sc, (x1b * cs.w + x2b * cs.z) * sc);
    }
}

constexpr int RP = 136;

__device__ __forceinline__ void ret_state_item(const bf16_t* proj, const f32x2* tab, bf16_t* states, int item, LAS unsigned char* lds, int tid) {
    const int wave = tid >> 6, lane = tid & 63, fr = lane & 15, fq = lane >> 4;
    const int h = item & 3, n = (item >> 2) & 31, bl = item >> 7;
    const size_t tok0 = (size_t)bl * SEQ + n * 128;
    LAS bf16_t* KT = (LAS bf16_t*)lds;
    LAS bf16_t* VT = (LAS bf16_t*)(lds + 128 * RP * 2);
    const float lg = log2g(h);
    {
        const int c = tid >> 2, jg = tid & 3;
        const bf16_t* row = proj + (tok0 + c) * INW + C_RK + h * 128;
        unsigned y1[8], y2[8];
        rot16(row, tab + (size_t)(n * 128 + c) * 64, jg, 0.08838834764831845f * exp2f(-(float)(c + 1) * lg), y1, y2);
#pragma unroll
        for (int i = 0; i < 8; ++i) {
            const int j = jg * 16 + 2 * i;
            KT[(j) * RP + c] = (bf16_t)(y1[i] & 0xffffu); KT[(j + 1) * RP + c] = (bf16_t)(y1[i] >> 16);
            KT[(j + 64) * RP + c] = (bf16_t)(y2[i] & 0xffffu); KT[(j + 65) * RP + c] = (bf16_t)(y2[i] >> 16);
        }
        const bf16_t* vrow = proj + (tok0 + c) * INW + C_RV + h * 256 + jg * 64;
#pragma unroll
        for (int i = 0; i < 8; ++i) {
            const u32x4 v = *(const u32x4*)(vrow + i * 8);
            const unsigned vw[4] = {v.x, v.y, v.z, v.w};
#pragma unroll
            for (int k = 0; k < 4; ++k) { const int e = jg * 64 + i * 8 + 2 * k; VT[e * RP + c] = (bf16_t)(vw[k] & 0xffffu); VT[(e + 1) * RP + c] = (bf16_t)(vw[k] >> 16); }
        }
    }
    __syncthreads();
    f32x4 acc[8][2];
#pragma unroll
    for (int dt = 0; dt < 8; ++dt) { acc[dt][0] = (f32x4){0.f, 0.f, 0.f, 0.f}; acc[dt][1] = (f32x4){0.f, 0.f, 0.f, 0.f}; }
#pragma unroll
    for (int ks = 0; ks < 4; ++ks) {
        bf16x8 bfr[2];
#pragma unroll
        for (int et = 0; et < 2; ++et) bfr[et] = *(const LAS bf16x8*)(VT + (32 * wave + 16 * et + fr) * RP + 32 * ks + 8 * fq);
#pragma unroll
        for (int dt = 0; dt < 8; ++dt) {
            const bf16x8 a = *(const LAS bf16x8*)(KT + (16 * dt + fr) * RP + 32 * ks + 8 * fq);
            acc[dt][0] = mfma16(a, bfr[0], acc[dt][0]); acc[dt][1] = mfma16(a, bfr[1], acc[dt][1]);
        }
    }
    const float gch = exp2f(128.f * lg);
    bf16_t* sp = states + (size_t)item * 32768;
#pragma unroll
    for (int et = 0; et < 2; ++et)
#pragma unroll
        for (int dt = 0; dt < 8; ++dt) { const f32x4 v = acc[dt][et] * gch; *(u32x2*)(sp + (size_t)(32 * wave + 16 * et + fr) * 128 + 16 * dt + 4 * fq) = (u32x2){cvt_pk_bf16(v[0], v[1]), cvt_pk_bf16(v[2], v[3])}; }
    __syncthreads();
}

__device__ __forceinline__ void ret_scan(bf16_t* states, int gtid, int nthreads, int dry) {
    for (int i = gtid; i < 16 * 8192; i += nthreads) {
        const int bh = i >> 13, off = i & 8191, bl = bh >> 2, h = bh & 3;
        const float g = exp2f(128.f * log2g(h));
        u32x2* p = (u32x2*)(states + ((size_t)(bl * 32) * 4 + h) * 32768) + off;
        f32x4 R = (f32x4){0.f, 0.f, 0.f, 0.f};
        for (int n0 = 0; n0 < 32; n0 += 8) {
            u32x2 sv[8];
#pragma unroll
            for (int k = 0; k < 8; ++k) sv[k] = p[(size_t)(n0 + k) * 32768];
#pragma unroll
            for (int k = 0; k < 8; ++k) { if (!dry) p[(size_t)(n0 + k) * 32768] = (u32x2){cvt_pk_bf16(R[0], R[1]), cvt_pk_bf16(R[2], R[3])};
                R = R * g + (f32x4){bflo(sv[k].x), bfhi(sv[k].x), bflo(sv[k].y), bfhi(sv[k].y)}; }
        }
    }
}

__device__ __forceinline__ void ret_out_item(bf16_t* proj, const f32x2* tab, const bf16_t* states, const float* gn, int item, LAS unsigned char* lds, int tid, int dry) {
    const int wave = tid >> 6, lane = tid & 63, fr = lane & 15, fq = lane >> 4;
    const int h = item & 3, n = (item >> 2) & 31, bl = item >> 7;
    const size_t tok0 = (size_t)bl * SEQ + n * 128;
    LAS bf16_t* QS = (LAS bf16_t*)lds;
    LAS bf16_t* KS = (LAS bf16_t*)(lds + 128 * RP * 2);
    LAS bf16_t* VT = (LAS bf16_t*)(lds + 2 * 128 * RP * 2);
    LAS float* red = (LAS float*)(lds + 4 * 128 * RP * 2);
    const float lg = log2g(h);
    {
        const int c = tid >> 2, jg = tid & 3;
        const f32x2* tr = tab + (size_t)(n * 128 + c) * 64;
        unsigned y1[8], y2[8];
        rot16(proj + (tok0 + c) * INW + C_RQ + h * 128, tr, jg, exp2f((float)(c + 1) * lg), y1, y2);
        *(LAS u32x4*)(QS + c * RP + jg * 16) = (u32x4){y1[0], y1[1], y1[2], y1[3]}; *(LAS u32x4*)(QS + c * RP + jg * 16 + 8) = (u32x4){y1[4], y1[5], y1[6], y1[7]};
        *(LAS u32x4*)(QS + c * RP + 64 + jg * 16) = (u32x4){y2[0], y2[1], y2[2], y2[3]}; *(LAS u32x4*)(QS + c * RP + 64 + jg * 16 + 8) = (u32x4){y2[4], y2[5], y2[6], y2[7]};
        rot16(proj + (tok0 + c) * INW + C_RK + h * 128, tr, jg, 0.08838834764831845f * exp2f(-(float)(c + 1) * lg), y1, y2);
        *(LAS u32x4*)(KS + c * RP + jg * 16) = (u32x4){y1[0], y1[1], y1[2], y1[3]}; *(LAS u32x4*)(KS + c * RP + jg * 16 + 8) = (u32x4){y1[4], y1[5], y1[6], y1[7]};
        *(LAS u32x4*)(KS + c * RP + 64 + jg * 16) = (u32x4){y2[0], y2[1], y2[2], y2[3]}; *(LAS u32x4*)(KS + c * RP + 64 + jg * 16 + 8) = (u32x4){y2[4], y2[5], y2[6], y2[7]};
        const bf16_t* vrow = proj + (tok0 + c) * INW + C_RV + h * 256 + jg * 64;
#pragma unroll
        for (int i = 0; i < 8; ++i) {
            const u32x4 v = *(const u32x4*)(vrow + i * 8);
            const unsigned vw[4] = {v.x, v.y, v.z, v.w};
#pragma unroll
            for (int k = 0; k < 4; ++k) { const int e = jg * 64 + i * 8 + 2 * k; VT[e * RP + c] = (bf16_t)(vw[k] & 0xffffu); VT[(e + 1) * RP + c] = (bf16_t)(vw[k] >> 16); }
        }
    }
    __syncthreads();
    unsigned pk[8][2];
    {
        f32x4 pacc[8];
#pragma unroll
        for (int st = 0; st < 8; ++st) pacc[st] = (f32x4){0.f, 0.f, 0.f, 0.f};
#pragma unroll
        for (int ks = 0; ks < 4; ++ks) {
            const bf16x8 b = *(const LAS bf16x8*)(QS + (16 * wave + fr) * RP + 32 * ks + 8 * fq);
#pragma unroll
            for (int st = 0; st < 8; ++st) { const bf16x8 a = *(const LAS bf16x8*)(KS + (16 * st + fr) * RP + 32 * ks + 8 * fq); pacc[st] = mfma16(a, b, pacc[st]); }
        }
        const int c = 16 * wave + fr;
#pragma unroll
        for (int st = 0; st < 8; ++st) { float v[4];
#pragma unroll
            for (int j = 0; j < 4; ++j) { const int s = 16 * st + 4 * fq + j; v[j] = (s <= c) ? pacc[st][j] : 0.f; }
            pk[st][0] = cvt_pk_bf16(v[0], v[1]); pk[st][1] = cvt_pk_bf16(v[2], v[3]); }
    }
    __syncthreads();
    {
        const int c = 16 * wave + fr;
#pragma unroll
        for (int st = 0; st < 8; ++st) *(LAS u32x2*)(KS + c * RP + 16 * st + 4 * fq) = (u32x2){pk[st][0], pk[st][1]};
    }
    __syncthreads();
    f32x4 acc[2][8];
#pragma unroll
    for (int et = 0; et < 2; ++et)
#pragma unroll
        for (int ct = 0; ct < 8; ++ct) acc[et][ct] = (f32x4){0.f, 0.f, 0.f, 0.f};
    const bf16_t* sp = states + (size_t)item * 32768;
#pragma unroll
    for (int ks = 0; ks < 4; ++ks) {
        bf16x8 av[2], ar[2];
#pragma unroll
        for (int et = 0; et < 2; ++et) {
            const int e = 32 * wave + 16 * et + fr;
            av[et] = *(const LAS bf16x8*)(VT + e * RP + 32 * ks + 8 * fq);
            ar[et] = *(const bf16x8*)(sp + (size_t)e * 128 + 32 * ks + 8 * fq);
        }
#pragma unroll
        for (int ct = 0; ct < 8; ++ct) {
            const bf16x8 bp = *(const LAS bf16x8*)(KS + (16 * ct + fr) * RP + 32 * ks + 8 * fq);
            const bf16x8 bq = *(const LAS bf16x8*)(QS + (16 * ct + fr) * RP + 32 * ks + 8 * fq);
#pragma unroll
            for (int et = 0; et < 2; ++et) { acc[et][ct] = mfma16(av[et], bp, acc[et][ct]); acc[et][ct] = mfma16(ar[et], bq, acc[et][ct]); }
        }
    }
#pragma unroll
    for (int ct = 0; ct < 8; ++ct) {
        float s = 0.f;
#pragma unroll
        for (int et = 0; et < 2; ++et) s += (acc[et][ct][0] * acc[et][ct][0] + acc[et][ct][1] * acc[et][ct][1]) + (acc[et][ct][2] * acc[et][ct][2] + acc[et][ct][3] * acc[et][ct][3]);
        s += __shfl_xor(s, 16); s += __shfl_xor(s, 32);
        if (fq == 0) red[wave * 128 + 16 * ct + fr] = s;
    }
    __syncthreads();
#pragma unroll
    for (int ct = 0; ct < 8; ++ct) {
        const int c = 16 * ct + fr;
        float s = 0.f;
#pragma unroll
        for (int w = 0; w < 8; ++w) s += red[w * 128 + c];
        const float rstd = rsqrtf(s * (1.f / 256.f) + 1e-6f);
        bf16_t* grow = proj + (tok0 + c) * INW + C_RG + h * 256;
#pragma unroll
        for (int et = 0; et < 2; ++et) {
            const int e = 32 * wave + 16 * et + 4 * fq;
            const u32x2 gw = *(const u32x2*)(grow + e);
            const f32x4 gg = *(const f32x4*)(gn + h * 256 + e);
            const float g0 = bflo(gw.x), g1 = bfhi(gw.x), g2 = bflo(gw.y), g3 = bfhi(gw.y);
            const float o0 = acc[et][ct][0] * rstd * gg.x * g0 * sigmoidf_(g0), o1 = acc[et][ct][1] * rstd * gg.y * g1 * sigmoidf_(g1);
            const float o2 = acc[et][ct][2] * rstd * gg.z * g2 * sigmoidf_(g2), o3 = acc[et][ct][3] * rstd * gg.w * g3 * sigmoidf_(g3);
            if (!dry) *(u32x2*)(grow + e) = (u32x2){cvt_pk_bf16(o0, o1), cvt_pk_bf16(o2, o3)};
        }
    }
    __syncthreads();
}

__device__ __forceinline__ int rowperm(int d) { return (d & ~31) | (((d >> 2) & 1) << 4) | (((d >> 3) & 3) << 2) | (d & 3); }
constexpr int SKP = 72, SVP = 264;
__device__ __forceinline__ void swa_item(bf16_t* proj, const float* sinks, int item, LAS unsigned char* lds, int tid, int dry) {
    const int wave = tid >> 6, lane = tid & 63, fr = lane & 15, fq = lane >> 4;
    const int kh = item & 1, n = (item >> 1) & 31, bl = item >> 6;
    const size_t tok0 = (size_t)bl * SEQ + n * 128;
    LAS bf16_t* Ks = (LAS bf16_t*)lds;
    LAS bf16_t* Vt = (LAS bf16_t*)(lds + 256 * SKP * 2);
#pragma unroll
    for (int i = 0; i < 4; ++i) {
        const int ch = tid + 512 * i, key = ch >> 3, part = ch & 7;
        u32x4 kv = (u32x4){0u, 0u, 0u, 0u}, vv = (u32x4){0u, 0u, 0u, 0u};
        if (n > 0 || key >= 128) { const bf16_t* r = proj + (tok0 + key - 128) * INW; kv = *(const u32x4*)(r + C_SK + kh * 64 + part * 8); vv = *(const u32x4*)(r + C_SV + kh * 64 + part * 8); }
        *(LAS u32x4*)(Ks + key * SKP + part * 8) = kv;
        const unsigned vw[4] = {vv.x, vv.y, vv.z, vv.w};
#pragma unroll
        for (int k = 0; k < 4; ++k) { const int d = part * 8 + 2 * k; Vt[rowperm(d) * SVP + key] = (bf16_t)(vw[k] & 0xffffu); Vt[rowperm(d + 1) * SVP + key] = (bf16_t)(vw[k] >> 16); }
    }
    __syncthreads();
    const int h = kh * 8 + wave; const float sink = sinks[h];
    for (int qt = 0; qt < 8; ++qt) {
        bf16_t* qrow = proj + (tok0 + 16 * qt + fr) * INW + C_SQ + h * 64;
        bf16x8 qf[2];
        qf[0] = *(const bf16x8*)(qrow + 8 * fq); qf[1] = *(const bf16x8*)(qrow + 32 + 8 * fq);
        f32x4 s[10];
#pragma unroll
        for (int r = 0; r < 9; ++r) { s[r] = (f32x4){0.f, 0.f, 0.f, 0.f};
#pragma unroll
            for (int ks = 0; ks < 2; ++ks) { const bf16x8 a = *(const LAS bf16x8*)(Ks + (16 * (qt + r) + fr) * SKP + 32 * ks + 8 * fq); s[r] = mfma16(a, qf[ks], s[r]); } }
        s[9] = (f32x4){0.f, 0.f, 0.f, 0.f};
        const int c = 16 * qt + fr; float mxr = -1e30f;
#pragma unroll
        for (int r = 0; r < 9; ++r) {
            const bool tile_ok = (n > 0) || (qt + r >= 8);
            if (r == 0 || r == 8 || !tile_ok) {
#pragma unroll
                for (int j = 0; j < 4; ++j) { const int kpos = 16 * (qt + r) + 4 * fq + j;
                    bool valid = tile_ok;
                    if (r == 0) valid = valid && (kpos > c);
                    if (r == 8) valid = valid && (kpos <= c + 128);
                    s[r][j] = valid ? s[r][j] : -1e30f; }
            }
            mxr = fmaxf(mxr, fmaxf(fmaxf(s[r][0], s[r][1]), fmaxf(s[r][2], s[r][3])));
        }
        mxr = fmaxf(mxr, __shfl_xor(mxr, 16)); mxr = fmaxf(mxr, __shfl_xor(mxr, 32));
        const float mx = fmaxf(mxr * 0.125f, sink);
        const float c1 = 0.125f * 1.4426950408889634f, mo = -mx * 1.4426950408889634f;
        float sum = 0.f;
#pragma unroll
        for (int r = 0; r < 9; ++r)
#pragma unroll
            for (int j = 0; j < 4; ++j) { const float pv = __builtin_amdgcn_exp2f(fmaf(s[r][j], c1, mo)); s[r][j] = pv; sum += pv; }
        sum += __shfl_xor(sum, 16); sum += __shfl_xor(sum, 32);
        sum += __expf(sink - mx);
        const float inv = __builtin_amdgcn_rcpf(sum);
        f32x4 o[4];
#pragma unroll
        for (int dt = 0; dt < 4; ++dt) o[dt] = (f32x4){0.f, 0.f, 0.f, 0.f};
#pragma unroll
        for (int k2 = 0; k2 < 5; ++k2) {
            u32x4 pw; pw.x = cvt_pk_bf16(s[2 * k2][0], s[2 * k2][1]); pw.y = cvt_pk_bf16(s[2 * k2][2], s[2 * k2][3]); pw.z = cvt_pk_bf16(s[2 * k2 + 1][0], s[2 * k2 + 1][1]); pw.w = cvt_pk_bf16(s[2 * k2 + 1][2], s[2 * k2 + 1][3]);
            const bf16x8 pf = __builtin_bit_cast(bf16x8, pw);
            const int kb = 16 * (qt + 2 * k2);
#pragma unroll
            for (int dt = 0; dt < 4; ++dt) {
                const u32x2 v0 = *(const LAS u32x2*)(Vt + (16 * dt + fr) * SVP + kb + 4 * fq), v1 = *(const LAS u32x2*)(Vt + (16 * dt + fr) * SVP + kb + (k2 == 4 ? 0 : 16) + 4 * fq);
                const bf16x8 a = __builtin_bit_cast(bf16x8, ((u32x4){v0.x, v0.y, v1.x, v1.y}));
                o[dt] = mfma16(a, pf, o[dt]);
            }
        }
#pragma unroll
        for (int pp = 0; pp < 2; ++pp) if (!dry) *(u32x4*)(qrow + 32 * pp + 8 * fq) = (u32x4){cvt_pk_bf16(o[2 * pp][0] * inv, o[2 * pp][1] * inv), cvt_pk_bf16(o[2 * pp][2] * inv, o[2 * pp][3] * inv), cvt_pk_bf16(o[2 * pp + 1][0] * inv, o[2 * pp + 1][1] * inv), cvt_pk_bf16(o[2 * pp + 1][2] * inv, o[2 * pp + 1][3] * inv)};
    }
    __syncthreads();
}

constexpr int MP = 264;
__device__ __forceinline__ void mem_item(bf16_t* proj, const bf16_t* mk, const bf16_t* mvT, int bglob0, int item, LAS unsigned char* lds, int tid, int dry) {
    const int wave = tid >> 6, lane = tid & 63, fr = lane & 15, fq = lane >> 4;
    const int qt = item & 15, h = (item >> 4) & 3, bl = item >> 6, b = bglob0 + bl;
    const size_t tok0 = (size_t)bl * SEQ + qt * 256;
    LAS bf16_t* Ms = (LAS bf16_t*)lds;
    {
        const bf16_t* src = mk + (size_t)b * 256 * 1024 + h * 256;
#pragma unroll 1
        for (int i0 = 0; i0 < 16; i0 += 8) {
            u32x4 st[8];
#pragma unroll
            for (int i = 0; i < 8; ++i) { const int ch = tid + 512 * (i0 + i), row = ch >> 5, part = ch & 31; st[i] = *(const u32x4*)(src + (size_t)row * 1024 + part * 8); }
#pragma unroll
            for (int i = 0; i < 8; ++i) { const int ch = tid + 512 * (i0 + i), row = ch >> 5, part = ch & 31; *(LAS u32x4*)(Ms + row * MP + part * 8) = st[i]; }
        }
    }
    bf16_t* qrow0 = proj + (tok0 + 16 * wave + fr) * INW + C_MQ + h * 256;
    const bf16_t* mvsrc = mvT + ((size_t)b * 1024 + h * 256) * 256;
    __syncthreads();
    bf16x8 pf[2][8]; float inv[2];
#pragma unroll
    for (int sub = 0; sub < 2; ++sub) {
        const bf16_t* qrow = qrow0 + (size_t)sub * 128 * INW;
        bf16x8 qf[8];
#pragma unroll
        for (int ks = 0; ks < 8; ++ks) qf[ks] = *(const bf16x8*)(qrow + 32 * ks + 8 * fq);
        f32x4 s[16];
#pragma unroll
        for (int t = 0; t < 16; ++t) { s[t] = (f32x4){0.f, 0.f, 0.f, 0.f};
#pragma unroll
            for (int ks = 0; ks < 8; ++ks) { const bf16x8 a = *(const LAS bf16x8*)(Ms + (16 * t + fr) * MP + 32 * ks + 8 * fq); s[t] = mfma16(a, qf[ks], s[t]); } }
        float mxr = -1e30f;
#pragma unroll
        for (int t = 0; t < 16; ++t) mxr = fmaxf(mxr, fmaxf(fmaxf(s[t][0], s[t][1]), fmaxf(s[t][2], s[t][3])));
        mxr = fmaxf(mxr, __shfl_xor(mxr, 16)); mxr = fmaxf(mxr, __shfl_xor(mxr, 32));
        const float c1 = 0.0625f * 1.4426950408889634f, mo = -mxr * c1;
        float sum = 0.f;
#pragma unroll
        for (int t = 0; t < 16; ++t)
#pragma unroll
            for (int j = 0; j < 4; ++j) { const float pv = __builtin_amdgcn_exp2f(fmaf(s[t][j], c1, mo)); s[t][j] = pv; sum += pv; }
        sum += __shfl_xor(sum, 16); sum += __shfl_xor(sum, 32);
        inv[sub] = __builtin_amdgcn_rcpf(sum);
#pragma unroll
        for (int k2 = 0; k2 < 8; ++k2) { u32x4 pw; pw.x = cvt_pk_bf16(s[2 * k2][0], s[2 * k2][1]); pw.y = cvt_pk_bf16(s[2 * k2][2], s[2 * k2][3]); pw.z = cvt_pk_bf16(s[2 * k2 + 1][0], s[2 * k2 + 1][1]); pw.w = cvt_pk_bf16(s[2 * k2 + 1][2], s[2 * k2 + 1][3]);
            pf[sub][k2] = __builtin_bit_cast(bf16x8, pw); }
    }
    __syncthreads();
    {
#pragma unroll 1
        for (int i0 = 0; i0 < 16; i0 += 8) {
            u32x4 st[8];
#pragma unroll
            for (int i = 0; i < 8; ++i) { const int ch = tid + 512 * (i0 + i), row = ch >> 5, part = ch & 31; st[i] = *(const u32x4*)(mvsrc + (size_t)row * 256 + part * 8); }
#pragma unroll
            for (int i = 0; i < 8; ++i) { const int ch = tid + 512 * (i0 + i), row = ch >> 5, part = ch & 31; *(LAS u32x4*)(Ms + rowperm(row) * MP + part * 8) = st[i]; }
        }
    }
    __syncthreads();
#pragma unroll
    for (int dp = 0; dp < 8; ++dp) {
        f32x4 oa0 = (f32x4){0.f, 0.f, 0.f, 0.f}, oa1 = oa0, ob0 = oa0, ob1 = oa0;
#pragma unroll
        for (int k2 = 0; k2 < 8; ++k2) {
            const u32x2 v0 = *(const LAS u32x2*)(Ms + (32 * dp + fr) * MP + 32 * k2 + 4 * fq), v1 = *(const LAS u32x2*)(Ms + (32 * dp + fr) * MP + 32 * k2 + 16 + 4 * fq);
            const u32x2 w0 = *(const LAS u32x2*)(Ms + (32 * dp + 16 + fr) * MP + 32 * k2 + 4 * fq), w1 = *(const LAS u32x2*)(Ms + (32 * dp + 16 + fr) * MP + 32 * k2 + 16 + 4 * fq);
            const bf16x8 a = __builtin_bit_cast(bf16x8, ((u32x4){v0.x, v0.y, v1.x, v1.y})), bb = __builtin_bit_cast(bf16x8, ((u32x4){w0.x, w0.y, w1.x, w1.y}));
            oa0 = mfma16(a, pf[0][k2], oa0); oa1 = mfma16(a, pf[1][k2], oa1); ob0 = mfma16(bb, pf[0][k2], ob0); ob1 = mfma16(bb, pf[1][k2], ob1);
        }
        if (!dry) {
            *(u32x4*)(qrow0 + 32 * dp + 8 * fq) = (u32x4){cvt_pk_bf16(oa0[0] * inv[0], oa0[1] * inv[0]), cvt_pk_bf16(oa0[2] * inv[0], oa0[3] * inv[0]), cvt_pk_bf16(ob0[0] * inv[0], ob0[1] * inv[0]), cvt_pk_bf16(ob0[2] * inv[0], ob0[3] * inv[0])};
            *(u32x4*)(qrow0 + (size_t)128 * INW + 32 * dp + 8 * fq) = (u32x4){cvt_pk_bf16(oa1[0] * inv[1], oa1[1] * inv[1]), cvt_pk_bf16(oa1[2] * inv[1], oa1[3] * inv[1]), cvt_pk_bf16(ob1[0] * inv[1], ob1[1] * inv[1]), cvt_pk_bf16(ob1[2] * inv[1], ob1[3] * inv[1])};
        }
    }
    __syncthreads();
}

#define XB_TMO      128
#define XB_XCNT(j)  (256  + 64 * (j))
#define XB_XSUB(j)  (1280 + 64 * (j))
#define XB_XGEN(j)  (2304 + 64 * (j))
#define XB_TOP      3328
#define XB_TOPGEN   3392
#define XCD_BAR_WORDS 3456
#define XB_SPIN_CAP (1u << 18)
__device__ __forceinline__ unsigned xb_ld(unsigned* p)              { return __hip_atomic_load(p, __ATOMIC_RELAXED, __HIP_MEMORY_SCOPE_AGENT); }
__device__ __forceinline__ unsigned xb_add(unsigned* p, unsigned v) { return __hip_atomic_fetch_add(p, v, __ATOMIC_RELAXED, __HIP_MEMORY_SCOPE_AGENT); }
__device__ __forceinline__ unsigned xb_xcc_id() { return (unsigned)__builtin_amdgcn_s_getreg((3 << 11) | 20) & 0xFu; }
#define XB_SPIN(cond, bar) do { unsigned _sp = 0; while (cond) { __builtin_amdgcn_s_sleep(1); \
    if ((++_sp & 255u) == 0u) { if (xb_ld(&(bar)[XB_TMO])) break; if (_sp > XB_SPIN_CAP) { atomicAdd(&(bar)[XB_TMO], 1u); break; } } } } while (0)
struct XcdBarrier { unsigned* bar; unsigned x; volatile LAS unsigned* st; };
__device__ __forceinline__ XcdBarrier xcd_barrier_post(unsigned* bar, volatile LAS unsigned* st) {
    XcdBarrier b; b.bar = bar; b.x = xb_xcc_id(); b.st = st;
    if (threadIdx.x == 0) (void)xb_add(&bar[XB_XCNT(b.x)], 1u);
    return b;
}
__device__ __forceinline__ void xcd_barrier_complete(unsigned* bar, unsigned x, unsigned& nloc, unsigned& nx) {
    const unsigned G = gridDim.x * gridDim.y * gridDim.z;
    unsigned sum, cnt, mine, sp = 0u;
    for (;;) {
        sum = 0u; cnt = 0u; mine = 0u;
#pragma unroll
        for (unsigned j = 0; j < 16; ++j) { const unsigned c = xb_ld(&bar[XB_XCNT(j)]); sum += c; cnt += (c > 0u) ? 1u : 0u; mine = (j == x) ? c : mine; }
        if (sum == G) break;
        __builtin_amdgcn_s_sleep(1);
        if ((++sp & 255u) == 0u) { if (xb_ld(&bar[XB_TMO])) break; if (sp > XB_SPIN_CAP) { atomicAdd(&bar[XB_TMO], 1u); break; } }
    }
    nloc = mine > 0u ? mine : 1u; nx = cnt > 0u ? cnt : 1u;
}
__device__ __forceinline__ void xcd_barrier(const XcdBarrier& b) {
    asm volatile("s_waitcnt vmcnt(0)" ::: "memory");
    __syncthreads();
    if (threadIdx.x == 0) {
        unsigned* bar = b.bar;
        __builtin_amdgcn_s_waitcnt(0);
        unsigned nloc = b.st[0], nx = b.st[1];
        if (nloc == 0u) { xcd_barrier_complete(bar, b.x, nloc, nx); b.st[0] = nloc; b.st[1] = nx; }
        const unsigned old = xb_add(&bar[XB_XSUB(b.x)], 1u);
        const unsigned gen = old / nloc;
        if (old + 1u == (gen + 1u) * nloc) {
            __builtin_amdgcn_fence(__ATOMIC_RELEASE, "agent");
            asm volatile("s_waitcnt vmcnt(0)" ::: "memory");
            const unsigned og = xb_add(&bar[XB_TOP], 1u);
            const unsigned tg = og / nx;
            if (og + 1u == (tg + 1u) * nx) xb_add(&bar[XB_TOPGEN], 1u);
            else XB_SPIN(xb_ld(&bar[XB_TOPGEN]) == tg, bar);
            __builtin_amdgcn_fence(__ATOMIC_ACQUIRE, "agent");
            xb_add(&bar[XB_XGEN(b.x)], 1u);
            asm volatile("s_waitcnt vmcnt(0)" ::: "memory");
        } else {
            XB_SPIN(xb_ld(&bar[XB_XGEN(b.x)]) == gen, bar);
            __builtin_amdgcn_fence(__ATOMIC_ACQUIRE, "agent");
            asm volatile("s_waitcnt vmcnt(0)" ::: "memory");
        }
    }
    __syncthreads();
}

__device__ __forceinline__ void run_phase(const Params& p, int ph, LAS unsigned char* lds, int dry) {
    int tid = threadIdx.x; asm volatile("" : "+v"(tid));
    const int lane = tid & 63, wave = tid >> 6;
    int G = gridDim.x, cu = blockIdx.x; asm volatile("" : "+s"(G), "+s"(cu));
    const int gw = cu * 8 + wave, ngw = G * 8;
    unsigned char* ws = p.ws; asm volatile("" : "+s"(ws));
    bf16_t* XB = (bf16_t*)p.out; asm volatile("" : "+s"(XB));
    const float* xin = p.in[0]; asm volatile("" : "+s"(xin));
    bf16_t* Hb = (bf16_t*)(ws + WS_H);
    if ((PHMASK & 1) && ph == NPH - 1) {
        for (int r = gw; r < T_ALL; r += ngw) rms_row_final(Hb + (size_t)r * DM, p.in[20], p.out + (size_t)r * DM, lane);
        return;
    }
    const int l = ph / NPL, k = ph - l * NPL;
    float* ssq1 = (float*)(ws + WS_SSQ); float* ssq2 = ssq1 + 4 * T_ALL; float* ssq3 = ssq2 + 4 * T_ALL;
    if (k == 0) {
        const size_t oFF = (size_t)l * DM * FF, oDD = (size_t)l * DM * DM;
        constexpr int I_F = 16 * 44, I_IN = 16 * 132, I_MKV = 16 * 32, I_DD = 16 * 16;
        constexpr int NIT = 6 * I_F + I_IN + I_MKV + 4 * I_DD;
        LAS float* scr = (LAS float*)(lds + wave * 16640);
        const float* g1 = p.in[2] + l * DM; const float* gm = p.in[6] + l * DM; const float* g2 = p.in[16] + l * DM; const float* gnone = nullptr;
        for (int it = gw; it < NIT; it += ngw) {
            int r = it;
            if (r < I_F) { wt_item(p.in[3] + oFF, DM, FF, (bf16_t*)(ws + WS_W13A), 1, r, scr, lane, g1); continue; } r -= I_F;
            if (r < I_F) { wt_item(p.in[4] + oFF, DM, FF, (bf16_t*)(ws + WS_W13A), 2, r, scr, lane, g1); continue; } r -= I_F;
            if (r < I_F) { wt_item(p.in[5] + oFF, FF, DM, (bf16_t*)(ws + WS_W2A), 0, r, scr, lane, gnone); continue; } r -= I_F;
            if (r < I_F) { wt_item(p.in[17] + oFF, DM, FF, (bf16_t*)(ws + WS_W13B), 1, r, scr, lane, g2); continue; } r -= I_F;
            if (r < I_F) { wt_item(p.in[18] + oFF, DM, FF, (bf16_t*)(ws + WS_W13B), 2, r, scr, lane, g2); continue; } r -= I_F;
            if (r < I_F) { wt_item(p.in[19] + oFF, FF, DM, (bf16_t*)(ws + WS_W2B), 0, r, scr, lane, gnone); continue; } r -= I_F;
            if (r < I_IN) { wt_item(p.in[7] + (size_t)l * DM * INW, DM, INW, (bf16_t*)(ws + WS_WIN), 0, r, scr, lane, gm); continue; } r -= I_IN;
            if (r < I_MKV) { wt_item(p.in[11] + (size_t)l * DM * 2048, DM, 2048, (bf16_t*)(ws + WS_WMKV), 0, r, scr, lane, gnone); continue; } r -= I_MKV;
            if (r < I_DD) { wt_item(p.in[12] + oDD, DM, DM, (bf16_t*)(ws + WS_WUP), 0, r, scr, lane, gnone); continue; } r -= I_DD;
            if (r < I_DD) { wt_item(p.in[13] + oDD, DM, DM, (bf16_t*)(ws + WS_WUP) + (size_t)DM * DM, 0, r, scr, lane, gnone); continue; } r -= I_DD;
            if (r < I_DD) { wt_item(p.in[14] + oDD, DM, DM, (bf16_t*)(ws + WS_WUP) + (size_t)2 * DM * DM, 0, r, scr, lane, gnone); continue; } r -= I_DD;
            wt_item(p.in[15] + oDD, DM, DM, (bf16_t*)(ws + WS_WO), 0, r, scr, lane, gnone);
        }
        for (int r = gw; r < 2048; r += ngw) rms_row_bf16(p.in[1] + (size_t)r * DM, p.in[10] + l * DM, (bf16_t*)(ws + WS_MEMH) + (size_t)r * DM, lane);
        if (l == 0) {
            for (int r = gw; r < T_ALL; r += ngw) {
                const f32x4* xr = (const f32x4*)(xin + (size_t)r * DM) + lane; u32x2* o8 = (u32x2*)(XB + (size_t)r * DM) + lane; float sacc = 0.f;
#pragma unroll
                for (int j = 0; j < 4; ++j) { const f32x4 v = __builtin_nontemporal_load(xr + 64 * j); sacc += (v.x * v.x + v.y * v.y) + (v.z * v.z + v.w * v.w); o8[64 * j] = (u32x2){cvt_pk_bf16(v.x, v.y), cvt_pk_bf16(v.z, v.w)}; }
                sacc = wave_sum(sacc); if (lane == 0) *(f32x4*)(ssq1 + (size_t)r * 4) = (f32x4){sacc, 0.f, 0.f, 0.f};
            }
            f32x2* tab = (f32x2*)(ws + WS_TAB);
            for (int i = cu * 512 + tid; i < SEQ * 64; i += G * 512) {
                const int pos = i >> 6, j = i & 63;
                const float inv = exp2f(-(float)j * (13.287712379549449f / 64.f));
                const float ang = (float)pos * inv;
                double rr = (double)ang * 0.15915494309189535; rr -= rint(rr);
                const float rf = (float)rr;
                tab[i] = (f32x2){__builtin_amdgcn_cosf(rf), __builtin_amdgcn_sinf(rf)};
            }
        }
        return;
    }
    if (k == 1 || k == 14) {
        pg8::Gemm g; g.A = XB; g.Bt = (const bf16_t*)(ws + (k == 1 ? WS_W13A : WS_W13B)); g.M = T_ALL; g.N = 2 * FF; g.K = DM; g.lda = DM; g.zoff0 = g.zoff1 = g.zoff2 = 0; g.zB = 0;
        pg8::Order S; S.init(g.M, g.N, G, cu, 1);
        LAS float* rtab = (LAS float*)(lds + pg8::STAGE_BYTES);
        { const float* sq = (k == 1) ? ssq1 : ssq3; pg8::Unit uu;
          for (int i = 0; i < 12 && S.next(i, uu); ++i) if (tid < 256) { const f32x4 q = *(const f32x4*)(sq + (size_t)(uu.pm * 256 + tid) * 4); rtab[i * 256 + tid] = rsqrtf(((q.x + q.y) + (q.z + q.w)) * (1.f / 1024.f) + 1e-6f); } }
        __syncthreads();
        pg8::EpiSwiglu E; E.U = (bf16_t*)(ws + WS_U); E.ldu = FF; E.rtab = rtab;
        pg8::gemm_phase(lds, g, S, E, tid);
        return;
    }
    if (k == 2 || k == 15 || k == 13) {
        pg8::Gemm g; pg8::EpiResid E; E.red = (LAS float*)(lds + pg8::STAGE_BYTES); g.zoff0 = g.zoff1 = g.zoff2 = 0; g.zB = 0; g.N = DM; g.M = T_ALL; E.ld = DM; E.src = XB; E.dst = XB;
        if (k == 2 || k == 15) {
            g.A = (const bf16_t*)(ws + WS_U); g.Bt = (const bf16_t*)(ws + (k == 2 ? WS_W2A : WS_W2B)); g.K = FF; g.lda = FF;
            E.scale = dry ? 0.f : 0.5f; E.ssq = (k == 2) ? ssq2 : ssq1;
            if (k == 15 && l == 1) E.dst = Hb;
        } else {
            g.A = Hb; g.Bt = (const bf16_t*)(ws + WS_WO); g.K = DM; g.lda = DM;
            E.scale = dry ? 0.f : 1.0f; E.ssq = ssq3;
        }
        pg8::Order S; S.init(g.M, g.N, G, cu, 1, 1);
        pg8::gemm_phase(lds, g, S, E, tid);
        return;
    }
    const int half = (k - 3) / 5, s = (k - 3) - 5 * half;
    bf16_t* proj = (bf16_t*)(ws + WS_PROJ);
    bf16_t* states = (bf16_t*)(ws + WS_ST);
    const f32x2* tab = (const f32x2*)(ws + WS_TAB);
    if (s == 0) {
        LAS float* rtab = (LAS float*)(lds + pg8::STAGE_BYTES);
        {
            pg8::Gemm g; g.A = XB + (size_t)half * T_HALF * DM; g.Bt = (const bf16_t*)(ws + WS_WIN); g.M = T_HALF; g.N = 8192; g.K = DM; g.lda = DM; g.zoff0 = g.zoff1 = g.zoff2 = 0; g.zB = 0;
            pg8::Order S; S.init(g.M, g.N, G, cu, 1, 2);
            { const float* sq = ssq2 + (size_t)half * T_HALF * 4; pg8::Unit uu;
              for (int i = 0; i < 12 && S.next(i, uu); ++i) if (tid < 256) { const f32x4 q = *(const f32x4*)(sq + (size_t)(uu.pm * 256 + tid) * 4); rtab[i * 256 + tid] = rsqrtf(((q.x + q.y) + (q.z + q.w)) * (1.f / 1024.f) + 1e-6f); } }
            __syncthreads();
            pg8::EpiStore E; E.O = proj; E.ldc = INW; E.rtab = rtab;
            pg8::gemm_phase(lds, g, S, E, tid);
        }
        if (half == 0) {
            {
                pg8::Gemm g; g.A = XB; g.Bt = (const bf16_t*)(ws + WS_WIN) + (size_t)8192 * DM; g.M = T_ALL; g.N = 256; g.K = DM; g.lda = DM; g.zoff0 = g.zoff1 = g.zoff2 = 0; g.zB = 0;
                pg8::Order S; S.init(g.M, g.N, G, cu < 128 ? cu : G, 1);
                { pg8::Unit uu;
                  for (int i = 0; i < 12 && S.next(i, uu); ++i) if (tid < 256) { const f32x4 q = *(const f32x4*)(ssq2 + (size_t)(uu.pm * 256 + tid) * 4); rtab[i * 256 + tid] = rsqrtf(((q.x + q.y) + (q.z + q.w)) * (1.f / 1024.f) + 1e-6f); } }
                __syncthreads();
                pg8::EpiStore E; E.O = (bf16_t*)(ws + WS_GL2); E.ldc = 256; E.rtab = rtab;
                pg8::gemm_phase(lds, g, S, E, tid);
            }
            {
                pg8::Gemm g2; g2.A = (const bf16_t*)(ws + WS_MEMH); g2.Bt = (const bf16_t*)(ws + WS_WMKV); g2.M = 2048; g2.N = 2048; g2.K = DM; g2.lda = DM; g2.zoff0 = g2.zoff1 = g2.zoff2 = 0; g2.zB = 0;
                pg8::Order S2; S2.init(2048, 2048, G, (cu >= 128 && cu < 192) ? cu - 128 : G, 1);
                pg8::EpiMkv E2; E2.mk = (bf16_t*)(ws + WS_MK); E2.mvT = (bf16_t*)(ws + WS_MVT);
                pg8::gemm_phase(lds, g2, S2, E2, tid);
            }
        }
        return;
    }
    if (s == 1) {
#ifndef MIXSUB
#define MIXSUB 7
#endif
        if (!dry || (MIXSUB & 1)) for (int it = cu; it < 512; it += G) ret_state_item(proj, tab, states, it, lds, tid);
        if (!dry || (MIXSUB & 2)) for (int it = cu; it < 256; it += G) swa_item(proj, p.in[9] + l * 16, it, lds, tid, dry);
        if (!dry || (MIXSUB & 4)) for (int it = cu; it < 256; it += G) mem_item(proj, (const bf16_t*)(ws + WS_MK), (const bf16_t*)(ws + WS_MVT), half * 4, it, lds, tid, dry);
        return;
    }
    if (s == 2) { ret_scan(states, cu * 512 + tid, G * 512, dry); return; }
    if (s == 3) {
        for (int it = cu; it < 512; it += G) ret_out_item(proj, tab, states, p.in[8] + l * 1024, it, lds, tid, dry);
        return;
    }
    {
        pg8::Gemm g; g.A = proj; g.Bt = (const bf16_t*)(ws + WS_WUP); g.M = T_HALF; g.N = DM; g.K = DM; g.lda = INW; g.zoff0 = C_RG; g.zoff1 = C_SQ; g.zoff2 = C_MQ; g.zB = (long)DM * DM;
        pg8::Order S; S.init(g.M, g.N, G, cu, 3);
        pg8::EpiGate E; E.Mg = Hb + (size_t)half * T_HALF * DM; E.gl = proj + C_GL; E.ldg = INW; E.gl2 = (const bf16_t*)(ws + WS_GL2) + (size_t)half * T_HALF * 256;
        pg8::gemm_phase(lds, g, S, E, tid);
    }
}

__global__ __launch_bounds__(512, 2) void mega(Params p, int ph_lo, int ph_hi) {
    extern __shared__ __attribute__((aligned(16))) unsigned char shm[];
    LAS unsigned char* lds = (LAS unsigned char*)shm;
    cg::grid_group grid = cg::this_grid();
    volatile LAS unsigned* st = (volatile LAS unsigned*)(lds + LDS_PHASE);
    if (threadIdx.x == 0) { st[0] = 0u; st[1] = 0u; st[2] = 0u; st[3] = 0u; }
    __syncthreads();
    const XcdBarrier xb = xcd_barrier_post((unsigned*)(p.ws + WS_BAR), st);
    for (int ph = ph_lo; ph < ph_hi; ++ph) {
        int nrep = 1;
#if DBL_MASK
        { const int kk = (ph == NPH - 1) ? 16 : ph % NPL; nrep += (DBL_MASK >> kk) & 1; }
#endif
        for (int rep = 0; rep < nrep; ++rep) { int dry = rep; asm volatile("" : "+s"(dry)); run_phase(p, ph, lds, dry); if (rep + 1 < nrep) __syncthreads(); }
        if (ph + 1 < ph_hi) { if (ph_hi < 0) grid.sync(); else xcd_barrier(xb); }
    }
}

extern "C" void kernel_launch(void* const* d_in, const int* in_sizes, int n_in, void* d_out, int out_size, void* d_ws, size_t ws_size, hipStream_t stream) {
    static int grid = 0;
    if (grid == 0) {
        if (n_in != 21 || out_size != T_ALL * DM || ws_size < WS_END2) { fprintf(stderr, "kernel_launch: unexpected shapes (n_in %d out %d ws %zu need %zu)\n", n_in, out_size, ws_size, (size_t)WS_END2); grid = -1; return; }
        int dev = 0, cus = 0, per_cu = 0;
        if (hipGetDevice(&dev) != hipSuccess || hipDeviceGetAttribute(&cus, hipDeviceAttributeMultiprocessorCount, dev) != hipSuccess) { grid = -1; return; }
        if (hipFuncSetAttribute((const void*)mega, hipFuncAttributeMaxDynamicSharedMemorySize, LDS_BYTES) != hipSuccess) { fprintf(stderr, "kernel_launch: hipFuncSetAttribute failed\n"); grid = -1; return; }
        if (hipOccupancyMaxActiveBlocksPerMultiprocessor(&per_cu, (const void*)mega, 512, LDS_BYTES) != hipSuccess || per_cu < 1) { fprintf(stderr, "kernel_launch: occupancy query says %d\n", per_cu); per_cu = 1; }
        (void)hipGetLastError();
        grid = cus;
    }
    if (grid <= 0) return;
    Params p{};
    for (int i = 0; i < 21; ++i) p.in[i] = (const float*)d_in[i];
    p.out = (float*)d_out; p.ws = (unsigned char*)d_ws;
    (void)hipMemsetAsync((unsigned char*)d_ws + WS_BAR, 0, 16384, stream);
#if MK_ONE_LAUNCH
    int lo = 0, hi = NPH;
    void* args[] = {&p, &lo, &hi};
    hipError_t e = hipLaunchCooperativeKernel((const void*)mega, dim3(grid), dim3(512), args, LDS_BYTES, stream);
    if (e != hipSuccess) fprintf(stderr, "cooperative launch failed: %s (grid %d)\n", hipGetErrorString(e), grid);
#else
    for (int ph = 0; ph < NPH; ++ph) hipLaunchKernelGGL(mega, dim3(grid), dim3(512), LDS_BYTES, stream, p, ph, ph + 1);
#endif
}
```

```cpp
#include <hip/hip_runtime.h>
#include <hip/hip_cooperative_groups.h>
#include <cstdio>
#include <cstdint>
namespace cg = cooperative_groups;

#ifndef MK_ONE_LAUNCH
#define MK_ONE_LAUNCH 1
#endif

#ifndef DBL_MASK
#define DBL_MASK 0
#endif
#ifndef PHMASK
#define PHMASK 0xffff
#endif
#define LAS __attribute__((address_space(3)))
typedef unsigned short bf16_t;
typedef short bf16x8 __attribute__((ext_vector_type(8)));
typedef short bf16x4 __attribute__((ext_vector_type(4)));
typedef float f32x4 __attribute__((ext_vector_type(4)));
typedef float f32x2 __attribute__((ext_vector_type(2)));
typedef unsigned u32x4 __attribute__((ext_vector_type(4)));
typedef unsigned u32x2 __attribute__((ext_vector_type(2)));

constexpr int T_ALL = 32768, DM = 1024, FF = 2816, INW = 8448, T_HALF = 16384, SEQ = 4096;
constexpr int C_RQ = 0, C_RK = 512, C_RV = 1024, C_RG = 2048, C_SQ = 3072, C_SK = 4096, C_SV = 4224, C_MQ = 4352, C_GL = 5376;
constexpr int LDS_PHASE = 143360, LDS_BYTES = LDS_PHASE + 16;
constexpr int NPL = 16, NPH = 2 * NPL + 1;

constexpr size_t SZ_W13 = (size_t)2 * FF * DM * 2, SZ_W2 = (size_t)DM * FF * 2;
constexpr size_t WS_W13A = 0, WS_W2A = WS_W13A + SZ_W13, WS_W13B = WS_W2A + SZ_W2, WS_W2B = WS_W13B + SZ_W13;
constexpr size_t WS_WIN = WS_W2B + SZ_W2, WS_WMKV = WS_WIN + (size_t)INW * DM * 2, WS_WUP = WS_WMKV + (size_t)2048 * DM * 2;
constexpr size_t WS_WO = WS_WUP + (size_t)3 * DM * DM * 2, WS_TAB = WS_WO + (size_t)DM * DM * 2;
constexpr size_t WS_MEMH = WS_TAB + (size_t)SEQ * 64 * 8, WS_MK = WS_MEMH + (size_t)2048 * DM * 2, WS_MVT = WS_MK + (size_t)2048 * DM * 2;
constexpr size_t WS_H = WS_MVT + (size_t)2048 * DM * 2, WS_TMP = WS_H + (size_t)T_ALL * DM * 2;
constexpr size_t WS_U = WS_TMP, WS_PROJ = WS_TMP, WS_ST = WS_PROJ + (size_t)T_HALF * INW * 2;
constexpr size_t WS_BAR = WS_ST + (size_t)512 * 32768 * 4;
constexpr size_t WS_SSQ = WS_BAR + 16384;
constexpr size_t WS_END = WS_SSQ + (size_t)3 * T_ALL * 16;
constexpr size_t WS_GL2 = WS_END;
constexpr size_t WS_END2 = WS_GL2 + (size_t)T_ALL * 256 * 2;
constexpr size_t WS_XB3 = WS_TMP + (size_t)192 * 1024 * 1024;

struct Params {
    const float* in[21];
    float* out;
    unsigned char* ws;
};

__device__ __forceinline__ unsigned cvt_pk_bf16(float lo, float hi) { unsigned r; asm volatile("v_cvt_pk_bf16_f32 %0, %1, %2" : "=v"(r) : "v"(lo), "v"(hi)); return r; }
__device__ __forceinline__ bf16_t f2bf(float f) { return (bf16_t)(cvt_pk_bf16(f, 0.f) & 0xffffu); }
__device__ __forceinline__ float bf2f(unsigned b) { return __uint_as_float(b << 16); }
__device__ __forceinline__ float bflo(unsigned w) { return __uint_as_float(w << 16); }
__device__ __forceinline__ float bfhi(unsigned w) { return __uint_as_float(w & 0xffff0000u); }
__device__ __forceinline__ float wave_sum(float v) {
#pragma unroll
    for (int o = 1; o < 64; o <<= 1) v += __shfl_xor(v, o);
    return v;
}
__device__ __forceinline__ f32x4 zero4() {
    typedef double f64x2 __attribute__((ext_vector_type(2)));
    double lo, hi;
    asm volatile("v_mov_b64 %0, 0" : "=v"(lo));
    asm volatile("v_mov_b64 %0, 0" : "=v"(hi));
    return __builtin_bit_cast(f32x4, ((f64x2){lo, hi}));
}
__device__ __forceinline__ f32x4 mfma16(bf16x8 a, bf16x8 b, f32x4 c) { return __builtin_amdgcn_mfma_f32_16x16x32_bf16(a, b, c, 0, 0, 0); }
__device__ __forceinline__ float sigmoidf_(float x) { return __builtin_amdgcn_rcpf(1.0f + __builtin_amdgcn_exp2f(x * -1.4426950408889634f)); }
__device__ __forceinline__ float log2g(int h) { return h == 0 ? -0.04580368961312479f : h == 1 ? -0.02272007650008353f : h == 2 ? -0.011315313227834146f : -0.005646563141142063f; }

namespace pg8 {
constexpr int BM = 256, BK = 64, HALF = 128, HTB = HALF * BK * 2, STAGE_BYTES = 8 * HTB, NXCD = 8, WGM = 8;
__host__ __device__ __forceinline__ int lds_byte(int r, int c) { const int st = (r >> 4) * 2 + (c >> 5), rr = r & 15, cc = c & 31, ob = rr * 64 + cc * 2; return st * 1024 + (ob ^ (((ob >> 9) & 1) << 5)); }
__host__ __device__ __forceinline__ void stage_rc(int b, int& R, int& C) { const int st = b / 1024, sb = b % 1024, swz = sb ^ (((sb >> 9) & 1) << 5); R = (st >> 1) * 16 + swz / 64; C = (st & 1) * 32 + (swz % 64) / 2; }
__host__ __device__ __forceinline__ int perm32(int rho) { const int n = rho >> 4, i = rho & 15; return 8 * (i >> 2) + 4 * n + (i & 3); }

struct Unit { int pm, pn, z, idx; };
struct Gemm { const bf16_t* A; const bf16_t* Bt; int M, N, K, lda; int zoff0, zoff1, zoff2; long zB; };

struct Order {
    int nM, nN, nwg, G, c, nZ, rev;
    __device__ void init(int M, int N, int G_, int c_, int nZ_, int rev_ = 0) { nM = M / BM; nN = N / BM; nwg = nM * nN; G = G_; c = c_; nZ = nZ_; rev = rev_; }
    __device__ bool next(int i, Unit& u) const {
        int rnd = i, z = 0;
        if (nZ == 3) { rnd = i / 3; z = i - 3 * rnd; }
        u.z = z; u.idx = i;
        const long L = (long)rnd * G + c; if (L >= nwg) return false;
        int wgid = (int)L; { const int q = nwg / NXCD, r = nwg % NXCD, xcd = wgid % NXCD, off = wgid / NXCD; wgid = (xcd < r ? xcd * (q + 1) : r * (q + 1) + (xcd - r) * q) + off; }
        const int nig = WGM * nN, gid = wgid / nig, fm = gid * WGM, gsz = (nM - fm) < WGM ? (nM - fm) : WGM;
        u.pm = fm + ((wgid % nig) % gsz); u.pn = (wgid % nig) / gsz;
        if (rev & 1) u.pm = nM - 1 - u.pm;
        if (rev & 2) u.pn = nN - 1 - u.pn;
        return true;
    }
};

struct EpiStore {
    static constexpr bool PERM = true; static constexpr int NST = 16;
    bf16_t* O; int ldc; const LAS float* rtab;
    __device__ __forceinline__ void operator()(const f32x4 (&acc)[2][2][4][2], const Unit& u, int wr, int wc, int fr, int fq) const {
        const int row0 = u.pm * BM + wr * 64 + fr, col0 = u.pn * BM + wc * 32 + 8 * fq;
        const LAS float* rt = rtab + u.idx * 256 + wr * 64 + fr;
#pragma unroll
        for (int ai = 0; ai < 2; ++ai)
#pragma unroll
            for (int m = 0; m < 4; ++m) { bf16_t* rowp = O + (size_t)(row0 + ai * HALF + m * 16) * ldc + col0;
                const float rs = rt[ai * HALF + m * 16];
#pragma unroll
                for (int bj = 0; bj < 2; ++bj) { const f32x4 v0 = acc[ai][bj][m][0] * rs, v1 = acc[ai][bj][m][1] * rs;
                    u32x4 w; w.x = cvt_pk_bf16(v0[0], v0[1]); w.y = cvt_pk_bf16(v0[2], v0[3]); w.z = cvt_pk_bf16(v1[0], v1[1]); w.w = cvt_pk_bf16(v1[2], v1[3]);
                    *(u32x4*)(rowp + bj * HALF) = w; } }
    }
};
struct EpiSwiglu {
    static constexpr bool PERM = true; static constexpr int NST = 8;
    bf16_t* U; int ldu; const LAS float* rtab;
    __device__ __forceinline__ void operator()(const f32x4 (&acc)[2][2][4][2], const Unit& u, int wr, int wc, int fr, int fq) const {
        const int row0 = u.pm * BM + wr * 64 + fr, col0 = u.pn * 128 + wc * 32 + 8 * fq;
        const LAS float* rt = rtab + u.idx * 256 + wr * 64 + fr;
#pragma unroll
        for (int ai = 0; ai < 2; ++ai)
#pragma unroll
            for (int m = 0; m < 4; ++m) { bf16_t* rowp = U + (size_t)(row0 + ai * HALF + m * 16) * ldu + col0;
                const float rs = rt[ai * HALF + m * 16];
                const float ke = rs * -1.4426950408889634f, rs2 = rs * rs;
                float r[8];
#pragma unroll
                for (int n = 0; n < 2; ++n) { const f32x4 a = acc[ai][0][m][n], b = acc[ai][1][m][n];
                    const f32x4 ab = a * b * rs2, ea = a * ke;
#pragma unroll
                    for (int j = 0; j < 4; ++j) r[4 * n + j] = ab[j] * __builtin_amdgcn_rcpf(1.0f + __builtin_amdgcn_exp2f(ea[j])); }
                *(u32x4*)rowp = (u32x4){cvt_pk_bf16(r[0], r[1]), cvt_pk_bf16(r[2], r[3]), cvt_pk_bf16(r[4], r[5]), cvt_pk_bf16(r[6], r[7])}; }
    }
};
struct EpiResid {
    static constexpr bool PERM = true; static constexpr int NST = 16;
    const bf16_t* src; bf16_t* dst; float* ssq; int ld; float scale; LAS float* red;
    __device__ __forceinline__ void operator()(const f32x4 (&acc)[2][2][4][2], const Unit& u, int wr, int wc, int fr, int fq) const {
        const int row0 = u.pm * BM + wr * 64 + fr, col0 = u.pn * BM + wc * 32 + 8 * fq;
        float ssr[2][4];
#pragma unroll
        for (int ai = 0; ai < 2; ++ai) {
            u32x4 sv[4][2];
#pragma unroll
            for (int m = 0; m < 4; ++m)
#pragma unroll
                for (int bj = 0; bj < 2; ++bj) sv[m][bj] = *(const u32x4*)(src + (size_t)(row0 + ai * HALF + m * 16) * ld + col0 + bj * HALF);
#pragma unroll
            for (int m = 0; m < 4; ++m) { const size_t ro = (size_t)(row0 + ai * HALF + m * 16) * ld + col0; float ss = 0.f;
#pragma unroll
                for (int bj = 0; bj < 2; ++bj) { const u32x4 w = sv[m][bj]; const f32x4 a0 = acc[ai][bj][m][0], a1 = acc[ai][bj][m][1];
                    const float v0 = bflo(w.x) + a0[0] * scale, v1 = bfhi(w.x) + a0[1] * scale, v2 = bflo(w.y) + a0[2] * scale, v3 = bfhi(w.y) + a0[3] * scale;
                    const float v4 = bflo(w.z) + a1[0] * scale, v5 = bfhi(w.z) + a1[1] * scale, v6 = bflo(w.w) + a1[2] * scale, v7 = bfhi(w.w) + a1[3] * scale;
                    *(u32x4*)(dst + ro + bj * HALF) = (u32x4){cvt_pk_bf16(v0, v1), cvt_pk_bf16(v2, v3), cvt_pk_bf16(v4, v5), cvt_pk_bf16(v6, v7)};
                    ss += ((v0 * v0 + v1 * v1) + (v2 * v2 + v3 * v3)) + ((v4 * v4 + v5 * v5) + (v6 * v6 + v7 * v7)); }
                ssr[ai][m] = ss; }
        }
        float t1[2][4];
#pragma unroll
        for (int ai = 0; ai < 2; ++ai)
#pragma unroll
            for (int m = 0; m < 4; ++m) t1[ai][m] = __shfl_xor(ssr[ai][m], 16);
#pragma unroll
        for (int ai = 0; ai < 2; ++ai)
#pragma unroll
            for (int m = 0; m < 4; ++m) ssr[ai][m] += t1[ai][m];
#pragma unroll
        for (int ai = 0; ai < 2; ++ai)
#pragma unroll
            for (int m = 0; m < 4; ++m) t1[ai][m] = __shfl_xor(ssr[ai][m], 32);
#pragma unroll
        for (int ai = 0; ai < 2; ++ai)
#pragma unroll
            for (int m = 0; m < 4; ++m) if (fq == 0) red[(ai * HALF + wr * 64 + m * 16 + fr) * 4 + wc] = ssr[ai][m] + t1[ai][m];
        asm volatile("s_waitcnt lgkmcnt(0)" ::: "memory"); __builtin_amdgcn_s_barrier(); asm volatile("" ::: "memory");
        const int t = (wr * 4 + wc) * 64 + fq * 16 + fr;
        if (t < 256) { const f32x4 q = *(const LAS f32x4*)(red + t * 4); ssq[(size_t)(u.pm * BM + t) * 4 + u.pn] = (q.x + q.y) + (q.z + q.w); }
    }
};
struct EpiGate {
    static constexpr bool PERM = true; static constexpr int NST = 16;
    bf16_t* Mg; const bf16_t* gl; int ldg; const bf16_t* gl2;
    __device__ __forceinline__ void operator()(const f32x4 (&acc)[2][2][4][2], const Unit& u, int wr, int wc, int fr, int fq) const {
        const int row0 = u.pm * BM + wr * 64 + fr, col0 = u.pn * BM + wc * 32 + 8 * fq;
#pragma unroll
        for (int ai = 0; ai < 2; ++ai)
#pragma unroll
            for (int m = 0; m < 4; ++m) { const int row = row0 + ai * HALF + m * 16;
                bf16_t* mp = Mg + (size_t)row * 1024 + col0;
                const bf16_t* gp = (u.z == 2 && u.pn == 3) ? gl2 + (size_t)row * 256 + (col0 - 768) : gl + (size_t)row * ldg + u.z * 1024 + col0;
#pragma unroll
                for (int bj = 0; bj < 2; ++bj) { const f32x4 v0 = acc[ai][bj][m][0], v1 = acc[ai][bj][m][1];
                    const u32x4 g = *(const u32x4*)(gp + bj * HALF);
                    u32x4 o = (u32x4){0u, 0u, 0u, 0u};
                    if (u.z > 0) o = *(const u32x4*)(mp + bj * HALF);
                    float r[8];
                    r[0] = bflo(o.x) + sigmoidf_(bflo(g.x)) * v0[0]; r[1] = bfhi(o.x) + sigmoidf_(bfhi(g.x)) * v0[1];
                    r[2] = bflo(o.y) + sigmoidf_(bflo(g.y)) * v0[2]; r[3] = bfhi(o.y) + sigmoidf_(bfhi(g.y)) * v0[3];
                    r[4] = bflo(o.z) + sigmoidf_(bflo(g.z)) * v1[0]; r[5] = bfhi(o.z) + sigmoidf_(bfhi(g.z)) * v1[1];
                    r[6] = bflo(o.w) + sigmoidf_(bflo(g.w)) * v1[2]; r[7] = bfhi(o.w) + sigmoidf_(bfhi(g.w)) * v1[3];
                    u32x4 w; w.x = cvt_pk_bf16(r[0], r[1]); w.y = cvt_pk_bf16(r[2], r[3]); w.z = cvt_pk_bf16(r[4], r[5]); w.w = cvt_pk_bf16(r[6], r[7]);
                    *(u32x4*)(mp + bj * HALF) = w; } }
    }
};
struct EpiMkv {
    static constexpr bool PERM = true; static constexpr int NST = 16;
    bf16_t* mk; bf16_t* mvT;
    __device__ __forceinline__ void operator()(const f32x4 (&acc)[2][2][4][2], const Unit& u, int wr, int wc, int fr, int fq) const {
        const int row0 = u.pm * BM + wr * 64 + fr, col0 = u.pn * BM + wc * 32 + 8 * fq;
#pragma unroll
        for (int ai = 0; ai < 2; ++ai)
#pragma unroll
            for (int m = 0; m < 4; ++m) { const int row = row0 + ai * HALF + m * 16;
#pragma unroll
                for (int bj = 0; bj < 2; ++bj) { const f32x4 v0 = acc[ai][bj][m][0], v1 = acc[ai][bj][m][1]; const int col = col0 + bj * HALF;
                    if (u.pn < 4) {
                        u32x4 w; w.x = cvt_pk_bf16(v0[0], v0[1]); w.y = cvt_pk_bf16(v0[2], v0[3]); w.z = cvt_pk_bf16(v1[0], v1[1]); w.w = cvt_pk_bf16(v1[2], v1[3]);
                        *(u32x4*)(mk + (size_t)row * 1024 + col) = w;
                    } else {
                        const int b = row >> 8, mem = row & 255; bf16_t* base = mvT + ((size_t)b * 1024 + (col - 1024)) * 256 + mem;
#pragma unroll
                        for (int j = 0; j < 4; ++j) { base[(size_t)j * 256] = f2bf(v0[j]); base[(size_t)(4 + j) * 256] = f2bf(v1[j]); }
                    } } }
    }
};

template <class Epi>
__device__ __forceinline__ void gemm_phase(LAS unsigned char* lds, const Gemm g, const Order& S, const Epi& E, const int tid) {
    const int wid = __builtin_amdgcn_readfirstlane(tid >> 6), lane = tid & 63, wr = wid >> 2, wc = wid & 3, fr = lane & 15, fq = lane >> 4;
    const int K = g.K, nt = K / BK, lda = g.lda;
    unsigned voffA[2], voffB[2];
#pragma unroll
    for (int i = 0; i < 2; ++i) { int R, C; stage_rc(tid * 16 + i * 8192, R, C); const int Rb = Epi::PERM ? ((R & ~31) + perm32(R & 31)) : R;
        voffA[i] = (unsigned)(R * lda + C) * 2u; voffB[i] = (unsigned)(Rb * K + C) * 2u; }
    const size_t kstep = (size_t)(BK * 2);
    const size_t hstepA = (size_t)HALF * lda * 2, hstepB = (size_t)HALF * K * 2;
    const size_t tstepA = 2 * hstepA, tstepB = 2 * hstepB;
    const unsigned ldsw = (unsigned)wid * 1024u;
    const int aoff = lds_byte(wr * 64 + fr, fq * 8), boff = lds_byte(wc * 32 + fr, fq * 8);
#define PG8_SA(b, h) (((b) * 2 + (h)) * HTB)
#define PG8_SB(b, h) ((4 + (b) * 2 + (h)) * HTB)
#define PG8_STAGE(bufoff, gbase, voff) do { _Pragma("unroll") for (int _i = 0; _i < 2; ++_i) \
        __builtin_amdgcn_global_load_lds((const unsigned*)((const char*)(gbase) + (voff)[_i]), (LAS unsigned*)(lds + (bufoff) + ldsw + _i * 8192), 16, 0, 0); } while (0)
#define PG8_LDA(dst, b, h) do { _Pragma("unroll") for (int m = 0; m < 4; ++m) _Pragma("unroll") for (int k = 0; k < 2; ++k) dst[m][k] = *(const LAS bf16x8*)(lds + PG8_SA(b, h) + aoff + m * 2048 + k * 1024); } while (0)
#define PG8_LDB(dst, b, h) do { _Pragma("unroll") for (int n = 0; n < 2; ++n) _Pragma("unroll") for (int k = 0; k < 2; ++k) dst[n][k] = *(const LAS bf16x8*)(lds + PG8_SB(b, h) + boff + n * 2048 + k * 1024); } while (0)
#define PG8_MMA(ai, bj, At, Bt) do { __builtin_amdgcn_s_setprio(1); _Pragma("unroll") for (int m = 0; m < 4; ++m) _Pragma("unroll") for (int n = 0; n < 2; ++n) _Pragma("unroll") for (int k = 0; k < 2; ++k) \
        acc[ai][bj][m][n] = __builtin_amdgcn_mfma_f32_16x16x32_bf16(Bt[n][k], At[m][k], acc[ai][bj][m][n], 0, 0, 0); __builtin_amdgcn_s_setprio(0); } while (0)
#define PG8_WAIT_V(n) asm volatile("s_waitcnt vmcnt(" #n ")" ::: "memory")
#define PG8_WAIT_L(n) asm volatile("s_waitcnt lgkmcnt(" #n ")" ::: "memory")
#define PG8_WAIT_V_RX(rx) do { if constexpr (Epi::NST >= 16) asm volatile("s_cmp_lg_u32 %0, 0\n\ts_cbranch_scc1 .Lrx_skip_%=\n\ts_waitcnt vmcnt(8)\n.Lrx_skip_%=:\n\ts_waitcnt vmcnt(24)" :: "s"(rx) : "memory", "scc"); \
        else asm volatile("s_cmp_lg_u32 %0, 0\n\ts_cbranch_scc1 .Lrx_skip_%=\n\ts_waitcnt vmcnt(8)\n.Lrx_skip_%=:\n\ts_waitcnt vmcnt(16)" :: "s"(rx) : "memory", "scc"); } while (0)
#define PG8_BAR __builtin_amdgcn_s_barrier()
#define PG8_SCHED __builtin_amdgcn_sched_barrier(0)
#define PG8_ABASE(u) ((const char*)g.A + (size_t)((u).z == 0 ? g.zoff0 : (u).z == 1 ? g.zoff1 : g.zoff2) * 2 + (size_t)(u).pm * tstepA)
#define PG8_BBASE(u) ((const char*)g.Bt + (size_t)((u).z * g.zB) * 2 + (size_t)(u).pn * tstepB)
    Unit cur, nxt; int ui = 0;
    if (!S.next(0, cur)) return;
    f32x4 acc[2][2][4][2];
#pragma unroll
    for (int a = 0; a < 2; ++a)
#pragma unroll
        for (int b = 0; b < 2; ++b)
#pragma unroll
            for (int m = 0; m < 4; ++m)
#pragma unroll
                for (int n = 0; n < 2; ++n) acc[a][b][m][n] = (f32x4){0.f, 0.f, 0.f, 0.f};
    bf16x8 At[4][2], B0[2][2], B1[2][2];
    const char* cA = PG8_ABASE(cur); const char* cB = PG8_BBASE(cur);
    PG8_STAGE(PG8_SB(0, 0), cB, voffB); PG8_STAGE(PG8_SB(0, 1), cB + hstepB, voffB); PG8_STAGE(PG8_SA(0, 0), cA, voffA); PG8_STAGE(PG8_SA(0, 1), cA + hstepA, voffA);
    if (wr == 1) PG8_BAR;
    PG8_WAIT_V(2); PG8_BAR;
    PG8_STAGE(PG8_SB(1, 0), cB + kstep, voffB); PG8_STAGE(PG8_SA(1, 0), cA + kstep, voffA); PG8_STAGE(PG8_SB(1, 1), cB + hstepB + kstep, voffB);
    PG8_WAIT_V(6); PG8_BAR;
    for (;;) {
        const bool has_next = S.next(ui + 1, nxt);
        const char* nA = has_next ? PG8_ABASE(nxt) : cA; const char* nB = has_next ? PG8_BBASE(nxt) : cB;
        for (int t = 0; t < nt; t += 2) {
            const bool last = (t == nt - 2);
            const char* a1 = cA + (size_t)(t + 1) * kstep;
            const char* a2 = last ? nA : cA + (size_t)(t + 2) * kstep; const char* b2 = last ? nB : cB + (size_t)(t + 2) * kstep;
            const char* a3 = a2 + kstep; const char* b3 = b2 + kstep;
            const int rx = __builtin_amdgcn_readfirstlane(((t == 0) && (ui > 0)) ? 1 : 0);
            PG8_LDB(B0, 0, 0); PG8_LDB(B1, 0, 1); PG8_SCHED; PG8_LDA(At, 0, 0); PG8_STAGE(PG8_SA(1, 1), a1 + hstepA, voffA);
            PG8_WAIT_V_RX(rx);
            PG8_WAIT_L(0); PG8_BAR; PG8_MMA(0, 0, At, B0); PG8_MMA(0, 1, At, B1); PG8_BAR; PG8_SCHED;
            PG8_LDA(At, 0, 1); PG8_STAGE(PG8_SB(0, 0), b2, voffB); PG8_STAGE(PG8_SB(0, 1), b2 + hstepB, voffB); PG8_STAGE(PG8_SA(0, 0), a2, voffA);
            PG8_WAIT_V_RX(rx);
            PG8_WAIT_L(0); PG8_BAR; PG8_MMA(1, 0, At, B0); PG8_MMA(1, 1, At, B1); PG8_BAR; PG8_SCHED;
            PG8_LDB(B0, 1, 0); PG8_LDB(B1, 1, 1); PG8_SCHED; PG8_LDA(At, 1, 0); PG8_STAGE(PG8_SA(0, 1), a2 + hstepA, voffA);
            PG8_WAIT_V(8); PG8_WAIT_L(0); PG8_BAR; PG8_MMA(0, 0, At, B0); PG8_MMA(0, 1, At, B1); PG8_BAR; PG8_SCHED;
            PG8_LDA(At, 1, 1); PG8_STAGE(PG8_SB(1, 0), b3, voffB); PG8_STAGE(PG8_SB(1, 1), b3 + hstepB, voffB); PG8_STAGE(PG8_SA(1, 0), a3, voffA);
            PG8_WAIT_V(8); PG8_WAIT_L(0); PG8_BAR; PG8_MMA(1, 0, At, B0); PG8_MMA(1, 1, At, B1); PG8_BAR; PG8_SCHED;
        }
        if (wr == 0) PG8_BAR;
        E(acc, cur, wr, wc, fr, fq);
        if (!has_next) break;
#pragma unroll
        for (int a = 0; a < 2; ++a)
#pragma unroll
            for (int b = 0; b < 2; ++b)
#pragma unroll
                for (int m = 0; m < 4; ++m)
#pragma unroll
                    for (int n = 0; n < 2; ++n) acc[a][b][m][n] = zero4();
        cur = nxt; cA = nA; cB = nB; ++ui;
        if (wr == 1) PG8_BAR;
    }
    PG8_WAIT_V(0);
    PG8_BAR;
#undef PG8_SA
#undef PG8_SB
#undef PG8_STAGE
#undef PG8_LDA
#undef PG8_LDB
#undef PG8_MMA
#undef PG8_WAIT_V
#undef PG8_WAIT_L
#undef PG8_WAIT_V_RX
#undef PG8_BAR
#undef PG8_SCHED
#undef PG8_ABASE
#undef PG8_BBASE
}
}

__device__ __forceinline__ void rms_row_bf16(const float* xrow, const float* g, bf16_t* orow, int lane) {
    const f32x4* xr = (const f32x4*)xrow + lane; const f32x4* gr = (const f32x4*)g + lane;
    f32x4 v[4]; float s = 0.f;
#pragma unroll
    for (int j = 0; j < 4; ++j) { v[j] = xr[64 * j]; s += (v[j].x * v[j].x + v[j].y * v[j].y) + (v[j].z * v[j].z + v[j].w * v[j].w); }
    const float rstd = rsqrtf(wave_sum(s) * (1.f / 1024.f) + 1e-6f);
    u32x2* o8 = (u32x2*)orow + lane;
#pragma unroll
    for (int j = 0; j < 4; ++j) { const f32x4 gg = gr[64 * j]; u32x2 w; w.x = cvt_pk_bf16(v[j].x * rstd * gg.x, v[j].y * rstd * gg.y); w.y = cvt_pk_bf16(v[j].z * rstd * gg.z, v[j].w * rstd * gg.w); o8[64 * j] = w; }
}
__device__ __forceinline__ void rms_row_final(const bf16_t* xrow, const float* g, float* orow, int lane) {
    const u32x4 a = *((const u32x4*)xrow + lane), b = *((const u32x4*)xrow + 64 + lane);
    float v[16] = {bflo(a.x), bfhi(a.x), bflo(a.y), bfhi(a.y), bflo(a.z), bfhi(a.z), bflo(a.w), bfhi(a.w), bflo(b.x), bfhi(b.x), bflo(b.y), bfhi(b.y), bflo(b.z), bfhi(b.z), bflo(b.w), bfhi(b.w)};
    float s = 0.f;
#pragma unroll
    for (int j = 0; j < 16; ++j) s += v[j] * v[j];
    const float rstd = rsqrtf(wave_sum(s) * (1.f / 1024.f) + 1e-6f);
#pragma unroll
    for (int hh = 0; hh < 2; ++hh)
#pragma unroll
        for (int q = 0; q < 2; ++q) { const int e = hh * 512 + lane * 8 + q * 4; const f32x4 gg = *(const f32x4*)(g + e);
            *(f32x4*)(orow + e) = (f32x4){v[hh * 8 + q * 4 + 0] * rstd * gg.x, v[hh * 8 + q * 4 + 1] * rstd * gg.y, v[hh * 8 + q * 4 + 2] * rstd * gg.z, v[hh * 8 + q * 4 + 3] * rstd * gg.w}; }
}

__device__ __forceinline__ void wt_item(const float* W, int K, int N, bf16_t* WT, int mode, int item, LAS float* scr, int lane, const float* gain) {
    const int nblk = N >> 6, kb = item / nblk, nb = item - kb * nblk, k0 = kb * 64, n0 = nb * 64;
#pragma unroll 16
    for (int kk = 0; kk < 64; ++kk) scr[kk * 65 + lane] = __builtin_nontemporal_load(W + (size_t)(k0 + kk) * N + n0 + lane);
    asm volatile("s_waitcnt lgkmcnt(0)" ::: "memory");
    const int c = lane & 7;
    f32x4 ga = (f32x4){1.f, 1.f, 1.f, 1.f}, gb = ga;
    if (gain) { ga = *(const f32x4*)(gain + k0 + 8 * c); gb = *(const f32x4*)(gain + k0 + 8 * c + 4); }
#pragma unroll
    for (int j = 0; j < 8; ++j) { const int n = (lane >> 3) + 8 * j, sn = n0 + n; const LAS float* q = scr + (8 * c) * 65 + n;
        const int dr = mode == 0 ? sn : (256 * (sn >> 7) + (sn & 127) + (mode == 2 ? 128 : 0));
        u32x4 o; o.x = cvt_pk_bf16(q[0 * 65] * ga.x, q[1 * 65] * ga.y); o.y = cvt_pk_bf16(q[2 * 65] * ga.z, q[3 * 65] * ga.w); o.z = cvt_pk_bf16(q[4 * 65] * gb.x, q[5 * 65] * gb.y); o.w = cvt_pk_bf16(q[6 * 65] * gb.z, q[7 * 65] * gb.w);
        *(u32x4*)(WT + (size_t)dr * K + k0 + 8 * c) = o; }
    asm volatile("s_waitcnt lgkmcnt(0)" ::: "memory");
}

__device__ __forceinline__ void rot16(const bf16_t* row, const f32x2* tabrow, int jg, float sc, unsigned (&y1)[8], unsigned (&y2)[8]) {
    const u32x4 a0 = *(const u32x4*)(row + jg * 16), a1 = *(const u32x4*)(row + jg * 16 + 8);
    const u32x4 b0 = *(const u32x4*)(row + 64 + jg * 16), b1 = *(const u32x4*)(row + 64 + jg * 16 + 8);
    const unsigned aw[8] = {a0.x, a0.y, a0.z, a0.w, a1.x, a1.y, a1.z, a1.w};
    const unsigned bw[8] = {b0.x, b0.y, b0.z, b0.w, b1.x, b1.y, b1.z, b1.w};
    const f32x4* tp = (const f32x4*)(tabrow + jg * 16);
#pragma unroll
    for (int i = 0; i < 8; ++i) {
        const f32x4 cs = tp[i];
        const float x1a = bflo(aw[i]), x1b = bfhi(aw[i]), x2a = bflo(bw[i]), x2b = bfhi(bw[i]);
        y1[i] = cvt_pk_bf16((x1a * cs.x - x2a * cs.y) * sc, (x1b * cs.z - x2b * cs.w) * sc);
        y2[i] = cvt_pk_bf16((x1a * cs.y + x2a * cs.x) * sc, (x1b * cs.w + x2b * cs.z) * sc);
    }
}

constexpr int RP = 136;

__device__ __forceinline__ void ret_state_item(const bf16_t* proj, const f32x2* tab, bf16_t* states, int item, LAS unsigned char* lds, int tid) {
    const int wave = tid >> 6, lane = tid & 63, fr = lane & 15, fq = lane >> 4;
    const int h = item & 3, n = (item >> 2) & 31, bl = item >> 7;
    const size_t tok0 = (size_t)bl * SEQ + n * 128;
    LAS bf16_t* KT = (LAS bf16_t*)lds;
    LAS bf16_t* VT = (LAS bf16_t*)(lds + 128 * RP * 2);
    const float lg = log2g(h);
    {
        const int c = tid >> 2, jg = tid & 3;
        const bf16_t* row = proj + (tok0 + c) * INW + C_RK + h * 128;
        unsigned y1[8], y2[8];
        rot16(row, tab + (size_t)(n * 128 + c) * 64, jg, 0.08838834764831845f * exp2f(-(float)(c + 1) * lg), y1, y2);
#pragma unroll
        for (int i = 0; i < 8; ++i) {
            const int j = jg * 16 + 2 * i;
            KT[(j) * RP + c] = (bf16_t)(y1[i] & 0xffffu); KT[(j + 1) * RP + c] = (bf16_t)(y1[i] >> 16);
            KT[(j + 64) * RP + c] = (bf16_t)(y2[i] & 0xffffu); KT[(j + 65) * RP + c] = (bf16_t)(y2[i] >> 16);
        }
        const bf16_t* vrow = proj + (tok0 + c) * INW + C_RV + h * 256 + jg * 64;
#pragma unroll
        for (int i = 0; i < 8; ++i) {
            const u32x4 v = *(const u32x4*)(vrow + i * 8);
            const unsigned vw[4] = {v.x, v.y, v.z, v.w};
#pragma unroll
            for (int k = 0; k < 4; ++k) { const int e = jg * 64 + i * 8 + 2 * k; VT[e * RP + c] = (bf16_t)(vw[k] & 0xffffu); VT[(e + 1) * RP + c] = (bf16_t)(vw[k] >> 16); }
        }
    }
    __syncthreads();
    f32x4 acc[8][2];
#pragma unroll
    for (int dt = 0; dt < 8; ++dt) { acc[dt][0] = (f32x4){0.f, 0.f, 0.f, 0.f}; acc[dt][1] = (f32x4){0.f, 0.f, 0.f, 0.f}; }
#pragma unroll
    for (int ks = 0; ks < 4; ++ks) {
        bf16x8 bfr[2];
#pragma unroll
        for (int et = 0; et < 2; ++et) bfr[et] = *(const LAS bf16x8*)(VT + (32 * wave + 16 * et + fr) * RP + 32 * ks + 8 * fq);
#pragma unroll
        for (int dt = 0; dt < 8; ++dt) {
            const bf16x8 a = *(const LAS bf16x8*)(KT + (16 * dt + fr) * RP + 32 * ks + 8 * fq);
            acc[dt][0] = mfma16(a, bfr[0], acc[dt][0]); acc[dt][1] = mfma16(a, bfr[1], acc[dt][1]);
        }
    }
    const float gch = exp2f(128.f * lg);
    bf16_t* sp = states + (size_t)item * 32768;
#pragma unroll
    for (int et = 0; et < 2; ++et)
#pragma unroll
        for (int dt = 0; dt < 8; ++dt) { const f32x4 v = acc[dt][et] * gch; *(u32x2*)(sp + (size_t)(32 * wave + 16 * et + fr) * 128 + 16 * dt + 4 * fq) = (u32x2){cvt_pk_bf16(v[0], v[1]), cvt_pk_bf16(v[2], v[3])}; }
    __syncthreads();
}

__device__ __forceinline__ void ret_scan(bf16_t* states, int gtid, int nthreads, int dry) {
    for (int i = gtid; i < 16 * 8192; i += nthreads) {
        const int bh = i >> 13, off = i & 8191, bl = bh >> 2, h = bh & 3;
        const float g = exp2f(128.f * log2g(h));
        u32x2* p = (u32x2*)(states + ((size_t)(bl * 32) * 4 + h) * 32768) + off;
        f32x4 R = (f32x4){0.f, 0.f, 0.f, 0.f};
        for (int n0 = 0; n0 < 32; n0 += 8) {
            u32x2 sv[8];
#pragma unroll
            for (int k = 0; k < 8; ++k) sv[k] = p[(size_t)(n0 + k) * 32768];
#pragma unroll
            for (int k = 0; k < 8; ++k) { if (!dry) p[(size_t)(n0 + k) * 32768] = (u32x2){cvt_pk_bf16(R[0], R[1]), cvt_pk_bf16(R[2], R[3])};
                R = R * g + (f32x4){bflo(sv[k].x), bfhi(sv[k].x), bflo(sv[k].y), bfhi(sv[k].y)}; }
        }
    }
}

__device__ __forceinline__ void ret_out_item(bf16_t* proj, const f32x2* tab, const bf16_t* states, const float* gn, int item, LAS unsigned char* lds, int tid, int dry) {
    const int wave = tid >> 6, lane = tid & 63, fr = lane & 15, fq = lane >> 4;
    const int h = item & 3, n = (item >> 2) & 31, bl = item >> 7;
    const size_t tok0 = (size_t)bl * SEQ + n * 128;
    LAS bf16_t* QS = (LAS bf16_t*)lds;
    LAS bf16_t* KS = (LAS bf16_t*)(lds + 128 * RP * 2);
    LAS bf16_t* VT = (LAS bf16_t*)(lds + 2 * 128 * RP * 2);
    LAS float* red = (LAS float*)(lds + 4 * 128 * RP * 2);
    const float lg = log2g(h);
    {
        const int c = tid >> 2, jg = tid & 3;
        const f32x2* tr = tab + (size_t)(n * 128 + c) * 64;
        unsigned y1[8], y2[8];
        rot16(proj + (tok0 + c) * INW + C_RQ + h * 128, tr, jg, exp2f((float)(c + 1) * lg), y1, y2);
        *(LAS u32x4*)(QS + c * RP + jg * 16) = (u32x4){y1[0], y1[1], y1[2], y1[3]}; *(LAS u32x4*)(QS + c * RP + jg * 16 + 8) = (u32x4){y1[4], y1[5], y1[6], y1[7]};
        *(LAS u32x4*)(QS + c * RP + 64 + jg * 16) = (u32x4){y2[0], y2[1], y2[2], y2[3]}; *(LAS u32x4*)(QS + c * RP + 64 + jg * 16 + 8) = (u32x4){y2[4], y2[5], y2[6], y2[7]};
        rot16(proj + (tok0 + c) * INW + C_RK + h * 128, tr, jg, 0.08838834764831845f * exp2f(-(float)(c + 1) * lg), y1, y2);
        *(LAS u32x4*)(KS + c * RP + jg * 16) = (u32x4){y1[0], y1[1], y1[2], y1[3]}; *(LAS u32x4*)(KS + c * RP + jg * 16 + 8) = (u32x4){y1[4], y1[5], y1[6], y1[7]};
        *(LAS u32x4*)(KS + c * RP + 64 + jg * 16) = (u32x4){y2[0], y2[1], y2[2], y2[3]}; *(LAS u32x4*)(KS + c * RP + 64 + jg * 16 + 8) = (u32x4){y2[4], y2[5], y2[6], y2[7]};
        const bf16_t* vrow = proj + (tok0 + c) * INW + C_RV + h * 256 + jg * 64;
#pragma unroll
        for (int i = 0; i < 8; ++i) {
            const u32x4 v = *(const u32x4*)(vrow + i * 8);
            const unsigned vw[4] = {v.x, v.y, v.z, v.w};
#pragma unroll
            for (int k = 0; k < 4; ++k) { const int e = jg * 64 + i * 8 + 2 * k; VT[e * RP + c] = (bf16_t)(vw[k] & 0xffffu); VT[(e + 1) * RP + c] = (bf16_t)(vw[k] >> 16); }
        }
    }
    __syncthreads();
    unsigned pk[8][2];
    {
        f32x4 pacc[8];
#pragma unroll
        for (int st = 0; st < 8; ++st) pacc[st] = (f32x4){0.f, 0.f, 0.f, 0.f};
#pragma unroll
        for (int ks = 0; ks < 4; ++ks) {
            const bf16x8 b = *(const LAS bf16x8*)(QS + (16 * wave + fr) * RP + 32 * ks + 8 * fq);
#pragma unroll
            for (int st = 0; st < 8; ++st) { const bf16x8 a = *(const LAS bf16x8*)(KS + (16 * st + fr) * RP + 32 * ks + 8 * fq); pacc[st] = mfma16(a, b, pacc[st]); }
        }
        const int c = 16 * wave + fr;
#pragma unroll
        for (int st = 0; st < 8; ++st) { float v[4];
#pragma unroll
            for (int j = 0; j < 4; ++j) { const int s = 16 * st + 4 * fq + j; v[j] = (s <= c) ? pacc[st][j] : 0.f; }
            pk[st][0] = cvt_pk_bf16(v[0], v[1]); pk[st][1] = cvt_pk_bf16(v[2], v[3]); }
    }
    __syncthreads();
    {
        const int c = 16 * wave + fr;
#pragma unroll
        for (int st = 0; st < 8; ++st) *(LAS u32x2*)(KS + c * RP + 16 * st + 4 * fq) = (u32x2){pk[st][0], pk[st][1]};
    }
    __syncthreads();
    f32x4 acc[2][8];
#pragma unroll
    for (int et = 0; et < 2; ++et)
#pragma unroll
        for (int ct = 0; ct < 8; ++ct) acc[et][ct] = (f32x4){0.f, 0.f, 0.f, 0.f};
    const bf16_t* sp = states + (size_t)item * 32768;
#pragma unroll
    for (int ks = 0; ks < 4; ++ks) {
        bf16x8 av[2], ar[2];
#pragma unroll
        for (int et = 0; et < 2; ++et) {
            const int e = 32 * wave + 16 * et + fr;
            av[et] = *(const LAS bf16x8*)(VT + e * RP + 32 * ks + 8 * fq);
            ar[et] = *(const bf16x8*)(sp + (size_t)e * 128 + 32 * ks + 8 * fq);
        }
#pragma unroll
        for (int ct = 0; ct < 8; ++ct) {
            const bf16x8 bp = *(const LAS bf16x8*)(KS + (16 * ct + fr) * RP + 32 * ks + 8 * fq);
            const bf16x8 bq = *(const LAS bf16x8*)(QS + (16 * ct + fr) * RP + 32 * ks + 8 * fq);
#pragma unroll
            for (int et = 0; et < 2; ++et) { acc[et][ct] = mfma16(av[et], bp, acc[et][ct]); acc[et][ct] = mfma16(ar[et], bq, acc[et][ct]); }
        }
    }
#pragma unroll
    for (int ct = 0; ct < 8; ++ct) {
        float s = 0.f;
#pragma unroll
        for (int et = 0; et < 2; ++et) s += (acc[et][ct][0] * acc[et][ct][0] + acc[et][ct][1] * acc[et][ct][1]) + (acc[et][ct][2] * acc[et][ct][2] + acc[et][ct][3] * acc[et][ct][3]);
        s += __shfl_xor(s, 16); s += __shfl_xor(s, 32);
        if (fq == 0) red[wave * 128 + 16 * ct + fr] = s;
    }
    __syncthreads();
#pragma unroll
    for (int ct = 0; ct < 8; ++ct) {
        const int c = 16 * ct + fr;
        float s = 0.f;
#pragma unroll
        for (int w = 0; w < 8; ++w) s += red[w * 128 + c];
        const float rstd = rsqrtf(s * (1.f / 256.f) + 1e-6f);
        bf16_t* grow = proj + (tok0 + c) * INW + C_RG + h * 256;
#pragma unroll
        for (int et = 0; et < 2; ++et) {
            const int e = 32 * wave + 16 * et + 4 * fq;
            const u32x2 gw = *(const u32x2*)(grow + e);
            const f32x4 gg = *(const f32x4*)(gn + h * 256 + e);
            const float g0 = bflo(gw.x), g1 = bfhi(gw.x), g2 = bflo(gw.y), g3 = bfhi(gw.y);
            const float o0 = acc[et][ct][0] * rstd * gg.x * g0 * sigmoidf_(g0), o1 = acc[et][ct][1] * rstd * gg.y * g1 * sigmoidf_(g1);
            const float o2 = acc[et][ct][2] * rstd * gg.z * g2 * sigmoidf_(g2), o3 = acc[et][ct][3] * rstd * gg.w * g3 * sigmoidf_(g3);
            if (!dry) *(u32x2*)(grow + e) = (u32x2){cvt_pk_bf16(o0, o1), cvt_pk_bf16(o2, o3)};
        }
    }
    __syncthreads();
}

__device__ __forceinline__ int rowperm(int d) { return (d & ~31) | (((d >> 2) & 1) << 4) | (((d >> 3) & 3) << 2) | (d & 3); }
constexpr int SKP = 72, SVP = 264;
__device__ __forceinline__ void swa_item(bf16_t* proj, const float* sinks, int item, LAS unsigned char* lds, int tid, int dry) {
    const int wave = tid >> 6, lane = tid & 63, fr = lane & 15, fq = lane >> 4;
    const int kh = item & 1, n = (item >> 1) & 31, bl = item >> 6;
    const size_t tok0 = (size_t)bl * SEQ + n * 128;
    LAS bf16_t* Ks = (LAS bf16_t*)lds;
    LAS bf16_t* Vt = (LAS bf16_t*)(lds + 256 * SKP * 2);
#pragma unroll
    for (int i = 0; i < 4; ++i) {
        const int ch = tid + 512 * i, key = ch >> 3, part = ch & 7;
        u32x4 kv = (u32x4){0u, 0u, 0u, 0u}, vv = (u32x4){0u, 0u, 0u, 0u};
        if (n > 0 || key >= 128) { const bf16_t* r = proj + (tok0 + key - 128) * INW; kv = *(const u32x4*)(r + C_SK + kh * 64 + part * 8); vv = *(const u32x4*)(r + C_SV + kh * 64 + part * 8); }
        *(LAS u32x4*)(Ks + key * SKP + part * 8) = kv;
        const unsigned vw[4] = {vv.x, vv.y, vv.z, vv.w};
#pragma unroll
        for (int k = 0; k < 4; ++k) { const int d = part * 8 + 2 * k; Vt[rowperm(d) * SVP + key] = (bf16_t)(vw[k] & 0xffffu); Vt[rowperm(d + 1) * SVP + key] = (bf16_t)(vw[k] >> 16); }
    }
    __syncthreads();
    const int h = kh * 8 + wave; const float sink = sinks[h];
    for (int qt = 0; qt < 8; ++qt) {
        bf16_t* qrow = proj + (tok0 + 16 * qt + fr) * INW + C_SQ + h * 64;
        bf16x8 qf[2];
        qf[0] = *(const bf16x8*)(qrow + 8 * fq); qf[1] = *(const bf16x8*)(qrow + 32 + 8 * fq);
        f32x4 s[10];
#pragma unroll
        for (int r = 0; r < 9; ++r) { s[r] = (f32x4){0.f, 0.f, 0.f, 0.f};
#pragma unroll
            for (int ks = 0; ks < 2; ++ks) { const bf16x8 a = *(const LAS bf16x8*)(Ks + (16 * (qt + r) + fr) * SKP + 32 * ks + 8 * fq); s[r] = mfma16(a, qf[ks], s[r]); } }
        s[9] = (f32x4){0.f, 0.f, 0.f, 0.f};
        const int c = 16 * qt + fr; float mxr = -1e30f;
#pragma unroll
        for (int r = 0; r < 9; ++r) {
            const bool tile_ok = (n > 0) || (qt + r >= 8);
            if (r == 0 || r == 8 || !tile_ok) {
#pragma unroll
                for (int j = 0; j < 4; ++j) { const int kpos = 16 * (qt + r) + 4 * fq + j;
                    bool valid = tile_ok;
                    if (r == 0) valid = valid && (kpos > c);
                    if (r == 8) valid = valid && (kpos <= c + 128);
                    s[r][j] = valid ? s[r][j] : -1e30f; }
            }
            mxr = fmaxf(mxr, fmaxf(fmaxf(s[r][0], s[r][1]), fmaxf(s[r][2], s[r][3])));
        }
        mxr = fmaxf(mxr, __shfl_xor(mxr, 16)); mxr = fmaxf(mxr, __shfl_xor(mxr, 32));
        const float mx = fmaxf(mxr * 0.125f, sink);
        const float c1 = 0.125f * 1.4426950408889634f, mo = -mx * 1.4426950408889634f;
        float sum = 0.f;
#pragma unroll
        for (int r = 0; r < 9; ++r)
#pragma unroll
            for (int j = 0; j < 4; ++j) { const float pv = __builtin_amdgcn_exp2f(fmaf(s[r][j], c1, mo)); s[r][j] = pv; sum += pv; }
        sum += __shfl_xor(sum, 16); sum += __shfl_xor(sum, 32);
        sum += __expf(sink - mx);
        const float inv = __builtin_amdgcn_rcpf(sum);
        f32x4 o[4];
#pragma unroll
        for (int dt = 0; dt < 4; ++dt) o[dt] = (f32x4){0.f, 0.f, 0.f, 0.f};
#pragma unroll
        for (int k2 = 0; k2 < 5; ++k2) {
            u32x4 pw; pw.x = cvt_pk_bf16(s[2 * k2][0], s[2 * k2][1]); pw.y = cvt_pk_bf16(s[2 * k2][2], s[2 * k2][3]); pw.z = cvt_pk_bf16(s[2 * k2 + 1][0], s[2 * k2 + 1][1]); pw.w = cvt_pk_bf16(s[2 * k2 + 1][2], s[2 * k2 + 1][3]);
            const bf16x8 pf = __builtin_bit_cast(bf16x8, pw);
            const int kb = 16 * (qt + 2 * k2);
#pragma unroll
            for (int dt = 0; dt < 4; ++dt) {
                const u32x2 v0 = *(const LAS u32x2*)(Vt + (16 * dt + fr) * SVP + kb + 4 * fq), v1 = *(const LAS u32x2*)(Vt + (16 * dt + fr) * SVP + kb + (k2 == 4 ? 0 : 16) + 4 * fq);
                const bf16x8 a = __builtin_bit_cast(bf16x8, ((u32x4){v0.x, v0.y, v1.x, v1.y}));
                o[dt] = mfma16(a, pf, o[dt]);
            }
        }
#pragma unroll
        for (int pp = 0; pp < 2; ++pp) if (!dry) *(u32x4*)(qrow + 32 * pp + 8 * fq) = (u32x4){cvt_pk_bf16(o[2 * pp][0] * inv, o[2 * pp][1] * inv), cvt_pk_bf16(o[2 * pp][2] * inv, o[2 * pp][3] * inv), cvt_pk_bf16(o[2 * pp + 1][0] * inv, o[2 * pp + 1][1] * inv), cvt_pk_bf16(o[2 * pp + 1][2] * inv, o[2 * pp + 1][3] * inv)};
    }
    __syncthreads();
}

constexpr int MP = 264;
__device__ __forceinline__ void mem_item(bf16_t* proj, const bf16_t* mk, const bf16_t* mvT, int bglob0, int item, LAS unsigned char* lds, int tid, int dry) {
    const int wave = tid >> 6, lane = tid & 63, fr = lane & 15, fq = lane >> 4;
    const int qt = item & 15, h = (item >> 4) & 3, bl = item >> 6, b = bglob0 + bl;
    const size_t tok0 = (size_t)bl * SEQ + qt * 256;
    LAS bf16_t* Ms = (LAS bf16_t*)lds;
    {
        const bf16_t* src = mk + (size_t)b * 256 * 1024 + h * 256;
#pragma unroll 1
        for (int i0 = 0; i0 < 16; i0 += 8) {
            u32x4 st[8];
#pragma unroll
            for (int i = 0; i < 8; ++i) { const int ch = tid + 512 * (i0 + i), row = ch >> 5, part = ch & 31; st[i] = *(const u32x4*)(src + (size_t)row * 1024 + part * 8); }
#pragma unroll
            for (int i = 0; i < 8; ++i) { const int ch = tid + 512 * (i0 + i), row = ch >> 5, part = ch & 31; *(LAS u32x4*)(Ms + row * MP + part * 8) = st[i]; }
        }
    }
    bf16_t* qrow0 = proj + (tok0 + 16 * wave + fr) * INW + C_MQ + h * 256;
    const bf16_t* mvsrc = mvT + ((size_t)b * 1024 + h * 256) * 256;
    __syncthreads();
    bf16x8 pf[2][8]; float inv[2];
#pragma unroll
    for (int sub = 0; sub < 2; ++sub) {
        const bf16_t* qrow = qrow0 + (size_t)sub * 128 * INW;
        bf16x8 qf[8];
#pragma unroll
        for (int ks = 0; ks < 8; ++ks) qf[ks] = *(const bf16x8*)(qrow + 32 * ks + 8 * fq);
        f32x4 s[16];
#pragma unroll
        for (int t = 0; t < 16; ++t) { s[t] = (f32x4){0.f, 0.f, 0.f, 0.f};
#pragma unroll
            for (int ks = 0; ks < 8; ++ks) { const bf16x8 a = *(const LAS bf16x8*)(Ms + (16 * t + fr) * MP + 32 * ks + 8 * fq); s[t] = mfma16(a, qf[ks], s[t]); } }
        float mxr = -1e30f;
#pragma unroll
        for (int t = 0; t < 16; ++t) mxr = fmaxf(mxr, fmaxf(fmaxf(s[t][0], s[t][1]), fmaxf(s[t][2], s[t][3])));
        mxr = fmaxf(mxr, __shfl_xor(mxr, 16)); mxr = fmaxf(mxr, __shfl_xor(mxr, 32));
        const float c1 = 0.0625f * 1.4426950408889634f, mo = -mxr * c1;
        float sum = 0.f;
#pragma unroll
        for (int t = 0; t < 16; ++t)
#pragma unroll
            for (int j = 0; j < 4; ++j) { const float pv = __builtin_amdgcn_exp2f(fmaf(s[t][j], c1, mo)); s[t][j] = pv; sum += pv; }
        sum += __shfl_xor(sum, 16); sum += __shfl_xor(sum, 32);
        inv[sub] = __builtin_amdgcn_rcpf(sum);
#pragma unroll
        for (int k2 = 0; k2 < 8; ++k2) { u32x4 pw; pw.x = cvt_pk_bf16(s[2 * k2][0], s[2 * k2][1]); pw.y = cvt_pk_bf16(s[2 * k2][2], s[2 * k2][3]); pw.z = cvt_pk_bf16(s[2 * k2 + 1][0], s[2 * k2 + 1][1]); pw.w = cvt_pk_bf16(s[2 * k2 + 1][2], s[2 * k2 + 1][3]);
            pf[sub][k2] = __builtin_bit_cast(bf16x8, pw); }
    }
    __syncthreads();
    {
#pragma unroll 1
        for (int i0 = 0; i0 < 16; i0 += 8) {
            u32x4 st[8];
#pragma unroll
            for (int i = 0; i < 8; ++i) { const int ch = tid + 512 * (i0 + i), row = ch >> 5, part = ch & 31; st[i] = *(const u32x4*)(mvsrc + (size_t)row * 256 + part * 8); }
#pragma unroll
            for (int i = 0; i < 8; ++i) { const int ch = tid + 512 * (i0 + i), row = ch >> 5, part = ch & 31; *(LAS u32x4*)(Ms + rowperm(row) * MP + part * 8) = st[i]; }
        }
    }
    __syncthreads();
#pragma unroll
    for (int dp = 0; dp < 8; ++dp) {
        f32x4 oa0 = (f32x4){0.f, 0.f, 0.f, 0.f}, oa1 = oa0, ob0 = oa0, ob1 = oa0;
#pragma unroll
        for (int k2 = 0; k2 < 8; ++k2) {
            const u32x2 v0 = *(const LAS u32x2*)(Ms + (32 * dp + fr) * MP + 32 * k2 + 4 * fq), v1 = *(const LAS u32x2*)(Ms + (32 * dp + fr) * MP + 32 * k2 + 16 + 4 * fq);
            const u32x2 w0 = *(const LAS u32x2*)(Ms + (32 * dp + 16 + fr) * MP + 32 * k2 + 4 * fq), w1 = *(const LAS u32x2*)(Ms + (32 * dp + 16 + fr) * MP + 32 * k2 + 16 + 4 * fq);
            const bf16x8 a = __builtin_bit_cast(bf16x8, ((u32x4){v0.x, v0.y, v1.x, v1.y})), bb = __builtin_bit_cast(bf16x8, ((u32x4){w0.x, w0.y, w1.x, w1.y}));
            oa0 = mfma16(a, pf[0][k2], oa0); oa1 = mfma16(a, pf[1][k2], oa1); ob0 = mfma16(bb, pf[0][k2], ob0); ob1 = mfma16(bb, pf[1][k2], ob1);
        }
        if (!dry) {
            *(u32x4*)(qrow0 + 32 * dp + 8 * fq) = (u32x4){cvt_pk_bf16(oa0[0] * inv[0], oa0[1] * inv[0]), cvt_pk_bf16(oa0[2] * inv[0], oa0[3] * inv[0]), cvt_pk_bf16(ob0[0] * inv[0], ob0[1] * inv[0]), cvt_pk_bf16(ob0[2] * inv[0], ob0[3] * inv[0])};
            *(u32x4*)(qrow0 + (size_t)128 * INW + 32 * dp + 8 * fq) = (u32x4){cvt_pk_bf16(oa1[0] * inv[1], oa1[1] * inv[1]), cvt_pk_bf16(oa1[2] * inv[1], oa1[3] * inv[1]), cvt_pk_bf16(ob1[0] * inv[1], ob1[1] * inv[1]), cvt_pk_bf16(ob1[2] * inv[1], ob1[3] * inv[1])};
        }
    }
    __syncthreads();
}

#define XB_TMO      128
#define XB_XCNT(j)  (256  + 64 * (j))
#define XB_XSUB(j)  (1280 + 64 * (j))
#define XB_XGEN(j)  (2304 + 64 * (j))
#define XB_TOP      3328
#define XB_TOPGEN   3392
#define XCD_BAR_WORDS 3456
#define XB_SPIN_CAP (1u << 18)
__device__ __forceinline__ unsigned xb_ld(unsigned* p)              { return __hip_atomic_load(p, __ATOMIC_RELAXED, __HIP_MEMORY_SCOPE_AGENT); }
__device__ __forceinline__ unsigned xb_add(unsigned* p, unsigned v) { return __hip_atomic_fetch_add(p, v, __ATOMIC_RELAXED, __HIP_MEMORY_SCOPE_AGENT); }
__device__ __forceinline__ unsigned xb_xcc_id() { return (unsigned)__builtin_amdgcn_s_getreg((3 << 11) | 20) & 0xFu; }
#define XB_SPIN(cond, bar) do { unsigned _sp = 0; while (cond) { __builtin_amdgcn_s_sleep(1); \
    if ((++_sp & 255u) == 0u) { if (xb_ld(&(bar)[XB_TMO])) break; if (_sp > XB_SPIN_CAP) { atomicAdd(&(bar)[XB_TMO], 1u); break; } } } } while (0)
struct XcdBarrier { unsigned* bar; unsigned x; volatile LAS unsigned* st; };
__device__ __forceinline__ XcdBarrier xcd_barrier_post(unsigned* bar, volatile LAS unsigned* st) {
    XcdBarrier b; b.bar = bar; b.x = xb_xcc_id(); b.st = st;
    if (threadIdx.x == 0) (void)xb_add(&bar[XB_XCNT(b.x)], 1u);
    return b;
}
__device__ __forceinline__ void xcd_barrier_complete(unsigned* bar, unsigned x, unsigned& nloc, unsigned& nx) {
    const unsigned G = gridDim.x * gridDim.y * gridDim.z;
    unsigned sum, cnt, mine, sp = 0u;
    for (;;) {
        sum = 0u; cnt = 0u; mine = 0u;
#pragma unroll
        for (unsigned j = 0; j < 16; ++j) { const unsigned c = xb_ld(&bar[XB_XCNT(j)]); sum += c; cnt += (c > 0u) ? 1u : 0u; mine = (j == x) ? c : mine; }
        if (sum == G) break;
        __builtin_amdgcn_s_sleep(1);
        if ((++sp & 255u) == 0u) { if (xb_ld(&bar[XB_TMO])) break; if (sp > XB_SPIN_CAP) { atomicAdd(&bar[XB_TMO], 1u); break; } }
    }
    nloc = mine > 0u ? mine : 1u; nx = cnt > 0u ? cnt : 1u;
}
__device__ __forceinline__ void xcd_barrier(const XcdBarrier& b) {
    asm volatile("s_waitcnt vmcnt(0)" ::: "memory");
    __syncthreads();
    if (threadIdx.x == 0) {
        unsigned* bar = b.bar;
        __builtin_amdgcn_s_waitcnt(0);
        unsigned nloc = b.st[0], nx = b.st[1];
        if (nloc == 0u) { xcd_barrier_complete(bar, b.x, nloc, nx); b.st[0] = nloc; b.st[1] = nx; }
        const unsigned old = xb_add(&bar[XB_XSUB(b.x)], 1u);
        const unsigned gen = old / nloc;
        if (old + 1u == (gen + 1u) * nloc) {
            __builtin_amdgcn_fence(__ATOMIC_RELEASE, "agent");
            asm volatile("s_waitcnt vmcnt(0)" ::: "memory");
            const unsigned og = xb_add(&bar[XB_TOP], 1u);
            const unsigned tg = og / nx;
            if (og + 1u == (tg + 1u) * nx) xb_add(&bar[XB_TOPGEN], 1u);
            else XB_SPIN(xb_ld(&bar[XB_TOPGEN]) == tg, bar);
            __builtin_amdgcn_fence(__ATOMIC_ACQUIRE, "agent");
            xb_add(&bar[XB_XGEN(b.x)], 1u);
            asm volatile("s_waitcnt vmcnt(0)" ::: "memory");
        } else {
            XB_SPIN(xb_ld(&bar[XB_XGEN(b.x)]) == gen, bar);
            __builtin_amdgcn_fence(__ATOMIC_ACQUIRE, "agent");
            asm volatile("s_waitcnt vmcnt(0)" ::: "memory");
        }
    }
    __syncthreads();
}

__device__ __forceinline__ void run_phase(const Params& p, int ph, LAS unsigned char* lds, int dry) {
    int tid = threadIdx.x; asm volatile("" : "+v"(tid));
    const int lane = tid & 63, wave = tid >> 6;
    int G = gridDim.x, cu = blockIdx.x; asm volatile("" : "+s"(G), "+s"(cu));
    const int gw = cu * 8 + wave, ngw = G * 8;
    unsigned char* ws = p.ws; asm volatile("" : "+s"(ws));
    bf16_t* XB = (bf16_t*)p.out; asm volatile("" : "+s"(XB));
    const float* xin = p.in[0]; asm volatile("" : "+s"(xin));
    bf16_t* Hb = (bf16_t*)(ws + WS_H);
    if ((PHMASK & 1) && ph == NPH - 1) {
        for (int r = gw; r < T_ALL; r += ngw) rms_row_final(Hb + (size_t)r * DM, p.in[20], p.out + (size_t)r * DM, lane);
        return;
    }
    const int l = ph / NPL, k = ph - l * NPL;
    float* ssq1 = (float*)(ws + WS_SSQ); float* ssq2 = ssq1 + 4 * T_ALL; float* ssq3 = ssq2 + 4 * T_ALL;
    if (k == 0) {
        const size_t oFF = (size_t)l * DM * FF, oDD = (size_t)l * DM * DM;
        constexpr int I_F = 16 * 44, I_IN = 16 * 132, I_MKV = 16 * 32, I_DD = 16 * 16;
        constexpr int NIT = 6 * I_F + I_IN + I_MKV + 4 * I_DD;
        LAS float* scr = (LAS float*)(lds + wave * 16640);
        const float* g1 = p.in[2] + l * DM; const float* gm = p.in[6] + l * DM; const float* g2 = p.in[16] + l * DM; const float* gnone = nullptr;
        for (int it = gw; it < NIT; it += ngw) {
            int r = it;
            if (r < I_F) { wt_item(p.in[3] + oFF, DM, FF, (bf16_t*)(ws + WS_W13A), 1, r, scr, lane, g1); continue; } r -= I_F;
            if (r < I_F) { wt_item(p.in[4] + oFF, DM, FF, (bf16_t*)(ws + WS_W13A), 2, r, scr, lane, g1); continue; } r -= I_F;
            if (r < I_F) { wt_item(p.in[5] + oFF, FF, DM, (bf16_t*)(ws + WS_W2A), 0, r, scr, lane, gnone); continue; } r -= I_F;
            if (r < I_F) { wt_item(p.in[17] + oFF, DM, FF, (bf16_t*)(ws + WS_W13B), 1, r, scr, lane, g2); continue; } r -= I_F;
            if (r < I_F) { wt_item(p.in[18] + oFF, DM, FF, (bf16_t*)(ws + WS_W13B), 2, r, scr, lane, g2); continue; } r -= I_F;
            if (r < I_F) { wt_item(p.in[19] + oFF, FF, DM, (bf16_t*)(ws + WS_W2B), 0, r, scr, lane, gnone); continue; } r -= I_F;
            if (r < I_IN) { wt_item(p.in[7] + (size_t)l * DM * INW, DM, INW, (bf16_t*)(ws + WS_WIN), 0, r, scr, lane, gm); continue; } r -= I_IN;
            if (r < I_MKV) { wt_item(p.in[11] + (size_t)l * DM * 2048, DM, 2048, (bf16_t*)(ws + WS_WMKV), 0, r, scr, lane, gnone); continue; } r -= I_MKV;
            if (r < I_DD) { wt_item(p.in[12] + oDD, DM, DM, (bf16_t*)(ws + WS_WUP), 0, r, scr, lane, gnone); continue; } r -= I_DD;
            if (r < I_DD) { wt_item(p.in[13] + oDD, DM, DM, (bf16_t*)(ws + WS_WUP) + (size_t)DM * DM, 0, r, scr, lane, gnone); continue; } r -= I_DD;
            if (r < I_DD) { wt_item(p.in[14] + oDD, DM, DM, (bf16_t*)(ws + WS_WUP) + (size_t)2 * DM * DM, 0, r, scr, lane, gnone); continue; } r -= I_DD;
            wt_item(p.in[15] + oDD, DM, DM, (bf16_t*)(ws + WS_WO), 0, r, scr, lane, gnone);
        }
        for (int r = gw; r < 2048; r += ngw) rms_row_bf16(p.in[1] + (size_t)r * DM, p.in[10] + l * DM, (bf16_t*)(ws + WS_MEMH) + (size_t)r * DM, lane);
        if (l == 0) {
            for (int r = gw; r < T_ALL; r += ngw) {
                const f32x4* xr = (const f32x4*)(xin + (size_t)r * DM) + lane; u32x2* o8 = (u32x2*)(XB + (size_t)r * DM) + lane; float sacc = 0.f;
#pragma unroll
                for (int j = 0; j < 4; ++j) { const f32x4 v = __builtin_nontemporal_load(xr + 64 * j); sacc += (v.x * v.x + v.y * v.y) + (v.z * v.z + v.w * v.w); o8[64 * j] = (u32x2){cvt_pk_bf16(v.x, v.y), cvt_pk_bf16(v.z, v.w)}; }
                sacc = wave_sum(sacc); if (lane == 0) *(f32x4*)(ssq1 + (size_t)r * 4) = (f32x4){sacc, 0.f, 0.f, 0.f};
            }
            f32x2* tab = (f32x2*)(ws + WS_TAB);
            for (int i = cu * 512 + tid; i < SEQ * 64; i += G * 512) {
                const int pos = i >> 6, j = i & 63;
                const float inv = exp2f(-(float)j * (13.287712379549449f / 64.f));
                const float ang = (float)pos * inv;
                double rr = (double)ang * 0.15915494309189535; rr -= rint(rr);
                const float rf = (float)rr;
                tab[i] = (f32x2){__builtin_amdgcn_cosf(rf), __builtin_amdgcn_sinf(rf)};
            }
        }
        return;
    }
    if (k == 1 || k == 14) {
        pg8::Gemm g; g.A = XB; g.Bt = (const bf16_t*)(ws + (k == 1 ? WS_W13A : WS_W13B)); g.M = T_ALL; g.N = 2 * FF; g.K = DM; g.lda = DM; g.zoff0 = g.zoff1 = g.zoff2 = 0; g.zB = 0;
        pg8::Order S; S.init(g.M, g.N, G, cu, 1);
        LAS float* rtab = (LAS float*)(lds + pg8::STAGE_BYTES);
        { const float* sq = (k == 1) ? ssq1 : ssq3; pg8::Unit uu;
          for (int i = 0; i < 12 && S.next(i, uu); ++i) if (tid < 256) { const f32x4 q = *(const f32x4*)(sq + (size_t)(uu.pm * 256 + tid) * 4); rtab[i * 256 + tid] = rsqrtf(((q.x + q.y) + (q.z + q.w)) * (1.f / 1024.f) + 1e-6f); } }
        __syncthreads();
        pg8::EpiSwiglu E; E.U = (bf16_t*)(ws + WS_U); E.ldu = FF; E.rtab = rtab;
        pg8::gemm_phase(lds, g, S, E, tid);
        return;
    }
    if (k == 2 || k == 15 || k == 13) {
        pg8::Gemm g; pg8::EpiResid E; E.red = (LAS float*)(lds + pg8::STAGE_BYTES); g.zoff0 = g.zoff1 = g.zoff2 = 0; g.zB = 0; g.N = DM; g.M = T_ALL; E.ld = DM; E.src = XB; E.dst = XB;
        if (k == 2 || k == 15) {
            g.A = (const bf16_t*)(ws + WS_U); g.Bt = (const bf16_t*)(ws + (k == 2 ? WS_W2A : WS_W2B)); g.K = FF; g.lda = FF;
            E.scale = dry ? 0.f : 0.5f; E.ssq = (k == 2) ? ssq2 : ssq1;
            if (k == 15 && l == 1) E.dst = Hb;
        } else {
            g.A = Hb; g.Bt = (const bf16_t*)(ws + WS_WO); g.K = DM; g.lda = DM;
            E.scale = dry ? 0.f : 1.0f; E.ssq = ssq3;
        }
        pg8::Order S; S.init(g.M, g.N, G, cu, 1, 1);
        pg8::gemm_phase(lds, g, S, E, tid);
        return;
    }
    const int half = (k - 3) / 5, s = (k - 3) - 5 * half;
    bf16_t* proj = (bf16_t*)(ws + WS_PROJ);
    bf16_t* states = (bf16_t*)(ws + WS_ST);
    const f32x2* tab = (const f32x2*)(ws + WS_TAB);
    if (s == 0) {
        LAS float* rtab = (LAS float*)(lds + pg8::STAGE_BYTES);
        {
            pg8::Gemm g; g.A = XB + (size_t)half * T_HALF * DM; g.Bt = (const bf16_t*)(ws + WS_WIN); g.M = T_HALF; g.N = 8192; g.K = DM; g.lda = DM; g.zoff0 = g.zoff1 = g.zoff2 = 0; g.zB = 0;
            pg8::Order S; S.init(g.M, g.N, G, cu, 1, 2);
            { const float* sq = ssq2 + (size_t)half * T_HALF * 4; pg8::Unit uu;
              for (int i = 0; i < 12 && S.next(i, uu); ++i) if (tid < 256) { const f32x4 q = *(const f32x4*)(sq + (size_t)(uu.pm * 256 + tid) * 4); rtab[i * 256 + tid] = rsqrtf(((q.x + q.y) + (q.z + q.w)) * (1.f / 1024.f) + 1e-6f); } }
            __syncthreads();
            pg8::EpiStore E; E.O = proj; E.ldc = INW; E.rtab = rtab;
            pg8::gemm_phase(lds, g, S, E, tid);
        }
        if (half == 0) {
            {
                pg8::Gemm g; g.A = XB; g.Bt = (const bf16_t*)(ws + WS_WIN) + (size_t)8192 * DM; g.M = T_ALL; g.N = 256; g.K = DM; g.lda = DM; g.zoff0 = g.zoff1 = g.zoff2 = 0; g.zB = 0;
                pg8::Order S; S.init(g.M, g.N, G, cu < 128 ? cu : G, 1);
                { pg8::Unit uu;
                  for (int i = 0; i < 12 && S.next(i, uu); ++i) if (tid < 256) { const f32x4 q = *(const f32x4*)(ssq2 + (size_t)(uu.pm * 256 + tid) * 4); rtab[i * 256 + tid] = rsqrtf(((q.x + q.y) + (q.z + q.w)) * (1.f / 1024.f) + 1e-6f); } }
                __syncthreads();
                pg8::EpiStore E; E.O = (bf16_t*)(ws + WS_GL2); E.ldc = 256; E.rtab = rtab;
                pg8::gemm_phase(lds, g, S, E, tid);
            }
            {
                pg8::Gemm g2; g2.A = (const bf16_t*)(ws + WS_MEMH); g2.Bt = (const bf16_t*)(ws + WS_WMKV); g2.M = 2048; g2.N = 2048; g2.K = DM; g2.lda = DM; g2.zoff0 = g2.zoff1 = g2.zoff2 = 0; g2.zB = 0;
                pg8::Order S2; S2.init(2048, 2048, G, (cu >= 128 && cu < 192) ? cu - 128 : G, 1);
                pg8::EpiMkv E2; E2.mk = (bf16_t*)(ws + WS_MK); E2.mvT = (bf16_t*)(ws + WS_MVT);
                pg8::gemm_phase(lds, g2, S2, E2, tid);
            }
        }
        return;
    }
    if (s == 1) {
#ifndef MIXSUB
#define MIXSUB 7
#endif
        if (!dry || (MIXSUB & 1)) for (int it = cu; it < 512; it += G) ret_state_item(proj, tab, states, it, lds, tid);
        if (!dry || (MIXSUB & 2)) for (int it = cu; it < 256; it += G) {
            const int its = (G == 256) ? (((((it & 7) >> 1) * 32 + (it >> 3)) << 1) | (it & 1)) : it;
            swa_item(proj, p.in[9] + l * 16, its, lds, tid, dry);
        }
        if (!dry || (MIXSUB & 4)) for (int it = cu; it < 256; it += G) {
            const int itm = (G == 256) ? ((((it & 7) * 2 + (it >> 7)) << 4) | ((it >> 3) & 15)) : it;
            mem_item(proj, (const bf16_t*)(ws + WS_MK), (const bf16_t*)(ws + WS_MVT), half * 4, itm, lds, tid, dry);
        }
        return;
    }
    if (s == 2) { ret_scan(states, cu * 512 + tid, G * 512, dry); return; }
    if (s == 3) {
        for (int it = cu; it < 512; it += G) ret_out_item(proj, tab, states, p.in[8] + l * 1024, it, lds, tid, dry);
        return;
    }
    {
        pg8::Gemm g; g.A = proj; g.Bt = (const bf16_t*)(ws + WS_WUP); g.M = T_HALF; g.N = DM; g.K = DM; g.lda = INW; g.zoff0 = C_RG; g.zoff1 = C_SQ; g.zoff2 = C_MQ; g.zB = (long)DM * DM;
        pg8::Order S; S.init(g.M, g.N, G, cu, 3);
        pg8::EpiGate E; E.Mg = Hb + (size_t)half * T_HALF * DM; E.gl = proj + C_GL; E.ldg = INW; E.gl2 = (const bf16_t*)(ws + WS_GL2) + (size_t)half * T_HALF * 256;
        pg8::gemm_phase(lds, g, S, E, tid);
    }
}

__global__ __launch_bounds__(512, 2) void mega(Params p, int ph_lo, int ph_hi) {
    extern __shared__ __attribute__((aligned(16))) unsigned char shm[];
    LAS unsigned char* lds = (LAS unsigned char*)shm;
    cg::grid_group grid = cg::this_grid();
    volatile LAS unsigned* st = (volatile LAS unsigned*)(lds + LDS_PHASE);
    if (threadIdx.x == 0) { st[0] = 0u; st[1] = 0u; st[2] = 0u; st[3] = 0u; }
    __syncthreads();
    const XcdBarrier xb = xcd_barrier_post((unsigned*)(p.ws + WS_BAR), st);
    for (int ph = ph_lo; ph < ph_hi; ++ph) {
        int nrep = 1;
#if DBL_MASK
        { const int kk = (ph == NPH - 1) ? 16 : ph % NPL; nrep += (DBL_MASK >> kk) & 1; }
#endif
        for (int rep = 0; rep < nrep; ++rep) { int dry = rep; asm volatile("" : "+s"(dry)); run_phase(p, ph, lds, dry); if (rep + 1 < nrep) __syncthreads(); }
        if (ph + 1 < ph_hi) { if (ph_hi < 0) grid.sync(); else xcd_barrier(xb); }
    }
}

extern "C" void kernel_launch(void* const* d_in, const int* in_sizes, int n_in, void* d_out, int out_size, void* d_ws, size_t ws_size, hipStream_t stream) {
    static int grid = 0;
    if (grid == 0) {
        if (n_in != 21 || out_size != T_ALL * DM || ws_size < WS_END2) { fprintf(stderr, "kernel_launch: unexpected shapes (n_in %d out %d ws %zu need %zu)\n", n_in, out_size, ws_size, (size_t)WS_END2); grid = -1; return; }
        int dev = 0, cus = 0, per_cu = 0;
        if (hipGetDevice(&dev) != hipSuccess || hipDeviceGetAttribute(&cus, hipDeviceAttributeMultiprocessorCount, dev) != hipSuccess) { grid = -1; return; }
        if (hipFuncSetAttribute((const void*)mega, hipFuncAttributeMaxDynamicSharedMemorySize, LDS_BYTES) != hipSuccess) { fprintf(stderr, "kernel_launch: hipFuncSetAttribute failed\n"); grid = -1; return; }
        if (hipOccupancyMaxActiveBlocksPerMultiprocessor(&per_cu, (const void*)mega, 512, LDS_BYTES) != hipSuccess || per_cu < 1) { fprintf(stderr, "kernel_launch: occupancy query says %d\n", per_cu); per_cu = 1; }
        (void)hipGetLastError();
        grid = cus;
    }
    if (grid <= 0) return;
    Params p{};
    for (int i = 0; i < 21; ++i) p.in[i] = (const float*)d_in[i];
    p.out = (float*)d_out; p.ws = (unsigned char*)d_ws;
    (void)hipMemsetAsync((unsigned char*)d_ws + WS_BAR, 0, 16384, stream);
#if MK_ONE_LAUNCH
    int lo = 0, hi = NPH;
    void* args[] = {&p, &lo, &hi};
    hipError_t e = hipLaunchCooperativeKernel((const void*)mega, dim3(grid), dim3(512), args, LDS_BYTES, stream);
    if (e != hipSuccess) fprintf(stderr, "cooperative launch failed: %s (grid %d)\n", hipGetErrorString(e), grid);
#else
    for (int ph = 0; ph < NPH; ++ph) hipLaunchKernelGGL(mega, dim3(grid), dim3(512), LDS_BYTES, stream, p, ph, ph + 1);
#endif
}
```

```cpp
#include <hip/hip_runtime.h>
#include <hip/hip_cooperative_groups.h>
#include <cstdio>
#include <cstdint>
namespace cg = cooperative_groups;

#ifndef MK_ONE_LAUNCH
#define MK_ONE_LAUNCH 1
#endif

#ifndef DBL_MASK
#define DBL_MASK 0
#endif
#ifndef PHMASK
#define PHMASK 0xffff
#endif
#define LAS __attribute__((address_space(3)))
#define GAS __attribute__((address_space(1)))
typedef unsigned short bf16_t;
typedef short bf16x8 __attribute__((ext_vector_type(8)));
typedef short bf16x4 __attribute__((ext_vector_type(4)));
typedef float f32x4 __attribute__((ext_vector_type(4)));
typedef float f32x2 __attribute__((ext_vector_type(2)));
typedef unsigned u32x4 __attribute__((ext_vector_type(4)));
typedef unsigned u32x2 __attribute__((ext_vector_type(2)));

constexpr int T_ALL = 32768, DM = 1024, FF = 2816, INW = 8448, T_HALF = 16384, SEQ = 4096;
constexpr int C_RQ = 0, C_RK = 512, C_RV = 1024, C_RG = 2048, C_SQ = 3072, C_SK = 4096, C_SV = 4224, C_MQ = 4352, C_GL = 5376;
constexpr int LDS_PHASE = 143360, LDS_BYTES = LDS_PHASE + 16;
constexpr int NPL = 16, NPH = 2 * NPL + 1;

constexpr size_t SZ_W13 = (size_t)2 * FF * DM * 2, SZ_W2 = (size_t)DM * FF * 2;
constexpr size_t WS_W13A = 0, WS_W2A = WS_W13A + SZ_W13, WS_W13B = WS_W2A + SZ_W2, WS_W2B = WS_W13B + SZ_W13;
constexpr size_t WS_WIN = WS_W2B + SZ_W2, WS_WMKV = WS_WIN + (size_t)INW * DM * 2, WS_WUP = WS_WMKV + (size_t)2048 * DM * 2;
constexpr size_t WS_WO = WS_WUP + (size_t)3 * DM * DM * 2, WS_TAB = WS_WO + (size_t)DM * DM * 2;
constexpr size_t WS_MEMH = WS_TAB + (size_t)SEQ * 64 * 8, WS_MK = WS_MEMH + (size_t)2048 * DM * 2, WS_MVT = WS_MK + (size_t)2048 * DM * 2;
constexpr size_t WS_H = WS_MVT + (size_t)2048 * DM * 2, WS_TMP = WS_H + (size_t)T_ALL * DM * 2;
constexpr size_t WS_U = WS_TMP, WS_PROJ = WS_TMP, WS_ST = WS_PROJ + (size_t)T_HALF * INW * 2;
constexpr size_t WS_BAR = WS_ST + (size_t)512 * 32768 * 4;
constexpr size_t WS_SSQ = WS_BAR + 16384;
constexpr size_t WS_END = WS_SSQ + (size_t)3 * T_ALL * 16;
constexpr size_t WS_GL2 = WS_END;
constexpr size_t WS_END2 = WS_GL2 + (size_t)T_ALL * 256 * 2;
constexpr size_t WS_XB3 = WS_TMP + (size_t)192 * 1024 * 1024;

struct Params {
    const float* in[21];
    float* out;
    unsigned char* ws;
};

__device__ __forceinline__ unsigned cvt_pk_bf16(float lo, float hi) { unsigned r; asm volatile("v_cvt_pk_bf16_f32 %0, %1, %2" : "=v"(r) : "v"(lo), "v"(hi)); return r; }
__device__ __forceinline__ bf16_t f2bf(float f) { return (bf16_t)(cvt_pk_bf16(f, 0.f) & 0xffffu); }
__device__ __forceinline__ float bf2f(unsigned b) { return __uint_as_float(b << 16); }
__device__ __forceinline__ float bflo(unsigned w) { return __uint_as_float(w << 16); }
__device__ __forceinline__ float bfhi(unsigned w) { return __uint_as_float(w & 0xffff0000u); }
__device__ __forceinline__ float wave_sum(float v) {
#pragma unroll
    for (int o = 1; o < 64; o <<= 1) v += __shfl_xor(v, o);
    return v;
}
__device__ __forceinline__ f32x4 zero4() {
    typedef double f64x2 __attribute__((ext_vector_type(2)));
    double lo, hi;
    asm volatile("v_mov_b64 %0, 0" : "=v"(lo));
    asm volatile("v_mov_b64 %0, 0" : "=v"(hi));
    return __builtin_bit_cast(f32x4, ((f64x2){lo, hi}));
}
__device__ __forceinline__ f32x4 mfma16(bf16x8 a, bf16x8 b, f32x4 c) { return __builtin_amdgcn_mfma_f32_16x16x32_bf16(a, b, c, 0, 0, 0); }
__device__ __forceinline__ float sigmoidf_(float x) { return __builtin_amdgcn_rcpf(1.0f + __builtin_amdgcn_exp2f(x * -1.4426950408889634f)); }
__device__ __forceinline__ float log2g(int h) { return h == 0 ? -0.04580368961312479f : h == 1 ? -0.02272007650008353f : h == 2 ? -0.011315313227834146f : -0.005646563141142063f; }

namespace pg8 {
constexpr int BM = 256, BK = 64, HALF = 128, HTB = HALF * BK * 2, STAGE_BYTES = 8 * HTB, NXCD = 8, WGM = 8;
__host__ __device__ __forceinline__ int lds_byte(int r, int c) { const int st = (r >> 4) * 2 + (c >> 5), rr = r & 15, cc = c & 31, ob = rr * 64 + cc * 2; return st * 1024 + (ob ^ (((ob >> 9) & 1) << 5)); }
__host__ __device__ __forceinline__ void stage_rc(int b, int& R, int& C) { const int st = b / 1024, sb = b % 1024, swz = sb ^ (((sb >> 9) & 1) << 5); R = (st >> 1) * 16 + swz / 64; C = (st & 1) * 32 + (swz % 64) / 2; }
__host__ __device__ __forceinline__ int perm32(int rho) { const int n = rho >> 4, i = rho & 15; return 8 * (i >> 2) + 4 * n + (i & 3); }

struct Unit { int pm, pn, z, idx; };
struct Gemm { const bf16_t* A; const bf16_t* Bt; int M, N, K, lda; int zoff0, zoff1, zoff2; long zB; };

struct Order {
    int nM, nN, nwg, G, c, nZ, rev;
    __device__ void init(int M, int N, int G_, int c_, int nZ_, int rev_ = 0) { nM = M / BM; nN = N / BM; nwg = nM * nN; G = G_; c = c_; nZ = nZ_; rev = rev_; }
    __device__ bool next(int i, Unit& u) const {
        int rnd = i, z = 0;
        if (nZ == 3) { rnd = i / 3; z = i - 3 * rnd; }
        u.z = z; u.idx = i;
        const long L = (long)rnd * G + c; if (L >= nwg) return false;
        int wgid = (int)L; { const int q = nwg / NXCD, r = nwg % NXCD, xcd = wgid % NXCD, off = wgid / NXCD; wgid = (xcd < r ? xcd * (q + 1) : r * (q + 1) + (xcd - r) * q) + off; }
        const int nig = WGM * nN, gid = wgid / nig, fm = gid * WGM, gsz = (nM - fm) < WGM ? (nM - fm) : WGM;
        u.pm = fm + ((wgid % nig) % gsz); u.pn = (wgid % nig) / gsz;
        if (rev & 1) u.pm = nM - 1 - u.pm;
        if (rev & 2) u.pn = nN - 1 - u.pn;
        return true;
    }
};

struct EpiStore {
    static constexpr bool PERM = true; static constexpr int NST = 16;
    bf16_t* O; int ldc; const LAS float* rtab;
    __device__ __forceinline__ void operator()(const f32x4 (&acc)[2][2][4][2], const Unit& u, int wr, int wc, int fr, int fq) const {
        const int row0 = u.pm * BM + wr * 64 + fr, col0 = u.pn * BM + wc * 32 + 8 * fq;
        const LAS float* rt = rtab + u.idx * 256 + wr * 64 + fr;
#pragma unroll
        for (int ai = 0; ai < 2; ++ai)
#pragma unroll
            for (int m = 0; m < 4; ++m) { bf16_t* rowp = O + (size_t)(row0 + ai * HALF + m * 16) * ldc + col0;
                const float rs = rt[ai * HALF + m * 16];
#pragma unroll
                for (int bj = 0; bj < 2; ++bj) { const f32x4 v0 = acc[ai][bj][m][0] * rs, v1 = acc[ai][bj][m][1] * rs;
                    u32x4 w; w.x = cvt_pk_bf16(v0[0], v0[1]); w.y = cvt_pk_bf16(v0[2], v0[3]); w.z = cvt_pk_bf16(v1[0], v1[1]); w.w = cvt_pk_bf16(v1[2], v1[3]);
                    *(u32x4*)(rowp + bj * HALF) = w; } }
    }
};
struct EpiSwiglu {
    static constexpr bool PERM = true; static constexpr int NST = 8;
    bf16_t* U; int ldu; const LAS float* rtab;
    __device__ __forceinline__ void operator()(const f32x4 (&acc)[2][2][4][2], const Unit& u, int wr, int wc, int fr, int fq) const {
        const int row0 = u.pm * BM + wr * 64 + fr, col0 = u.pn * 128 + wc * 32 + 8 * fq;
        const LAS float* rt = rtab + u.idx * 256 + wr * 64 + fr;
#pragma unroll
        for (int ai = 0; ai < 2; ++ai)
#pragma unroll
            for (int m = 0; m < 4; ++m) { bf16_t* rowp = U + (size_t)(row0 + ai * HALF + m * 16) * ldu + col0;
                const float rs = rt[ai * HALF + m * 16];
                const float ke = rs * -1.4426950408889634f, rs2 = rs * rs;
                float r[8];
#pragma unroll
                for (int n = 0; n < 2; ++n) { const f32x4 a = acc[ai][0][m][n], b = acc[ai][1][m][n];
                    const f32x4 ab = a * b * rs2, ea = a * ke;
#pragma unroll
                    for (int j = 0; j < 4; ++j) r[4 * n + j] = ab[j] * __builtin_amdgcn_rcpf(1.0f + __builtin_amdgcn_exp2f(ea[j])); }
                *(u32x4*)rowp = (u32x4){cvt_pk_bf16(r[0], r[1]), cvt_pk_bf16(r[2], r[3]), cvt_pk_bf16(r[4], r[5]), cvt_pk_bf16(r[6], r[7])}; }
    }
};
struct EpiResid {
    static constexpr bool PERM = true; static constexpr int NST = 16;
    const bf16_t* src; bf16_t* dst; float* ssq; int ld; float scale; LAS float* red;
    __device__ __forceinline__ void operator()(const f32x4 (&acc)[2][2][4][2], const Unit& u, int wr, int wc, int fr, int fq) const {
        const int row0 = u.pm * BM + wr * 64 + fr, col0 = u.pn * BM + wc * 32 + 8 * fq;
        float ssr[2][4];
#pragma unroll
        for (int ai = 0; ai < 2; ++ai) {
            u32x4 sv[4][2];
#pragma unroll
            for (int m = 0; m < 4; ++m)
#pragma unroll
                for (int bj = 0; bj < 2; ++bj) sv[m][bj] = *(const u32x4*)(src + (size_t)(row0 + ai * HALF + m * 16) * ld + col0 + bj * HALF);
#pragma unroll
            for (int m = 0; m < 4; ++m) { const size_t ro = (size_t)(row0 + ai * HALF + m * 16) * ld + col0; float ss = 0.f;
#pragma unroll
                for (int bj = 0; bj < 2; ++bj) { const u32x4 w = sv[m][bj]; const f32x4 a0 = acc[ai][bj][m][0], a1 = acc[ai][bj][m][1];
                    const float v0 = bflo(w.x) + a0[0] * scale, v1 = bfhi(w.x) + a0[1] * scale, v2 = bflo(w.y) + a0[2] * scale, v3 = bfhi(w.y) + a0[3] * scale;
                    const float v4 = bflo(w.z) + a1[0] * scale, v5 = bfhi(w.z) + a1[1] * scale, v6 = bflo(w.w) + a1[2] * scale, v7 = bfhi(w.w) + a1[3] * scale;
                    *(u32x4*)(dst + ro + bj * HALF) = (u32x4){cvt_pk_bf16(v0, v1), cvt_pk_bf16(v2, v3), cvt_pk_bf16(v4, v5), cvt_pk_bf16(v6, v7)};
                    ss += ((v0 * v0 + v1 * v1) + (v2 * v2 + v3 * v3)) + ((v4 * v4 + v5 * v5) + (v6 * v6 + v7 * v7)); }
                ssr[ai][m] = ss; }
        }
        float t1[2][4];
#pragma unroll
        for (int ai = 0; ai < 2; ++ai)
#pragma unroll
            for (int m = 0; m < 4; ++m) t1[ai][m] = __shfl_xor(ssr[ai][m], 16);
#pragma unroll
        for (int ai = 0; ai < 2; ++ai)
#pragma unroll
            for (int m = 0; m < 4; ++m) ssr[ai][m] += t1[ai][m];
#pragma unroll
        for (int ai = 0; ai < 2; ++ai)
#pragma unroll
            for (int m = 0; m < 4; ++m) t1[ai][m] = __shfl_xor(ssr[ai][m], 32);
#pragma unroll
        for (int ai = 0; ai < 2; ++ai)
#pragma unroll
            for (int m = 0; m < 4; ++m) if (fq == 0) red[(ai * HALF + wr * 64 + m * 16 + fr) * 4 + wc] = ssr[ai][m] + t1[ai][m];
        asm volatile("s_waitcnt lgkmcnt(0)" ::: "memory"); __builtin_amdgcn_s_barrier(); asm volatile("" ::: "memory");
        const int t = (wr * 4 + wc) * 64 + fq * 16 + fr;
        if (t < 256) { const f32x4 q = *(const LAS f32x4*)(red + t * 4); ssq[(size_t)(u.pm * BM + t) * 4 + u.pn] = (q.x + q.y) + (q.z + q.w); }
    }
};
struct EpiGate {
    static constexpr bool PERM = true; static constexpr int NST = 16;
    bf16_t* Mg; const bf16_t* gl; int ldg; const bf16_t* gl2;
    __device__ __forceinline__ void operator()(const f32x4 (&acc)[2][2][4][2], const Unit& u, int wr, int wc, int fr, int fq) const {
        const int row0 = u.pm * BM + wr * 64 + fr, col0 = u.pn * BM + wc * 32 + 8 * fq;
#pragma unroll
        for (int ai = 0; ai < 2; ++ai)
#pragma unroll
            for (int m = 0; m < 4; ++m) { const int row = row0 + ai * HALF + m * 16;
                bf16_t* mp = Mg + (size_t)row * 1024 + col0;
                const bf16_t* gp = (u.z == 2 && u.pn == 3) ? gl2 + (size_t)row * 256 + (col0 - 768) : gl + (size_t)row * ldg + u.z * 1024 + col0;
#pragma unroll
                for (int bj = 0; bj < 2; ++bj) { const f32x4 v0 = acc[ai][bj][m][0], v1 = acc[ai][bj][m][1];
                    const u32x4 g = *(const u32x4*)(gp + bj * HALF);
                    u32x4 o = (u32x4){0u, 0u, 0u, 0u};
                    if (u.z > 0) o = *(const u32x4*)(mp + bj * HALF);
                    float r[8];
                    r[0] = bflo(o.x) + sigmoidf_(bflo(g.x)) * v0[0]; r[1] = bfhi(o.x) + sigmoidf_(bfhi(g.x)) * v0[1];
                    r[2] = bflo(o.y) + sigmoidf_(bflo(g.y)) * v0[2]; r[3] = bfhi(o.y) + sigmoidf_(bfhi(g.y)) * v0[3];
                    r[4] = bflo(o.z) + sigmoidf_(bflo(g.z)) * v1[0]; r[5] = bfhi(o.z) + sigmoidf_(bfhi(g.z)) * v1[1];
                    r[6] = bflo(o.w) + sigmoidf_(bflo(g.w)) * v1[2]; r[7] = bfhi(o.w) + sigmoidf_(bfhi(g.w)) * v1[3];
                    u32x4 w; w.x = cvt_pk_bf16(r[0], r[1]); w.y = cvt_pk_bf16(r[2], r[3]); w.z = cvt_pk_bf16(r[4], r[5]); w.w = cvt_pk_bf16(r[6], r[7]);
                    *(u32x4*)(mp + bj * HALF) = w; } }
    }
};
struct EpiMkv {
    static constexpr bool PERM = true; static constexpr int NST = 16;
    bf16_t* mk; bf16_t* mvT;
    __device__ __forceinline__ void operator()(const f32x4 (&acc)[2][2][4][2], const Unit& u, int wr, int wc, int fr, int fq) const {
        const int row0 = u.pm * BM + wr * 64 + fr, col0 = u.pn * BM + wc * 32 + 8 * fq;
#pragma unroll
        for (int ai = 0; ai < 2; ++ai)
#pragma unroll
            for (int m = 0; m < 4; ++m) { const int row = row0 + ai * HALF + m * 16;
#pragma unroll
                for (int bj = 0; bj < 2; ++bj) { const f32x4 v0 = acc[ai][bj][m][0], v1 = acc[ai][bj][m][1]; const int col = col0 + bj * HALF;
                    if (u.pn < 4) {
                        u32x4 w; w.x = cvt_pk_bf16(v0[0], v0[1]); w.y = cvt_pk_bf16(v0[2], v0[3]); w.z = cvt_pk_bf16(v1[0], v1[1]); w.w = cvt_pk_bf16(v1[2], v1[3]);
                        *(u32x4*)(mk + (size_t)row * 1024 + col) = w;
                    } else {
                        const int b = row >> 8, mem = row & 255; bf16_t* base = mvT + ((size_t)b * 1024 + (col - 1024)) * 256 + mem;
#pragma unroll
                        for (int j = 0; j < 4; ++j) { base[(size_t)j * 256] = f2bf(v0[j]); base[(size_t)(4 + j) * 256] = f2bf(v1[j]); }
                    } } }
    }
};

template <class Epi>
__device__ __forceinline__ void gemm_phase(LAS unsigned char* lds, const Gemm g, const Order& S, const Epi& E, const int tid) {
    const int wid = __builtin_amdgcn_readfirstlane(tid >> 6), lane = tid & 63, wr = wid >> 2, wc = wid & 3, fr = lane & 15, fq = lane >> 4;
    const int K = g.K, nt = K / BK, lda = g.lda;
    unsigned voffA[2], voffB[2];
#pragma unroll
    for (int i = 0; i < 2; ++i) { int R, C; stage_rc(tid * 16 + i * 8192, R, C); const int Rb = Epi::PERM ? ((R & ~31) + perm32(R & 31)) : R;
        voffA[i] = (unsigned)(R * lda + C) * 2u; voffB[i] = (unsigned)(Rb * K + C) * 2u; }
    const size_t kstep = (size_t)(BK * 2);
    const size_t hstepA = (size_t)HALF * lda * 2, hstepB = (size_t)HALF * K * 2;
    const size_t tstepA = 2 * hstepA, tstepB = 2 * hstepB;
    const unsigned ldsw = (unsigned)wid * 1024u;
    const unsigned ldsbase = (unsigned)(size_t)lds;
    const int aoff = lds_byte(wr * 64 + fr, fq * 8), boff = lds_byte(wc * 32 + fr, fq * 8);
#define PG8_SA(b, h) (((b) * 2 + (h)) * HTB)
#define PG8_SB(b, h) ((4 + (b) * 2 + (h)) * HTB)
#define PG8_STAGE(bufoff, gbase, voff) do { _Pragma("unroll") for (int _i = 0; _i < 2; ++_i) \
        asm volatile("s_mov_b32 m0, %0\n\ts_nop 0\n\tglobal_load_lds_dwordx4 %1, %2" :: "s"((unsigned)(__builtin_amdgcn_readfirstlane((int)(ldsbase + (unsigned)(bufoff) + ldsw + (unsigned)_i * 8192u)))), "v"((voff)[_i]), "s"((const char*)(gbase)) : "m0", "memory"); } while (0)
#define PG8_LDA(dst, b, h) do { _Pragma("unroll") for (int m = 0; m < 4; ++m) _Pragma("unroll") for (int k = 0; k < 2; ++k) dst[m][k] = *(const LAS bf16x8*)(lds + PG8_SA(b, h) + aoff + m * 2048 + k * 1024); } while (0)
#define PG8_LDB(dst, b, h) do { _Pragma("unroll") for (int n = 0; n < 2; ++n) _Pragma("unroll") for (int k = 0; k < 2; ++k) dst[n][k] = *(const LAS bf16x8*)(lds + PG8_SB(b, h) + boff + n * 2048 + k * 1024); } while (0)
#define PG8_MMA(ai, bj, At, Bt) do { __builtin_amdgcn_s_setprio(1); _Pragma("unroll") for (int m = 0; m < 4; ++m) _Pragma("unroll") for (int n = 0; n < 2; ++n) _Pragma("unroll") for (int k = 0; k < 2; ++k) \
        acc[ai][bj][m][n] = __builtin_amdgcn_mfma_f32_16x16x32_bf16(Bt[n][k], At[m][k], acc[ai][bj][m][n], 0, 0, 0); __builtin_amdgcn_s_setprio(0); } while (0)
#define PG8_WAIT_V(n) asm volatile("s_waitcnt vmcnt(" #n ")" ::: "memory")
#define PG8_WAIT_L(n) asm volatile("s_waitcnt lgkmcnt(" #n ")" ::: "memory")
#define PG8_WAIT_V_RX(rx) do { if constexpr (Epi::NST >= 16) asm volatile("s_cmp_lg_u32 %0, 0\n\ts_cbranch_scc1 .Lrx_skip_%=\n\ts_waitcnt vmcnt(8)\n.Lrx_skip_%=:\n\ts_waitcnt vmcnt(24)" :: "s"(rx) : "memory", "scc"); \
        else asm volatile("s_cmp_lg_u32 %0, 0\n\ts_cbranch_scc1 .Lrx_skip_%=\n\ts_waitcnt vmcnt(8)\n.Lrx_skip_%=:\n\ts_waitcnt vmcnt(16)" :: "s"(rx) : "memory", "scc"); } while (0)
#define PG8_BAR __builtin_amdgcn_s_barrier()
#define PG8_SCHED __builtin_amdgcn_sched_barrier(0)
#define PG8_ABASE(u) ((const char*)g.A + (size_t)((u).z == 0 ? g.zoff0 : (u).z == 1 ? g.zoff1 : g.zoff2) * 2 + (size_t)(u).pm * tstepA)
#define PG8_BBASE(u) ((const char*)g.Bt + (size_t)((u).z * g.zB) * 2 + (size_t)(u).pn * tstepB)
    Unit cur, nxt; int ui = 0;
    if (!S.next(0, cur)) return;
    f32x4 acc[2][2][4][2];
#pragma unroll
    for (int a = 0; a < 2; ++a)
#pragma unroll
        for (int b = 0; b < 2; ++b)
#pragma unroll
            for (int m = 0; m < 4; ++m)
#pragma unroll
                for (int n = 0; n < 2; ++n) acc[a][b][m][n] = (f32x4){0.f, 0.f, 0.f, 0.f};
    bf16x8 At[4][2], B0[2][2], B1[2][2];
    const char* cA = PG8_ABASE(cur); const char* cB = PG8_BBASE(cur);
    PG8_STAGE(PG8_SB(0, 0), cB, voffB); PG8_STAGE(PG8_SB(0, 1), cB + hstepB, voffB); PG8_STAGE(PG8_SA(0, 0), cA, voffA); PG8_STAGE(PG8_SA(0, 1), cA + hstepA, voffA);
    if (wr == 1) PG8_BAR;
    PG8_WAIT_V(2); PG8_BAR;
    PG8_STAGE(PG8_SB(1, 0), cB + kstep, voffB); PG8_STAGE(PG8_SA(1, 0), cA + kstep, voffA); PG8_STAGE(PG8_SB(1, 1), cB + hstepB + kstep, voffB);
    PG8_WAIT_V(6); PG8_BAR;
    for (;;) {
        const bool has_next = S.next(ui + 1, nxt);
        const char* nA = has_next ? PG8_ABASE(nxt) : cA; const char* nB = has_next ? PG8_BBASE(nxt) : cB;
        for (int t = 0; t < nt; t += 2) {
            const bool last = (t == nt - 2);
            const char* a1 = cA + (size_t)(t + 1) * kstep;
            const char* a2 = last ? nA : cA + (size_t)(t + 2) * kstep; const char* b2 = last ? nB : cB + (size_t)(t + 2) * kstep;
            const char* a3 = a2 + kstep; const char* b3 = b2 + kstep;
            const int rx = __builtin_amdgcn_readfirstlane(((t == 0) && (ui > 0)) ? 1 : 0);
            PG8_LDB(B0, 0, 0); PG8_LDB(B1, 0, 1); PG8_SCHED; PG8_LDA(At, 0, 0); PG8_STAGE(PG8_SA(1, 1), a1 + hstepA, voffA);
            PG8_WAIT_V_RX(rx);
            PG8_WAIT_L(0); PG8_BAR; PG8_MMA(0, 0, At, B0); PG8_MMA(0, 1, At, B1); PG8_BAR; PG8_SCHED;
            PG8_LDA(At, 0, 1); PG8_STAGE(PG8_SB(0, 0), b2, voffB); PG8_STAGE(PG8_SB(0, 1), b2 + hstepB, voffB); PG8_STAGE(PG8_SA(0, 0), a2, voffA);
            PG8_WAIT_V_RX(rx);
            PG8_WAIT_L(0); PG8_BAR; PG8_MMA(1, 0, At, B0); PG8_MMA(1, 1, At, B1); PG8_BAR; PG8_SCHED;
            PG8_LDB(B0, 1, 0); PG8_LDB(B1, 1, 1); PG8_SCHED; PG8_LDA(At, 1, 0); PG8_STAGE(PG8_SA(0, 1), a2 + hstepA, voffA);
            PG8_WAIT_V(8); PG8_WAIT_L(0); PG8_BAR; PG8_MMA(0, 0, At, B0); PG8_MMA(0, 1, At, B1); PG8_BAR; PG8_SCHED;
            PG8_LDA(At, 1, 1); PG8_STAGE(PG8_SB(1, 0), b3, voffB); PG8_STAGE(PG8_SB(1, 1), b3 + hstepB, voffB); PG8_STAGE(PG8_SA(1, 0), a3, voffA);
            PG8_WAIT_V(8); PG8_WAIT_L(0); PG8_BAR; PG8_MMA(1, 0, At, B0); PG8_MMA(1, 1, At, B1); PG8_BAR; PG8_SCHED;
        }
        if (wr == 0) PG8_BAR;
        E(acc, cur, wr, wc, fr, fq);
        if (!has_next) break;
#pragma unroll
        for (int a = 0; a < 2; ++a)
#pragma unroll
            for (int b = 0; b < 2; ++b)
#pragma unroll
                for (int m = 0; m < 4; ++m)
#pragma unroll
                    for (int n = 0; n < 2; ++n) acc[a][b][m][n] = zero4();
        cur = nxt; cA = nA; cB = nB; ++ui;
        if (wr == 1) PG8_BAR;
    }
    PG8_WAIT_V(0);
    PG8_BAR;
#undef PG8_SA
#undef PG8_SB
#undef PG8_STAGE
#undef PG8_LDA
#undef PG8_LDB
#undef PG8_MMA
#undef PG8_WAIT_V
#undef PG8_WAIT_L
#undef PG8_WAIT_V_RX
#undef PG8_BAR
#undef PG8_SCHED
#undef PG8_ABASE
#undef PG8_BBASE
}
}

__device__ __forceinline__ void rms_row_bf16(const float* xrow, const float* g, bf16_t* orow, int lane) {
    const f32x4* xr = (const f32x4*)xrow + lane; const f32x4* gr = (const f32x4*)g + lane;
    f32x4 v[4]; float s = 0.f;
#pragma unroll
    for (int j = 0; j < 4; ++j) { v[j] = xr[64 * j]; s += (v[j].x * v[j].x + v[j].y * v[j].y) + (v[j].z * v[j].z + v[j].w * v[j].w); }
    const float rstd = rsqrtf(wave_sum(s) * (1.f / 1024.f) + 1e-6f);
    u32x2* o8 = (u32x2*)orow + lane;
#pragma unroll
    for (int j = 0; j < 4; ++j) { const f32x4 gg = gr[64 * j]; u32x2 w; w.x = cvt_pk_bf16(v[j].x * rstd * gg.x, v[j].y * rstd * gg.y); w.y = cvt_pk_bf16(v[j].z * rstd * gg.z, v[j].w * rstd * gg.w); o8[64 * j] = w; }
}
__device__ __forceinline__ void rms_row_final(const bf16_t* xrow, const float* g, float* orow, int lane) {
    const u32x4 a = *((const u32x4*)xrow + lane), b = *((const u32x4*)xrow + 64 + lane);
    float v[16] = {bflo(a.x), bfhi(a.x), bflo(a.y), bfhi(a.y), bflo(a.z), bfhi(a.z), bflo(a.w), bfhi(a.w), bflo(b.x), bfhi(b.x), bflo(b.y), bfhi(b.y), bflo(b.z), bfhi(b.z), bflo(b.w), bfhi(b.w)};
    float s = 0.f;
#pragma unroll
    for (int j = 0; j < 16; ++j) s += v[j] * v[j];
    const float rstd = rsqrtf(wave_sum(s) * (1.f / 1024.f) + 1e-6f);
#pragma unroll
    for (int hh = 0; hh < 2; ++hh)
#pragma unroll
        for (int q = 0; q < 2; ++q) { const int e = hh * 512 + lane * 8 + q * 4; const f32x4 gg = *(const f32x4*)(g + e);
            *(f32x4*)(orow + e) = (f32x4){v[hh * 8 + q * 4 + 0] * rstd * gg.x, v[hh * 8 + q * 4 + 1] * rstd * gg.y, v[hh * 8 + q * 4 + 2] * rstd * gg.z, v[hh * 8 + q * 4 + 3] * rstd * gg.w}; }
}

__device__ __forceinline__ void wt_item(const float* W, int K, int N, bf16_t* WT, int mode, int item, LAS float* scr, int lane, const float* gain) {
    const int nblk = N >> 6, kb = item / nblk, nb = item - kb * nblk, k0 = kb * 64, n0 = nb * 64;
#pragma unroll 16
    for (int kk = 0; kk < 64; ++kk) scr[kk * 65 + lane] = __builtin_nontemporal_load(W + (size_t)(k0 + kk) * N + n0 + lane);
    asm volatile("s_waitcnt lgkmcnt(0)" ::: "memory");
    const int c = lane & 7;
    f32x4 ga = (f32x4){1.f, 1.f, 1.f, 1.f}, gb = ga;
    if (gain) { ga = *(const f32x4*)(gain + k0 + 8 * c); gb = *(const f32x4*)(gain + k0 + 8 * c + 4); }
#pragma unroll
    for (int j = 0; j < 8; ++j) { const int n = (lane >> 3) + 8 * j, sn = n0 + n; const LAS float* q = scr + (8 * c) * 65 + n;
        const int dr = mode == 0 ? sn : (256 * (sn >> 7) + (sn & 127) + (mode == 2 ? 128 : 0));
        u32x4 o; o.x = cvt_pk_bf16(q[0 * 65] * ga.x, q[1 * 65] * ga.y); o.y = cvt_pk_bf16(q[2 * 65] * ga.z, q[3 * 65] * ga.w); o.z = cvt_pk_bf16(q[4 * 65] * gb.x, q[5 * 65] * gb.y); o.w = cvt_pk_bf16(q[6 * 65] * gb.z, q[7 * 65] * gb.w);
        *(u32x4*)(WT + (size_t)dr * K + k0 + 8 * c) = o; }
    asm volatile("s_waitcnt lgkmcnt(0)" ::: "memory");
}

__device__ __forceinline__ void rot16(const bf16_t* row, const f32x2* tabrow, int jg, float sc, unsigned (&y1)[8], unsigned (&y2)[8]) {
    const u32x4 a0 = *(const u32x4*)(row + jg * 16), a1 = *(const u32x4*)(row + jg * 16 + 8);
    const u32x4 b0 = *(const u32x4*)(row + 64 + jg * 16), b1 = *(const u32x4*)(row + 64 + jg * 16 + 8);
    const unsigned aw[8] = {a0.x, a0.y, a0.z, a0.w, a1.x, a1.y, a1.z, a1.w};
    const unsigned bw[8] = {b0.x, b0.y, b0.z, b0.w, b1.x, b1.y, b1.z, b1.w};
    const f32x4* tp = (const f32x4*)(tabrow + jg * 16);
#pragma unroll
    for (int i = 0; i < 8; ++i) {
        const f32x4 cs = tp[i];
        const float x1a = bflo(aw[i]), x1b = bfhi(aw[i]), x2a = bflo(bw[i]), x2b = bfhi(bw[i]);
        y1[i] = cvt_pk_bf16((x1a * cs.x - x2a * cs.y) * sc, (x1b * cs.z - x2b * cs.w) * sc);
        y2[i] = cvt_pk_bf16((x1a * cs.y + x2a * cs.x) * sc, (x1b * cs.w + x2b * cs.z) * sc);
    }
}

constexpr int RP = 136;

__device__ __forceinline__ void ret_state_item(const bf16_t* proj, const f32x2* tab, bf16_t* states, int item, LAS unsigned char* lds, int tid) {
    const int wave = tid >> 6, lane = tid & 63, fr = lane & 15, fq = lane >> 4;
    const int h = item & 3, n = (item >> 2) & 31, bl = item >> 7;
    const size_t tok0 = (size_t)bl * SEQ + n * 128;
    LAS bf16_t* KT = (LAS bf16_t*)lds;
    LAS bf16_t* VT = (LAS bf16_t*)(lds + 128 * RP * 2);
    const float lg = log2g(h);
    {
        const int c = tid >> 2, jg = tid & 3;
        const bf16_t* row = proj + (tok0 + c) * INW + C_RK + h * 128;
        unsigned y1[8], y2[8];
        rot16(row, tab + (size_t)(n * 128 + c) * 64, jg, 0.08838834764831845f * exp2f(-(float)(c + 1) * lg), y1, y2);
#pragma unroll
        for (int i = 0; i < 8; ++i) {
            const int j = jg * 16 + 2 * i;
            KT[(j) * RP + c] = (bf16_t)(y1[i] & 0xffffu); KT[(j + 1) * RP + c] = (bf16_t)(y1[i] >> 16);
            KT[(j + 64) * RP + c] = (bf16_t)(y2[i] & 0xffffu); KT[(j + 65) * RP + c] = (bf16_t)(y2[i] >> 16);
        }
        const bf16_t* vrow = proj + (tok0 + c) * INW + C_RV + h * 256 + jg * 64;
#pragma unroll
        for (int i = 0; i < 8; ++i) {
            const u32x4 v = *(const u32x4*)(vrow + i * 8);
            const unsigned vw[4] = {v.x, v.y, v.z, v.w};
#pragma unroll
            for (int k = 0; k < 4; ++k) { const int e = jg * 64 + i * 8 + 2 * k; VT[e * RP + c] = (bf16_t)(vw[k] & 0xffffu); VT[(e + 1) * RP + c] = (bf16_t)(vw[k] >> 16); }
        }
    }
    __syncthreads();
    f32x4 acc[8][2];
#pragma unroll
    for (int dt = 0; dt < 8; ++dt) { acc[dt][0] = (f32x4){0.f, 0.f, 0.f, 0.f}; acc[dt][1] = (f32x4){0.f, 0.f, 0.f, 0.f}; }
#pragma unroll
    for (int ks = 0; ks < 4; ++ks) {
        bf16x8 bfr[2];
#pragma unroll
        for (int et = 0; et < 2; ++et) bfr[et] = *(const LAS bf16x8*)(VT + (32 * wave + 16 * et + fr) * RP + 32 * ks + 8 * fq);
#pragma unroll
        for (int dt = 0; dt < 8; ++dt) {
            const bf16x8 a = *(const LAS bf16x8*)(KT + (16 * dt + fr) * RP + 32 * ks + 8 * fq);
            acc[dt][0] = mfma16(a, bfr[0], acc[dt][0]); acc[dt][1] = mfma16(a, bfr[1], acc[dt][1]);
        }
    }
    const float gch = exp2f(128.f * lg);
    bf16_t* sp = states + (size_t)item * 32768;
#pragma unroll
    for (int et = 0; et < 2; ++et)
#pragma unroll
        for (int dt = 0; dt < 8; ++dt) { const f32x4 v = acc[dt][et] * gch; *(u32x2*)(sp + (size_t)(32 * wave + 16 * et + fr) * 128 + 16 * dt + 4 * fq) = (u32x2){cvt_pk_bf16(v[0], v[1]), cvt_pk_bf16(v[2], v[3])}; }
    __syncthreads();
}

__device__ __forceinline__ void ret_scan(bf16_t* states, int gtid, int nthreads, int dry) {
    for (int i = gtid; i < 16 * 8192; i += nthreads) {
        const int bh = i >> 13, off = i & 8191, bl = bh >> 2, h = bh & 3;
        const float g = exp2f(128.f * log2g(h));
        u32x2* p = (u32x2*)(states + ((size_t)(bl * 32) * 4 + h) * 32768) + off;
        f32x4 R = (f32x4){0.f, 0.f, 0.f, 0.f};
        for (int n0 = 0; n0 < 32; n0 += 8) {
            u32x2 sv[8];
#pragma unroll
            for (int k = 0; k < 8; ++k) sv[k] = p[(size_t)(n0 + k) * 32768];
#pragma unroll
            for (int k = 0; k < 8; ++k) { if (!dry) p[(size_t)(n0 + k) * 32768] = (u32x2){cvt_pk_bf16(R[0], R[1]), cvt_pk_bf16(R[2], R[3])};
                R = R * g + (f32x4){bflo(sv[k].x), bfhi(sv[k].x), bflo(sv[k].y), bfhi(sv[k].y)}; }
        }
    }
}

__device__ __forceinline__ void ret_out_item(bf16_t* proj, const f32x2* tab, const bf16_t* states, const float* gn, int item, LAS unsigned char* lds, int tid, int dry) {
    const int wave = tid >> 6, lane = tid & 63, fr = lane & 15, fq = lane >> 4;
    const int h = item & 3, n = (item >> 2) & 31, bl = item >> 7;
    const size_t tok0 = (size_t)bl * SEQ + n * 128;
    LAS bf16_t* QS = (LAS bf16_t*)lds;
    LAS bf16_t* KS = (LAS bf16_t*)(lds + 128 * RP * 2);
    LAS bf16_t* VT = (LAS bf16_t*)(lds + 2 * 128 * RP * 2);
    LAS float* red = (LAS float*)(lds + 4 * 128 * RP * 2);
    const float lg = log2g(h);
    {
        const int c = tid >> 2, jg = tid & 3;
        const f32x2* tr = tab + (size_t)(n * 128 + c) * 64;
        unsigned y1[8], y2[8];
        rot16(proj + (tok0 + c) * INW + C_RQ + h * 128, tr, jg, exp2f((float)(c + 1) * lg), y1, y2);
        *(LAS u32x4*)(QS + c * RP + jg * 16) = (u32x4){y1[0], y1[1], y1[2], y1[3]}; *(LAS u32x4*)(QS + c * RP + jg * 16 + 8) = (u32x4){y1[4], y1[5], y1[6], y1[7]};
        *(LAS u32x4*)(QS + c * RP + 64 + jg * 16) = (u32x4){y2[0], y2[1], y2[2], y2[3]}; *(LAS u32x4*)(QS + c * RP + 64 + jg * 16 + 8) = (u32x4){y2[4], y2[5], y2[6], y2[7]};
        rot16(proj + (tok0 + c) * INW + C_RK + h * 128, tr, jg, 0.08838834764831845f * exp2f(-(float)(c + 1) * lg), y1, y2);
        *(LAS u32x4*)(KS + c * RP + jg * 16) = (u32x4){y1[0], y1[1], y1[2], y1[3]}; *(LAS u32x4*)(KS + c * RP + jg * 16 + 8) = (u32x4){y1[4], y1[5], y1[6], y1[7]};
        *(LAS u32x4*)(KS + c * RP + 64 + jg * 16) = (u32x4){y2[0], y2[1], y2[2], y2[3]}; *(LAS u32x4*)(KS + c * RP + 64 + jg * 16 + 8) = (u32x4){y2[4], y2[5], y2[6], y2[7]};
        const bf16_t* vrow = proj + (tok0 + c) * INW + C_RV + h * 256 + jg * 64;
#pragma unroll
        for (int i = 0; i < 8; ++i) {
            const u32x4 v = *(const u32x4*)(vrow + i * 8);
            const unsigned vw[4] = {v.x, v.y, v.z, v.w};
#pragma unroll
            for (int k = 0; k < 4; ++k) { const int e = jg * 64 + i * 8 + 2 * k; VT[e * RP + c] = (bf16_t)(vw[k] & 0xffffu); VT[(e + 1) * RP + c] = (bf16_t)(vw[k] >> 16); }
        }
    }
    __syncthreads();
    unsigned pk[8][2];
    {
        f32x4 pacc[8];
#pragma unroll
        for (int st = 0; st < 8; ++st) pacc[st] = (f32x4){0.f, 0.f, 0.f, 0.f};
#pragma unroll
        for (int ks = 0; ks < 4; ++ks) {
            const bf16x8 b = *(const LAS bf16x8*)(QS + (16 * wave + fr) * RP + 32 * ks + 8 * fq);
#pragma unroll
            for (int st = 0; st < 8; ++st) { const bf16x8 a = *(const LAS bf16x8*)(KS + (16 * st + fr) * RP + 32 * ks + 8 * fq); pacc[st] = mfma16(a, b, pacc[st]); }
        }
        const int c = 16 * wave + fr;
#pragma unroll
        for (int st = 0; st < 8; ++st) { float v[4];
#pragma unroll
            for (int j = 0; j < 4; ++j) { const int s = 16 * st + 4 * fq + j; v[j] = (s <= c) ? pacc[st][j] : 0.f; }
            pk[st][0] = cvt_pk_bf16(v[0], v[1]); pk[st][1] = cvt_pk_bf16(v[2], v[3]); }
    }
    __syncthreads();
    {
        const int c = 16 * wave + fr;
#pragma unroll
        for (int st = 0; st < 8; ++st) *(LAS u32x2*)(KS + c * RP + 16 * st + 4 * fq) = (u32x2){pk[st][0], pk[st][1]};
    }
    __syncthreads();
    f32x4 acc[2][8];
#pragma unroll
    for (int et = 0; et < 2; ++et)
#pragma unroll
        for (int ct = 0; ct < 8; ++ct) acc[et][ct] = (f32x4){0.f, 0.f, 0.f, 0.f};
    const bf16_t* sp = states + (size_t)item * 32768;
#pragma unroll
    for (int ks = 0; ks < 4; ++ks) {
        bf16x8 av[2], ar[2];
#pragma unroll
        for (int et = 0; et < 2; ++et) {
            const int e = 32 * wave + 16 * et + fr;
            av[et] = *(const LAS bf16x8*)(VT + e * RP + 32 * ks + 8 * fq);
            ar[et] = *(const bf16x8*)(sp + (size_t)e * 128 + 32 * ks + 8 * fq);
        }
#pragma unroll
        for (int ct = 0; ct < 8; ++ct) {
            const bf16x8 bp = *(const LAS bf16x8*)(KS + (16 * ct + fr) * RP + 32 * ks + 8 * fq);
            const bf16x8 bq = *(const LAS bf16x8*)(QS + (16 * ct + fr) * RP + 32 * ks + 8 * fq);
#pragma unroll
            for (int et = 0; et < 2; ++et) { acc[et][ct] = mfma16(av[et], bp, acc[et][ct]); acc[et][ct] = mfma16(ar[et], bq, acc[et][ct]); }
        }
    }
#pragma unroll
    for (int ct = 0; ct < 8; ++ct) {
        float s = 0.f;
#pragma unroll
        for (int et = 0; et < 2; ++et) s += (acc[et][ct][0] * acc[et][ct][0] + acc[et][ct][1] * acc[et][ct][1]) + (acc[et][ct][2] * acc[et][ct][2] + acc[et][ct][3] * acc[et][ct][3]);
        s += __shfl_xor(s, 16); s += __shfl_xor(s, 32);
        if (fq == 0) red[wave * 128 + 16 * ct + fr] = s;
    }
    __syncthreads();
#pragma unroll
    for (int ct = 0; ct < 8; ++ct) {
        const int c = 16 * ct + fr;
        float s = 0.f;
#pragma unroll
        for (int w = 0; w < 8; ++w) s += red[w * 128 + c];
        const float rstd = rsqrtf(s * (1.f / 256.f) + 1e-6f);
        bf16_t* grow = proj + (tok0 + c) * INW + C_RG + h * 256;
#pragma unroll
        for (int et = 0; et < 2; ++et) {
            const int e = 32 * wave + 16 * et + 4 * fq;
            const u32x2 gw = *(const u32x2*)(grow + e);
            const f32x4 gg = *(const f32x4*)(gn + h * 256 + e);
            const float g0 = bflo(gw.x), g1 = bfhi(gw.x), g2 = bflo(gw.y), g3 = bfhi(gw.y);
            const float o0 = acc[et][ct][0] * rstd * gg.x * g0 * sigmoidf_(g0), o1 = acc[et][ct][1] * rstd * gg.y * g1 * sigmoidf_(g1);
            const float o2 = acc[et][ct][2] * rstd * gg.z * g2 * sigmoidf_(g2), o3 = acc[et][ct][3] * rstd * gg.w * g3 * sigmoidf_(g3);
            if (!dry) *(u32x2*)(grow + e) = (u32x2){cvt_pk_bf16(o0, o1), cvt_pk_bf16(o2, o3)};
        }
    }
    __syncthreads();
}

__device__ __forceinline__ int rowperm(int d) { return (d & ~31) | (((d >> 2) & 1) << 4) | (((d >> 3) & 3) << 2) | (d & 3); }
constexpr int SKP = 72, SVP = 264;
__device__ __forceinline__ void swa_item(bf16_t* proj, const float* sinks, int item, LAS unsigned char* lds, int tid, int dry) {
    const int wave = tid >> 6, lane = tid & 63, fr = lane & 15, fq = lane >> 4;
    const int kh = item & 1, n = (item >> 1) & 31, bl = item >> 6;
    const size_t tok0 = (size_t)bl * SEQ + n * 128;
    LAS bf16_t* Ks = (LAS bf16_t*)lds;
    LAS bf16_t* Vt = (LAS bf16_t*)(lds + 256 * SKP * 2);
#pragma unroll
    for (int i = 0; i < 4; ++i) {
        const int ch = tid + 512 * i, key = ch >> 3, part = ch & 7;
        u32x4 kv = (u32x4){0u, 0u, 0u, 0u}, vv = (u32x4){0u, 0u, 0u, 0u};
        if (n > 0 || key >= 128) { const bf16_t* r = proj + (tok0 + key - 128) * INW; kv = *(const u32x4*)(r + C_SK + kh * 64 + part * 8); vv = *(const u32x4*)(r + C_SV + kh * 64 + part * 8); }
        *(LAS u32x4*)(Ks + key * SKP + part * 8) = kv;
        const unsigned vw[4] = {vv.x, vv.y, vv.z, vv.w};
#pragma unroll
        for (int k = 0; k < 4; ++k) { const int d = part * 8 + 2 * k; Vt[rowperm(d) * SVP + key] = (bf16_t)(vw[k] & 0xffffu); Vt[rowperm(d + 1) * SVP + key] = (bf16_t)(vw[k] >> 16); }
    }
    __syncthreads();
    const int h = kh * 8 + wave; const float sink = sinks[h];
    for (int qt = 0; qt < 8; ++qt) {
        bf16_t* qrow = proj + (tok0 + 16 * qt + fr) * INW + C_SQ + h * 64;
        bf16x8 qf[2];
        qf[0] = *(const bf16x8*)(qrow + 8 * fq); qf[1] = *(const bf16x8*)(qrow + 32 + 8 * fq);
        f32x4 s[10];
#pragma unroll
        for (int r = 0; r < 9; ++r) { s[r] = (f32x4){0.f, 0.f, 0.f, 0.f};
#pragma unroll
            for (int ks = 0; ks < 2; ++ks) { const bf16x8 a = *(const LAS bf16x8*)(Ks + (16 * (qt + r) + fr) * SKP + 32 * ks + 8 * fq); s[r] = mfma16(a, qf[ks], s[r]); } }
        s[9] = (f32x4){0.f, 0.f, 0.f, 0.f};
        const int c = 16 * qt + fr; float mxr = -1e30f;
#pragma unroll
        for (int r = 0; r < 9; ++r) {
            const bool tile_ok = (n > 0) || (qt + r >= 8);
            if (r == 0 || r == 8 || !tile_ok) {
#pragma unroll
                for (int j = 0; j < 4; ++j) { const int kpos = 16 * (qt + r) + 4 * fq + j;
                    bool valid = tile_ok;
                    if (r == 0) valid = valid && (kpos > c);
                    if (r == 8) valid = valid && (kpos <= c + 128);
                    s[r][j] = valid ? s[r][j] : -1e30f; }
            }
            mxr = fmaxf(mxr, fmaxf(fmaxf(s[r][0], s[r][1]), fmaxf(s[r][2], s[r][3])));
        }
        mxr = fmaxf(mxr, __shfl_xor(mxr, 16)); mxr = fmaxf(mxr, __shfl_xor(mxr, 32));
        const float mx = fmaxf(mxr * 0.125f, sink);
        const float c1 = 0.125f * 1.4426950408889634f, mo = -mx * 1.4426950408889634f;
        float sum = 0.f;
#pragma unroll
        for (int r = 0; r < 9; ++r)
#pragma unroll
            for (int j = 0; j < 4; ++j) { const float pv = __builtin_amdgcn_exp2f(fmaf(s[r][j], c1, mo)); s[r][j] = pv; sum += pv; }
        sum += __shfl_xor(sum, 16); sum += __shfl_xor(sum, 32);
        sum += __expf(sink - mx);
        const float inv = __builtin_amdgcn_rcpf(sum);
        f32x4 o[4];
#pragma unroll
        for (int dt = 0; dt < 4; ++dt) o[dt] = (f32x4){0.f, 0.f, 0.f, 0.f};
#pragma unroll
        for (int k2 = 0; k2 < 5; ++k2) {
            u32x4 pw; pw.x = cvt_pk_bf16(s[2 * k2][0], s[2 * k2][1]); pw.y = cvt_pk_bf16(s[2 * k2][2], s[2 * k2][3]); pw.z = cvt_pk_bf16(s[2 * k2 + 1][0], s[2 * k2 + 1][1]); pw.w = cvt_pk_bf16(s[2 * k2 + 1][2], s[2 * k2 + 1][3]);
            const bf16x8 pf = __builtin_bit_cast(bf16x8, pw);
            const int kb = 16 * (qt + 2 * k2);
#pragma unroll
            for (int dt = 0; dt < 4; ++dt) {
                const u32x2 v0 = *(const LAS u32x2*)(Vt + (16 * dt + fr) * SVP + kb + 4 * fq), v1 = *(const LAS u32x2*)(Vt + (16 * dt + fr) * SVP + kb + (k2 == 4 ? 0 : 16) + 4 * fq);
                const bf16x8 a = __builtin_bit_cast(bf16x8, ((u32x4){v0.x, v0.y, v1.x, v1.y}));
                o[dt] = mfma16(a, pf, o[dt]);
            }
        }
#pragma unroll
        for (int pp = 0; pp < 2; ++pp) if (!dry) *(u32x4*)(qrow + 32 * pp + 8 * fq) = (u32x4){cvt_pk_bf16(o[2 * pp][0] * inv, o[2 * pp][1] * inv), cvt_pk_bf16(o[2 * pp][2] * inv, o[2 * pp][3] * inv), cvt_pk_bf16(o[2 * pp + 1][0] * inv, o[2 * pp + 1][1] * inv), cvt_pk_bf16(o[2 * pp + 1][2] * inv, o[2 * pp + 1][3] * inv)};
    }
    __syncthreads();
}

constexpr int MP = 264;
__device__ __forceinline__ void mem_item(bf16_t* proj, const bf16_t* mk, const bf16_t* mvT, int bglob0, int item, LAS unsigned char* lds, int tid, int dry) {
    const int wave = tid >> 6, lane = tid & 63, fr = lane & 15, fq = lane >> 4;
    const int qt = item & 15, h = (item >> 4) & 3, bl = item >> 6, b = bglob0 + bl;
    const size_t tok0 = (size_t)bl * SEQ + qt * 256;
    LAS bf16_t* Ms = (LAS bf16_t*)lds;
    {
        const bf16_t* src = mk + (size_t)b * 256 * 1024 + h * 256;
#pragma unroll 1
        for (int i0 = 0; i0 < 16; i0 += 8) {
            u32x4 st[8];
#pragma unroll
            for (int i = 0; i < 8; ++i) { const int ch = tid + 512 * (i0 + i), row = ch >> 5, part = ch & 31; st[i] = *(const u32x4*)(src + (size_t)row * 1024 + part * 8); }
#pragma unroll
            for (int i = 0; i < 8; ++i) { const int ch = tid + 512 * (i0 + i), row = ch >> 5, part = ch & 31; *(LAS u32x4*)(Ms + row * MP + part * 8) = st[i]; }
        }
    }
    bf16_t* qrow0 = proj + (tok0 + 16 * wave + fr) * INW + C_MQ + h * 256;
    const bf16_t* mvsrc = mvT + ((size_t)b * 1024 + h * 256) * 256;
    __syncthreads();
    bf16x8 pf[2][8]; float inv[2];
#pragma unroll
    for (int sub = 0; sub < 2; ++sub) {
        const bf16_t* qrow = qrow0 + (size_t)sub * 128 * INW;
        bf16x8 qf[8];
#pragma unroll
        for (int ks = 0; ks < 8; ++ks) qf[ks] = *(const bf16x8*)(qrow + 32 * ks + 8 * fq);
        f32x4 s[16];
#pragma unroll
        for (int t = 0; t < 16; ++t) { s[t] = (f32x4){0.f, 0.f, 0.f, 0.f};
#pragma unroll
            for (int ks = 0; ks < 8; ++ks) { const bf16x8 a = *(const LAS bf16x8*)(Ms + (16 * t + fr) * MP + 32 * ks + 8 * fq); s[t] = mfma16(a, qf[ks], s[t]); } }
        float mxr = -1e30f;
#pragma unroll
        for (int t = 0; t < 16; ++t) mxr = fmaxf(mxr, fmaxf(fmaxf(s[t][0], s[t][1]), fmaxf(s[t][2], s[t][3])));
        mxr = fmaxf(mxr, __shfl_xor(mxr, 16)); mxr = fmaxf(mxr, __shfl_xor(mxr, 32));
        const float c1 = 0.0625f * 1.4426950408889634f, mo = -mxr * c1;
        float sum = 0.f;
#pragma unroll
        for (int t = 0; t < 16; ++t)
#pragma unroll
            for (int j = 0; j < 4; ++j) { const float pv = __builtin_amdgcn_exp2f(fmaf(s[t][j], c1, mo)); s[t][j] = pv; sum += pv; }
        sum += __shfl_xor(sum, 16); sum += __shfl_xor(sum, 32);
        inv[sub] = __builtin_amdgcn_rcpf(sum);
#pragma unroll
        for (int k2 = 0; k2 < 8; ++k2) { u32x4 pw; pw.x = cvt_pk_bf16(s[2 * k2][0], s[2 * k2][1]); pw.y = cvt_pk_bf16(s[2 * k2][2], s[2 * k2][3]); pw.z = cvt_pk_bf16(s[2 * k2 + 1][0], s[2 * k2 + 1][1]); pw.w = cvt_pk_bf16(s[2 * k2 + 1][2], s[2 * k2 + 1][3]);
            pf[sub][k2] = __builtin_bit_cast(bf16x8, pw); }
    }
    __syncthreads();
    {
#pragma unroll 1
        for (int i0 = 0; i0 < 16; i0 += 8) {
            u32x4 st[8];
#pragma unroll
            for (int i = 0; i < 8; ++i) { const int ch = tid + 512 * (i0 + i), row = ch >> 5, part = ch & 31; st[i] = *(const u32x4*)(mvsrc + (size_t)row * 256 + part * 8); }
#pragma unroll
            for (int i = 0; i < 8; ++i) { const int ch = tid + 512 * (i0 + i), row = ch >> 5, part = ch & 31; *(LAS u32x4*)(Ms + rowperm(row) * MP + part * 8) = st[i]; }
        }
    }
    __syncthreads();
#pragma unroll
    for (int dp = 0; dp < 8; ++dp) {
        f32x4 oa0 = (f32x4){0.f, 0.f, 0.f, 0.f}, oa1 = oa0, ob0 = oa0, ob1 = oa0;
#pragma unroll
        for (int k2 = 0; k2 < 8; ++k2) {
            const u32x2 v0 = *(const LAS u32x2*)(Ms + (32 * dp + fr) * MP + 32 * k2 + 4 * fq), v1 = *(const LAS u32x2*)(Ms + (32 * dp + fr) * MP + 32 * k2 + 16 + 4 * fq);
            const u32x2 w0 = *(const LAS u32x2*)(Ms + (32 * dp + 16 + fr) * MP + 32 * k2 + 4 * fq), w1 = *(const LAS u32x2*)(Ms + (32 * dp + 16 + fr) * MP + 32 * k2 + 16 + 4 * fq);
            const bf16x8 a = __builtin_bit_cast(bf16x8, ((u32x4){v0.x, v0.y, v1.x, v1.y})), bb = __builtin_bit_cast(bf16x8, ((u32x4){w0.x, w0.y, w1.x, w1.y}));
            oa0 = mfma16(a, pf[0][k2], oa0); oa1 = mfma16(a, pf[1][k2], oa1); ob0 = mfma16(bb, pf[0][k2], ob0); ob1 = mfma16(bb, pf[1][k2], ob1);
        }
        if (!dry) {
            *(u32x4*)(qrow0 + 32 * dp + 8 * fq) = (u32x4){cvt_pk_bf16(oa0[0] * inv[0], oa0[1] * inv[0]), cvt_pk_bf16(oa0[2] * inv[0], oa0[3] * inv[0]), cvt_pk_bf16(ob0[0] * inv[0], ob0[1] * inv[0]), cvt_pk_bf16(ob0[2] * inv[0], ob0[3] * inv[0])};
            *(u32x4*)(qrow0 + (size_t)128 * INW + 32 * dp + 8 * fq) = (u32x4){cvt_pk_bf16(oa1[0] * inv[1], oa1[1] * inv[1]), cvt_pk_bf16(oa1[2] * inv[1], oa1[3] * inv[1]), cvt_pk_bf16(ob1[0] * inv[1], ob1[1] * inv[1]), cvt_pk_bf16(ob1[2] * inv[1], ob1[3] * inv[1])};
        }
    }
    __syncthreads();
}

#define XB_TMO      128
#define XB_XCNT(j)  (256  + 64 * (j))
#define XB_XSUB(j)  (1280 + 64 * (j))
#define XB_XGEN(j)  (2304 + 64 * (j))
#define XB_TOP      3328
#define XB_TOPGEN   3392
#define XCD_BAR_WORDS 3456
#define XB_SPIN_CAP (1u << 18)
__device__ __forceinline__ unsigned xb_ld(unsigned* p)              { return __hip_atomic_load(p, __ATOMIC_RELAXED, __HIP_MEMORY_SCOPE_AGENT); }
__device__ __forceinline__ unsigned xb_add(unsigned* p, unsigned v) { return __hip_atomic_fetch_add(p, v, __ATOMIC_RELAXED, __HIP_MEMORY_SCOPE_AGENT); }
__device__ __forceinline__ unsigned xb_xcc_id() { return (unsigned)__builtin_amdgcn_s_getreg((3 << 11) | 20) & 0xFu; }
#define XB_SPIN(cond, bar) do { unsigned _sp = 0; while (cond) { __builtin_amdgcn_s_sleep(1); \
    if ((++_sp & 255u) == 0u) { if (xb_ld(&(bar)[XB_TMO])) break; if (_sp > XB_SPIN_CAP) { atomicAdd(&(bar)[XB_TMO], 1u); break; } } } } while (0)
struct XcdBarrier { unsigned* bar; unsigned x; volatile LAS unsigned* st; };
__device__ __forceinline__ XcdBarrier xcd_barrier_post(unsigned* bar, volatile LAS unsigned* st) {
    XcdBarrier b; b.bar = bar; b.x = xb_xcc_id(); b.st = st;
    if (threadIdx.x == 0) (void)xb_add(&bar[XB_XCNT(b.x)], 1u);
    return b;
}
__device__ __forceinline__ void xcd_barrier_complete(unsigned* bar, unsigned x, unsigned& nloc, unsigned& nx) {
    const unsigned G = gridDim.x * gridDim.y * gridDim.z;
    unsigned sum, cnt, mine, sp = 0u;
    for (;;) {
        sum = 0u; cnt = 0u; mine = 0u;
#pragma unroll
        for (unsigned j = 0; j < 16; ++j) { const unsigned c = xb_ld(&bar[XB_XCNT(j)]); sum += c; cnt += (c > 0u) ? 1u : 0u; mine = (j == x) ? c : mine; }
        if (sum == G) break;
        __builtin_amdgcn_s_sleep(1);
        if ((++sp & 255u) == 0u) { if (xb_ld(&bar[XB_TMO])) break; if (sp > XB_SPIN_CAP) { atomicAdd(&bar[XB_TMO], 1u); break; } }
    }
    nloc = mine > 0u ? mine : 1u; nx = cnt > 0u ? cnt : 1u;
}
__device__ __forceinline__ void xcd_barrier(const XcdBarrier& b) {
    asm volatile("s_waitcnt vmcnt(0)" ::: "memory");
    __syncthreads();
    if (threadIdx.x == 0) {
        unsigned* bar = b.bar;
        __builtin_amdgcn_s_waitcnt(0);
        unsigned nloc = b.st[0], nx = b.st[1];
        if (nloc == 0u) { xcd_barrier_complete(bar, b.x, nloc, nx); b.st[0] = nloc; b.st[1] = nx; }
        const unsigned old = xb_add(&bar[XB_XSUB(b.x)], 1u);
        const unsigned gen = old / nloc;
        if (old + 1u == (gen + 1u) * nloc) {
            __builtin_amdgcn_fence(__ATOMIC_RELEASE, "agent");
            asm volatile("s_waitcnt vmcnt(0)" ::: "memory");
            const unsigned og = xb_add(&bar[XB_TOP], 1u);
            const unsigned tg = og / nx;
            if (og + 1u == (tg + 1u) * nx) xb_add(&bar[XB_TOPGEN], 1u);
            else XB_SPIN(xb_ld(&bar[XB_TOPGEN]) == tg, bar);
            __builtin_amdgcn_fence(__ATOMIC_ACQUIRE, "agent");
            xb_add(&bar[XB_XGEN(b.x)], 1u);
            asm volatile("s_waitcnt vmcnt(0)" ::: "memory");
        } else {
            XB_SPIN(xb_ld(&bar[XB_XGEN(b.x)]) == gen, bar);
            __builtin_amdgcn_fence(__ATOMIC_ACQUIRE, "agent");
            asm volatile("s_waitcnt vmcnt(0)" ::: "memory");
        }
    }
    __syncthreads();
}

__device__ __forceinline__ void run_phase(const Params& p, int ph, LAS unsigned char* lds, int dry) {
    int tid = threadIdx.x; asm volatile("" : "+v"(tid));
    const int lane = tid & 63, wave = tid >> 6;
    int G = gridDim.x, cu = blockIdx.x; asm volatile("" : "+s"(G), "+s"(cu));
    const int gw = cu * 8 + wave, ngw = G * 8;
    unsigned char* ws = p.ws; asm volatile("" : "+s"(ws));
    bf16_t* XB = (bf16_t*)p.out; asm volatile("" : "+s"(XB));
    const float* xin = p.in[0]; asm volatile("" : "+s"(xin));
    bf16_t* Hb = (bf16_t*)(ws + WS_H);
    if ((PHMASK & 1) && ph == NPH - 1) {
        for (int r = gw; r < T_ALL; r += ngw) rms_row_final(Hb + (size_t)r * DM, p.in[20], p.out + (size_t)r * DM, lane);
        return;
    }
    const int l = ph / NPL, k = ph - l * NPL;
    float* ssq1 = (float*)(ws + WS_SSQ); float* ssq2 = ssq1 + 4 * T_ALL; float* ssq3 = ssq2 + 4 * T_ALL;
    if (k == 0) {
        const size_t oFF = (size_t)l * DM * FF, oDD = (size_t)l * DM * DM;
        constexpr int I_F = 16 * 44, I_IN = 16 * 132, I_MKV = 16 * 32, I_DD = 16 * 16;
        constexpr int NIT = 6 * I_F + I_IN + I_MKV + 4 * I_DD;
        LAS float* scr = (LAS float*)(lds + wave * 16640);
        const float* g1 = p.in[2] + l * DM; const float* gm = p.in[6] + l * DM; const float* g2 = p.in[16] + l * DM; const float* gnone = nullptr;
        for (int it = gw; it < NIT; it += ngw) {
            int r = it;
            if (r < I_F) { wt_item(p.in[3] + oFF, DM, FF, (bf16_t*)(ws + WS_W13A), 1, r, scr, lane, g1); continue; } r -= I_F;
            if (r < I_F) { wt_item(p.in[4] + oFF, DM, FF, (bf16_t*)(ws + WS_W13A), 2, r, scr, lane, g1); continue; } r -= I_F;
            if (r < I_F) { wt_item(p.in[5] + oFF, FF, DM, (bf16_t*)(ws + WS_W2A), 0, r, scr, lane, gnone); continue; } r -= I_F;
            if (r < I_F) { wt_item(p.in[17] + oFF, DM, FF, (bf16_t*)(ws + WS_W13B), 1, r, scr, lane, g2); continue; } r -= I_F;
            if (r < I_F) { wt_item(p.in[18] + oFF, DM, FF, (bf16_t*)(ws + WS_W13B), 2, r, scr, lane, g2); continue; } r -= I_F;
            if (r < I_F) { wt_item(p.in[19] + oFF, FF, DM, (bf16_t*)(ws + WS_W2B), 0, r, scr, lane, gnone); continue; } r -= I_F;
            if (r < I_IN) { wt_item(p.in[7] + (size_t)l * DM * INW, DM, INW, (bf16_t*)(ws + WS_WIN), 0, r, scr, lane, gm); continue; } r -= I_IN;
            if (r < I_MKV) { wt_item(p.in[11] + (size_t)l * DM * 2048, DM, 2048, (bf16_t*)(ws + WS_WMKV), 0, r, scr, lane, gnone); continue; } r -= I_MKV;
            if (r < I_DD) { wt_item(p.in[12] + oDD, DM, DM, (bf16_t*)(ws + WS_WUP), 0, r, scr, lane, gnone); continue; } r -= I_DD;
            if (r < I_DD) { wt_item(p.in[13] + oDD, DM, DM, (bf16_t*)(ws + WS_WUP) + (size_t)DM * DM, 0, r, scr, lane, gnone); continue; } r -= I_DD;
            if (r < I_DD) { wt_item(p.in[14] + oDD, DM, DM, (bf16_t*)(ws + WS_WUP) + (size_t)2 * DM * DM, 0, r, scr, lane, gnone); continue; } r -= I_DD;
            wt_item(p.in[15] + oDD, DM, DM, (bf16_t*)(ws + WS_WO), 0, r, scr, lane, gnone);
        }
        for (int r = gw; r < 2048; r += ngw) rms_row_bf16(p.in[1] + (size_t)r * DM, p.in[10] + l * DM, (bf16_t*)(ws + WS_MEMH) + (size_t)r * DM, lane);
        if (l == 0) {
            for (int r = gw; r < T_ALL; r += ngw) {
                const f32x4* xr = (const f32x4*)(xin + (size_t)r * DM) + lane; u32x2* o8 = (u32x2*)(XB + (size_t)r * DM) + lane; float sacc = 0.f;
#pragma unroll
                for (int j = 0; j < 4; ++j) { const f32x4 v = __builtin_nontemporal_load(xr + 64 * j); sacc += (v.x * v.x + v.y * v.y) + (v.z * v.z + v.w * v.w); o8[64 * j] = (u32x2){cvt_pk_bf16(v.x, v.y), cvt_pk_bf16(v.z, v.w)}; }
                sacc = wave_sum(sacc); if (lane == 0) *(f32x4*)(ssq1 + (size_t)r * 4) = (f32x4){sacc, 0.f, 0.f, 0.f};
            }
            f32x2* tab = (f32x2*)(ws + WS_TAB);
            for (int i = cu * 512 + tid; i < SEQ * 64; i += G * 512) {
                const int pos = i >> 6, j = i & 63;
                const float inv = exp2f(-(float)j * (13.287712379549449f / 64.f));
                const float ang = (float)pos * inv;
                double rr = (double)ang * 0.15915494309189535; rr -= rint(rr);
                const float rf = (float)rr;
                tab[i] = (f32x2){__builtin_amdgcn_cosf(rf), __builtin_amdgcn_sinf(rf)};
            }
        }
        return;
    }
    if (k == 1 || k == 14) {
        pg8::Gemm g; g.A = XB; g.Bt = (const bf16_t*)(ws + (k == 1 ? WS_W13A : WS_W13B)); g.M = T_ALL; g.N = 2 * FF; g.K = DM; g.lda = DM; g.zoff0 = g.zoff1 = g.zoff2 = 0; g.zB = 0;
        pg8::Order S; S.init(g.M, g.N, G, cu, 1);
        LAS float* rtab = (LAS float*)(lds + pg8::STAGE_BYTES);
        { const float* sq = (k == 1) ? ssq1 : ssq3; pg8::Unit uu;
          for (int i = 0; i < 12 && S.next(i, uu); ++i) if (tid < 256) { const f32x4 q = *(const f32x4*)(sq + (size_t)(uu.pm * 256 + tid) * 4); rtab[i * 256 + tid] = rsqrtf(((q.x + q.y) + (q.z + q.w)) * (1.f / 1024.f) + 1e-6f); } }
        __syncthreads();
        pg8::EpiSwiglu E; E.U = (bf16_t*)(ws + WS_U); E.ldu = FF; E.rtab = rtab;
        pg8::gemm_phase(lds, g, S, E, tid);
        return;
    }
    if (k == 2 || k == 15 || k == 13) {
        pg8::Gemm g; pg8::EpiResid E; E.red = (LAS float*)(lds + pg8::STAGE_BYTES); g.zoff0 = g.zoff1 = g.zoff2 = 0; g.zB = 0; g.N = DM; g.M = T_ALL; E.ld = DM; E.src = XB; E.dst = XB;
        if (k == 2 || k == 15) {
            g.A = (const bf16_t*)(ws + WS_U); g.Bt = (const bf16_t*)(ws + (k == 2 ? WS_W2A : WS_W2B)); g.K = FF; g.lda = FF;
            E.scale = dry ? 0.f : 0.5f; E.ssq = (k == 2) ? ssq2 : ssq1;
            if (k == 15 && l == 1) E.dst = Hb;
        } else {
            g.A = Hb; g.Bt = (const bf16_t*)(ws + WS_WO); g.K = DM; g.lda = DM;
            E.scale = dry ? 0.f : 1.0f; E.ssq = ssq3;
        }
        pg8::Order S; S.init(g.M, g.N, G, cu, 1, 1);
        pg8::gemm_phase(lds, g, S, E, tid);
        return;
    }
    const int half = (k - 3) / 5, s = (k - 3) - 5 * half;
    bf16_t* proj = (bf16_t*)(ws + WS_PROJ);
    bf16_t* states = (bf16_t*)(ws + WS_ST);
    const f32x2* tab = (const f32x2*)(ws + WS_TAB);
    if (s == 0) {
        LAS float* rtab = (LAS float*)(lds + pg8::STAGE_BYTES);
        {
            pg8::Gemm g; g.A = XB + (size_t)half * T_HALF * DM; g.Bt = (const bf16_t*)(ws + WS_WIN); g.M = T_HALF; g.N = 8192; g.K = DM; g.lda = DM; g.zoff0 = g.zoff1 = g.zoff2 = 0; g.zB = 0;
            pg8::Order S; S.init(g.M, g.N, G, cu, 1, 2);
            { const float* sq = ssq2 + (size_t)half * T_HALF * 4; pg8::Unit uu;
              for (int i = 0; i < 12 && S.next(i, uu); ++i) if (tid < 256) { const f32x4 q = *(const f32x4*)(sq + (size_t)(uu.pm * 256 + tid) * 4); rtab[i * 256 + tid] = rsqrtf(((q.x + q.y) + (q.z + q.w)) * (1.f / 1024.f) + 1e-6f); } }
            __syncthreads();
            pg8::EpiStore E; E.O = proj; E.ldc = INW; E.rtab = rtab;
            pg8::gemm_phase(lds, g, S, E, tid);
        }
        if (half == 0) {
            {
                pg8::Gemm g; g.A = XB; g.Bt = (const bf16_t*)(ws + WS_WIN) + (size_t)8192 * DM; g.M = T_ALL; g.N = 256; g.K = DM; g.lda = DM; g.zoff0 = g.zoff1 = g.zoff2 = 0; g.zB = 0;
                pg8::Order S; S.init(g.M, g.N, G, cu < 128 ? cu : G, 1);
                { pg8::Unit uu;
                  for (int i = 0; i < 12 && S.next(i, uu); ++i) if (tid < 256) { const f32x4 q = *(const f32x4*)(ssq2 + (size_t)(uu.pm * 256 + tid) * 4); rtab[i * 256 + tid] = rsqrtf(((q.x + q.y) + (q.z + q.w)) * (1.f / 1024.f) + 1e-6f); } }
                __syncthreads();
                pg8::EpiStore E; E.O = (bf16_t*)(ws + WS_GL2); E.ldc = 256; E.rtab = rtab;
                pg8::gemm_phase(lds, g, S, E, tid);
            }
            {
                pg8::Gemm g2; g2.A = (const bf16_t*)(ws + WS_MEMH); g2.Bt = (const bf16_t*)(ws + WS_WMKV); g2.M = 2048; g2.N = 2048; g2.K = DM; g2.lda = DM; g2.zoff0 = g2.zoff1 = g2.zoff2 = 0; g2.zB = 0;
                pg8::Order S2; S2.init(2048, 2048, G, (cu >= 128 && cu < 192) ? cu - 128 : G, 1);
                pg8::EpiMkv E2; E2.mk = (bf16_t*)(ws + WS_MK); E2.mvT = (bf16_t*)(ws + WS_MVT);
                pg8::gemm_phase(lds, g2, S2, E2, tid);
            }
        }
        return;
    }
    if (s == 1) {
#ifndef MIXSUB
#define MIXSUB 7
#endif
        if (!dry || (MIXSUB & 1)) for (int it = cu; it < 512; it += G) ret_state_item(proj, tab, states, it, lds, tid);
        if (!dry || (MIXSUB & 2)) for (int it = cu; it < 256; it += G) swa_item(proj, p.in[9] + l * 16, it, lds, tid, dry);
        if (!dry || (MIXSUB & 4)) for (int it = cu; it < 256; it += G) mem_item(proj, (const bf16_t*)(ws + WS_MK), (const bf16_t*)(ws + WS_MVT), half * 4, it, lds, tid, dry);
        return;
    }
    if (s == 2) { ret_scan(states, cu * 512 + tid, G * 512, dry); return; }
    if (s == 3) {
        for (int it = cu; it < 512; it += G) ret_out_item(proj, tab, states, p.in[8] + l * 1024, it, lds, tid, dry);
        return;
    }
    {
        pg8::Gemm g; g.A = proj; g.Bt = (const bf16_t*)(ws + WS_WUP); g.M = T_HALF; g.N = DM; g.K = DM; g.lda = INW; g.zoff0 = C_RG; g.zoff1 = C_SQ; g.zoff2 = C_MQ; g.zB = (long)DM * DM;
        pg8::Order S; S.init(g.M, g.N, G, cu, 3);
        pg8::EpiGate E; E.Mg = Hb + (size_t)half * T_HALF * DM; E.gl = proj + C_GL; E.ldg = INW; E.gl2 = (const bf16_t*)(ws + WS_GL2) + (size_t)half * T_HALF * 256;
        pg8::gemm_phase(lds, g, S, E, tid);
    }
}

__global__ __launch_bounds__(512, 2) void mega(Params p, int ph_lo, int ph_hi) {
    extern __shared__ __attribute__((aligned(16))) unsigned char shm[];
    LAS unsigned char* lds = (LAS unsigned char*)shm;
    cg::grid_group grid = cg::this_grid();
    volatile LAS unsigned* st = (volatile LAS unsigned*)(lds + LDS_PHASE);
    if (threadIdx.x == 0) { st[0] = 0u; st[1] = 0u; st[2] = 0u; st[3] = 0u; }
    __syncthreads();
    const XcdBarrier xb = xcd_barrier_post((unsigned*)(p.ws + WS_BAR), st);
    for (int ph = ph_lo; ph < ph_hi; ++ph) {
        int nrep = 1;
#if DBL_MASK
        { const int kk = (ph == NPH - 1) ? 16 : ph % NPL; nrep += (DBL_MASK >> kk) & 1; }
#endif
        for (int rep = 0; rep < nrep; ++rep) { int dry = rep; asm volatile("" : "+s"(dry)); run_phase(p, ph, lds, dry); if (rep + 1 < nrep) __syncthreads(); }
        if (ph + 1 < ph_hi) { if (ph_hi < 0) grid.sync(); else xcd_barrier(xb); }
    }
}

extern "C" void kernel_launch(void* const* d_in, const int* in_sizes, int n_in, void* d_out, int out_size, void* d_ws, size_t ws_size, hipStream_t stream) {
    static int grid = 0;
    if (grid == 0) {
        if (n_in != 21 || out_size != T_ALL * DM || ws_size < WS_END2) { fprintf(stderr, "kernel_launch: unexpected shapes (n_in %d out %d ws %zu need %zu)\n", n_in, out_size, ws_size, (size_t)WS_END2); grid = -1; return; }
        int dev = 0, cus = 0, per_cu = 0;
        if (hipGetDevice(&dev) != hipSuccess || hipDeviceGetAttribute(&cus, hipDeviceAttributeMultiprocessorCount, dev) != hipSuccess) { grid = -1; return; }
        if (hipFuncSetAttribute((const void*)mega, hipFuncAttributeMaxDynamicSharedMemorySize, LDS_BYTES) != hipSuccess) { fprintf(stderr, "kernel_launch: hipFuncSetAttribute failed\n"); grid = -1; return; }
        if (hipOccupancyMaxActiveBlocksPerMultiprocessor(&per_cu, (const void*)mega, 512, LDS_BYTES) != hipSuccess || per_cu < 1) { fprintf(stderr, "kernel_launch: occupancy query says %d\n", per_cu); per_cu = 1; }
        (void)hipGetLastError();
        grid = cus;
    }
    if (grid <= 0) return;
    Params p{};
    for (int i = 0; i < 21; ++i) p.in[i] = (const float*)d_in[i];
    p.out = (float*)d_out; p.ws = (unsigned char*)d_ws;
    (void)hipMemsetAsync((unsigned char*)d_ws + WS_BAR, 0, 16384, stream);
#if MK_ONE_LAUNCH
    int lo = 0, hi = NPH;
    void* args[] = {&p, &lo, &hi};
    hipError_t e = hipLaunchCooperativeKernel((const void*)mega, dim3(grid), dim3(512), args, LDS_BYTES, stream);
    if (e != hipSuccess) fprintf(stderr, "cooperative launch failed: %s (grid %d)\n", hipGetErrorString(e), grid);
#else
    for (int ph = 0; ph < NPH; ++ph) hipLaunchKernelGGL(mega, dim3(grid), dim3(512), LDS_BYTES, stream, p, ph, ph + 1);
#endif
}
```

```cpp
#include <hip/hip_runtime.h>
#include <hip/hip_cooperative_groups.h>
#include <cstdio>
#include <cstdint>
namespace cg = cooperative_groups;

#ifndef MK_ONE_LAUNCH
#define MK_ONE_LAUNCH 1
#endif

#ifndef DBL_MASK
#define DBL_MASK 0
#endif
#ifndef PHMASK
#define PHMASK 0xffff
#endif
#define LAS __attribute__((address_space(3)))
#define GAS __attribute__((address_space(1)))
typedef unsigned short bf16_t;
typedef short bf16x8 __attribute__((ext_vector_type(8)));
typedef short bf16x4 __attribute__((ext_vector_type(4)));
typedef float f32x4 __attribute__((ext_vector_type(4)));
typedef float f32x2 __attribute__((ext_vector_type(2)));
typedef unsigned u32x4 __attribute__((ext_vector_type(4)));
typedef unsigned u32x2 __attribute__((ext_vector_type(2)));

constexpr int T_ALL = 32768, DM = 1024, FF = 2816, INW = 8448, T_HALF = 16384, SEQ = 4096;
constexpr int C_RQ = 0, C_RK = 512, C_RV = 1024, C_RG = 2048, C_SQ = 3072, C_SK = 4096, C_SV = 4224, C_MQ = 4352, C_GL = 5376;
constexpr int LDS_PHASE = 143360, LDS_BYTES = LDS_PHASE + 16;
constexpr int NPL = 16, NPH = 2 * NPL + 1;

constexpr size_t SZ_W13 = (size_t)2 * FF * DM * 2, SZ_W2 = (size_t)DM * FF * 2;
constexpr size_t WS_W13A = 0, WS_W2A = WS_W13A + SZ_W13, WS_W13B = WS_W2A + SZ_W2, WS_W2B = WS_W13B + SZ_W13;
constexpr size_t WS_WIN = WS_W2B + SZ_W2, WS_WMKV = WS_WIN + (size_t)INW * DM * 2, WS_WUP = WS_WMKV + (size_t)2048 * DM * 2;
constexpr size_t WS_WO = WS_WUP + (size_t)3 * DM * DM * 2, WS_TAB = WS_WO + (size_t)DM * DM * 2;
constexpr size_t WS_MEMH = WS_TAB + (size_t)SEQ * 64 * 8, WS_MK = WS_MEMH + (size_t)2048 * DM * 2, WS_MVT = WS_MK + (size_t)2048 * DM * 2;
constexpr size_t WS_H = WS_MVT + (size_t)2048 * DM * 2, WS_TMP = WS_H + (size_t)T_ALL * DM * 2;
constexpr size_t WS_U = WS_TMP, WS_PROJ = WS_TMP, WS_ST = WS_PROJ + (size_t)T_HALF * INW * 2;
constexpr size_t WS_BAR = WS_ST + (size_t)512 * 32768 * 4;
constexpr size_t WS_SSQ = WS_BAR + 16384;
constexpr size_t WS_END = WS_SSQ + (size_t)3 * T_ALL * 16;
constexpr size_t WS_GL2 = WS_END;
constexpr size_t WS_END2 = WS_GL2 + (size_t)T_ALL * 256 * 2;
constexpr size_t WS_XB3 = WS_TMP + (size_t)192 * 1024 * 1024;

struct Params {
    const float* in[21];
    float* out;
    unsigned char* ws;
};

__device__ __forceinline__ unsigned cvt_pk_bf16(float lo, float hi) { unsigned r; asm volatile("v_cvt_pk_bf16_f32 %0, %1, %2" : "=v"(r) : "v"(lo), "v"(hi)); return r; }
__device__ __forceinline__ bf16_t f2bf(float f) { return (bf16_t)(cvt_pk_bf16(f, 0.f) & 0xffffu); }
__device__ __forceinline__ float bf2f(unsigned b) { return __uint_as_float(b << 16); }
__device__ __forceinline__ float bflo(unsigned w) { return __uint_as_float(w << 16); }
__device__ __forceinline__ float bfhi(unsigned w) { return __uint_as_float(w & 0xffff0000u); }
__device__ __forceinline__ float wave_sum(float v) {
#pragma unroll
    for (int o = 1; o < 64; o <<= 1) v += __shfl_xor(v, o);
    return v;
}
__device__ __forceinline__ f32x4 zero4() {
    typedef double f64x2 __attribute__((ext_vector_type(2)));
    double lo, hi;
    asm volatile("v_mov_b64 %0, 0" : "=v"(lo));
    asm volatile("v_mov_b64 %0, 0" : "=v"(hi));
    return __builtin_bit_cast(f32x4, ((f64x2){lo, hi}));
}
__device__ __forceinline__ f32x4 mfma16(bf16x8 a, bf16x8 b, f32x4 c) { return __builtin_amdgcn_mfma_f32_16x16x32_bf16(a, b, c, 0, 0, 0); }
__device__ __forceinline__ float sigmoidf_(float x) { return __builtin_amdgcn_rcpf(1.0f + __builtin_amdgcn_exp2f(x * -1.4426950408889634f)); }
__device__ __forceinline__ float log2g(int h) { return h == 0 ? -0.04580368961312479f : h == 1 ? -0.02272007650008353f : h == 2 ? -0.011315313227834146f : -0.005646563141142063f; }

namespace pg8 {
constexpr int BM = 256, BK = 64, HALF = 128, HTB = HALF * BK * 2, STAGE_BYTES = 8 * HTB, NXCD = 8, WGM = 8;
__host__ __device__ __forceinline__ int lds_byte(int r, int c) { const int st = (r >> 4) * 2 + (c >> 5), rr = r & 15, cc = c & 31, ob = rr * 64 + cc * 2; return st * 1024 + (ob ^ (((ob >> 9) & 1) << 5)); }
__host__ __device__ __forceinline__ void stage_rc(int b, int& R, int& C) { const int st = b / 1024, sb = b % 1024, swz = sb ^ (((sb >> 9) & 1) << 5); R = (st >> 1) * 16 + swz / 64; C = (st & 1) * 32 + (swz % 64) / 2; }
__host__ __device__ __forceinline__ int perm32(int rho) { const int n = rho >> 4, i = rho & 15; return 8 * (i >> 2) + 4 * n + (i & 3); }

struct Unit { int pm, pn, z, idx; };
struct Gemm { const bf16_t* A; const bf16_t* Bt; int M, N, K, lda; int zoff0, zoff1, zoff2; long zB; };

struct Order {
    int nM, nN, nwg, G, c, nZ, rev;
    __device__ void init(int M, int N, int G_, int c_, int nZ_, int rev_ = 0) { nM = M / BM; nN = N / BM; nwg = nM * nN; G = G_; c = c_; nZ = nZ_; rev = rev_; }
    __device__ bool next(int i, Unit& u) const {
        int rnd = i, z = 0;
        if (nZ == 3) { rnd = i / 3; z = i - 3 * rnd; }
        u.z = z; u.idx = i;
        const long L = (long)rnd * G + c; if (L >= nwg) return false;
        int wgid = (int)L; { const int q = nwg / NXCD, r = nwg % NXCD, xcd = wgid % NXCD, off = wgid / NXCD; wgid = (xcd < r ? xcd * (q + 1) : r * (q + 1) + (xcd - r) * q) + off; }
        const int nig = WGM * nN, gid = wgid / nig, fm = gid * WGM, gsz = (nM - fm) < WGM ? (nM - fm) : WGM;
        u.pm = fm + ((wgid % nig) % gsz); u.pn = (wgid % nig) / gsz;
        if (rev & 1) u.pm = nM - 1 - u.pm;
        if (rev & 2) u.pn = nN - 1 - u.pn;
        return true;
    }
};

struct EpiStore {
    static constexpr bool PERM = true; static constexpr int NST = 16;
    bf16_t* O; int ldc; const LAS float* rtab;
    __device__ __forceinline__ void operator()(const f32x4 (&acc)[2][2][4][2], const Unit& u, int wr, int wc, int fr, int fq) const {
        const int row0 = u.pm * BM + wr * 64 + fr, col0 = u.pn * BM + wc * 32 + 8 * fq;
        const LAS float* rt = rtab + u.idx * 256 + wr * 64 + fr;
#pragma unroll
        for (int ai = 0; ai < 2; ++ai)
#pragma unroll
            for (int m = 0; m < 4; ++m) { bf16_t* rowp = O + (size_t)(row0 + ai * HALF + m * 16) * ldc + col0;
                const float rs = rt[ai * HALF + m * 16];
#pragma unroll
                for (int bj = 0; bj < 2; ++bj) { const f32x4 v0 = acc[ai][bj][m][0] * rs, v1 = acc[ai][bj][m][1] * rs;
                    u32x4 w; w.x = cvt_pk_bf16(v0[0], v0[1]); w.y = cvt_pk_bf16(v0[2], v0[3]); w.z = cvt_pk_bf16(v1[0], v1[1]); w.w = cvt_pk_bf16(v1[2], v1[3]);
                    *(u32x4*)(rowp + bj * HALF) = w; } }
    }
};
struct EpiSwiglu {
    static constexpr bool PERM = true; static constexpr int NST = 8;
    bf16_t* U; int ldu; const LAS float* rtab;
    __device__ __forceinline__ void operator()(const f32x4 (&acc)[2][2][4][2], const Unit& u, int wr, int wc, int fr, int fq) const {
        const int row0 = u.pm * BM + wr * 64 + fr, col0 = u.pn * 128 + wc * 32 + 8 * fq;
        const LAS float* rt = rtab + u.idx * 256 + wr * 64 + fr;
#pragma unroll
        for (int ai = 0; ai < 2; ++ai)
#pragma unroll
            for (int m = 0; m < 4; ++m) { bf16_t* rowp = U + (size_t)(row0 + ai * HALF + m * 16) * ldu + col0;
                const float rs = rt[ai * HALF + m * 16];
                const float ke = rs * -1.4426950408889634f, rs2 = rs * rs;
                float r[8];
#pragma unroll
                for (int n = 0; n < 2; ++n) { const f32x4 a = acc[ai][0][m][n], b = acc[ai][1][m][n];
                    const f32x4 ab = a * b * rs2, ea = a * ke;
#pragma unroll
                    for (int j = 0; j < 4; ++j) r[4 * n + j] = ab[j] * __builtin_amdgcn_rcpf(1.0f + __builtin_amdgcn_exp2f(ea[j])); }
                *(u32x4*)rowp = (u32x4){cvt_pk_bf16(r[0], r[1]), cvt_pk_bf16(r[2], r[3]), cvt_pk_bf16(r[4], r[5]), cvt_pk_bf16(r[6], r[7])}; }
    }
};
struct EpiResid {
    static constexpr bool PERM = true; static constexpr int NST = 16;
    const bf16_t* src; bf16_t* dst; float* ssq; int ld; float scale; LAS float* red;
    __device__ __forceinline__ void operator()(const f32x4 (&acc)[2][2][4][2], const Unit& u, int wr, int wc, int fr, int fq) const {
        const int row0 = u.pm * BM + wr * 64 + fr, col0 = u.pn * BM + wc * 32 + 8 * fq;
        float ssr[2][4];
#pragma unroll
        for (int ai = 0; ai < 2; ++ai) {
            u32x4 sv[4][2];
#pragma unroll
            for (int m = 0; m < 4; ++m)
#pragma unroll
                for (int bj = 0; bj < 2; ++bj) sv[m][bj] = *(const u32x4*)(src + (size_t)(row0 + ai * HALF + m * 16) * ld + col0 + bj * HALF);
#pragma unroll
            for (int m = 0; m < 4; ++m) { const size_t ro = (size_t)(row0 + ai * HALF + m * 16) * ld + col0; float ss = 0.f;
#pragma unroll
                for (int bj = 0; bj < 2; ++bj) { const u32x4 w = sv[m][bj]; const f32x4 a0 = acc[ai][bj][m][0], a1 = acc[ai][bj][m][1];
                    const float v0 = bflo(w.x) + a0[0] * scale, v1 = bfhi(w.x) + a0[1] * scale, v2 = bflo(w.y) + a0[2] * scale, v3 = bfhi(w.y) + a0[3] * scale;
                    const float v4 = bflo(w.z) + a1[0] * scale, v5 = bfhi(w.z) + a1[1] * scale, v6 = bflo(w.w) + a1[2] * scale, v7 = bfhi(w.w) + a1[3] * scale;
                    *(u32x4*)(dst + ro + bj * HALF) = (u32x4){cvt_pk_bf16(v0, v1), cvt_pk_bf16(v2, v3), cvt_pk_bf16(v4, v5), cvt_pk_bf16(v6, v7)};
                    ss += ((v0 * v0 + v1 * v1) + (v2 * v2 + v3 * v3)) + ((v4 * v4 + v5 * v5) + (v6 * v6 + v7 * v7)); }
                ssr[ai][m] = ss; }
        }
        float t1[2][4];
#pragma unroll
        for (int ai = 0; ai < 2; ++ai)
#pragma unroll
            for (int m = 0; m < 4; ++m) t1[ai][m] = __shfl_xor(ssr[ai][m], 16);
#pragma unroll
        for (int ai = 0; ai < 2; ++ai)
#pragma unroll
            for (int m = 0; m < 4; ++m) ssr[ai][m] += t1[ai][m];
#pragma unroll
        for (int ai = 0; ai < 2; ++ai)
#pragma unroll
            for (int m = 0; m < 4; ++m) t1[ai][m] = __shfl_xor(ssr[ai][m], 32);
#pragma unroll
        for (int ai = 0; ai < 2; ++ai)
#pragma unroll
            for (int m = 0; m < 4; ++m) if (fq == 0) red[(ai * HALF + wr * 64 + m * 16 + fr) * 4 + wc] = ssr[ai][m] + t1[ai][m];
        asm volatile("s_waitcnt lgkmcnt(0)" ::: "memory"); __builtin_amdgcn_s_barrier(); asm volatile("" ::: "memory");
        const int t = (wr * 4 + wc) * 64 + fq * 16 + fr;
        if (t < 256) { const f32x4 q = *(const LAS f32x4*)(red + t * 4); ssq[(size_t)(u.pm * BM + t) * 4 + u.pn] = (q.x + q.y) + (q.z + q.w); }
    }
};
struct EpiGate {
    static constexpr bool PERM = true; static constexpr int NST = 16;
    bf16_t* Mg; const bf16_t* gl; int ldg; const bf16_t* gl2;
    __device__ __forceinline__ void operator()(const f32x4 (&acc)[2][2][4][2], const Unit& u, int wr, int wc, int fr, int fq) const {
        const int row0 = u.pm * BM + wr * 64 + fr, col0 = u.pn * BM + wc * 32 + 8 * fq;
#pragma unroll
        for (int ai = 0; ai < 2; ++ai)
#pragma unroll
            for (int m = 0; m < 4; ++m) { const int row = row0 + ai * HALF + m * 16;
                bf16_t* mp = Mg + (size_t)row * 1024 + col0;
                const bf16_t* gp = (u.z == 2 && u.pn == 3) ? gl2 + (size_t)row * 256 + (col0 - 768) : gl + (size_t)row * ldg + u.z * 1024 + col0;
#pragma unroll
                for (int bj = 0; bj < 2; ++bj) { const f32x4 v0 = acc[ai][bj][m][0], v1 = acc[ai][bj][m][1];
                    const u32x4 g = *(const u32x4*)(gp + bj * HALF);
                    u32x4 o = (u32x4){0u, 0u, 0u, 0u};
                    if (u.z > 0) o = *(const u32x4*)(mp + bj * HALF);
                    float r[8];
                    r[0] = bflo(o.x) + sigmoidf_(bflo(g.x)) * v0[0]; r[1] = bfhi(o.x) + sigmoidf_(bfhi(g.x)) * v0[1];
                    r[2] = bflo(o.y) + sigmoidf_(bflo(g.y)) * v0[2]; r[3] = bfhi(o.y) + sigmoidf_(bfhi(g.y)) * v0[3];
                    r[4] = bflo(o.z) + sigmoidf_(bflo(g.z)) * v1[0]; r[5] = bfhi(o.z) + sigmoidf_(bfhi(g.z)) * v1[1];
                    r[6] = bflo(o.w) + sigmoidf_(bflo(g.w)) * v1[2]; r[7] = bfhi(o.w) + sigmoidf_(bfhi(g.w)) * v1[3];
                    u32x4 w; w.x = cvt_pk_bf16(r[0], r[1]); w.y = cvt_pk_bf16(r[2], r[3]); w.z = cvt_pk_bf16(r[4], r[5]); w.w = cvt_pk_bf16(r[6], r[7]);
                    *(u32x4*)(mp + bj * HALF) = w; } }
    }
};
struct EpiMkv {
    static constexpr bool PERM = true; static constexpr int NST = 16;
    bf16_t* mk; bf16_t* mvT;
    __device__ __forceinline__ void operator()(const f32x4 (&acc)[2][2][4][2], const Unit& u, int wr, int wc, int fr, int fq) const {
        const int row0 = u.pm * BM + wr * 64 + fr, col0 = u.pn * BM + wc * 32 + 8 * fq;
#pragma unroll
        for (int ai = 0; ai < 2; ++ai)
#pragma unroll
            for (int m = 0; m < 4; ++m) { const int row = row0 + ai * HALF + m * 16;
#pragma unroll
                for (int bj = 0; bj < 2; ++bj) { const f32x4 v0 = acc[ai][bj][m][0], v1 = acc[ai][bj][m][1]; const int col = col0 + bj * HALF;
                    if (u.pn < 4) {
                        u32x4 w; w.x = cvt_pk_bf16(v0[0], v0[1]); w.y = cvt_pk_bf16(v0[2], v0[3]); w.z = cvt_pk_bf16(v1[0], v1[1]); w.w = cvt_pk_bf16(v1[2], v1[3]);
                        *(u32x4*)(mk + (size_t)row * 1024 + col) = w;
                    } else {
                        const int b = row >> 8, mem = row & 255; bf16_t* base = mvT + ((size_t)b * 1024 + (col - 1024)) * 256 + mem;
#pragma unroll
                        for (int j = 0; j < 4; ++j) { base[(size_t)j * 256] = f2bf(v0[j]); base[(size_t)(4 + j) * 256] = f2bf(v1[j]); }
                    } } }
    }
};

template <class Epi>
__device__ __forceinline__ void gemm_phase(LAS unsigned char* lds, const Gemm g, const Order& S, const Epi& E, const int tid) {
    const int wid = __builtin_amdgcn_readfirstlane(tid >> 6), lane = tid & 63, wr = wid >> 2, wc = wid & 3, fr = lane & 15, fq = lane >> 4;
    const int K = g.K, nt = K / BK, lda = g.lda;
    unsigned voffA[2], voffB[2];
#pragma unroll
    for (int i = 0; i < 2; ++i) { int R, C; stage_rc(tid * 16 + i * 8192, R, C); const int Rb = Epi::PERM ? ((R & ~31) + perm32(R & 31)) : R;
        voffA[i] = (unsigned)(R * lda + C) * 2u; voffB[i] = (unsigned)(Rb * K + C) * 2u; }
    const size_t kstep = (size_t)(BK * 2);
    const size_t hstepA = (size_t)HALF * lda * 2, hstepB = (size_t)HALF * K * 2;
    const size_t tstepA = 2 * hstepA, tstepB = 2 * hstepB;
    const unsigned ldsw = (unsigned)wid * 1024u;
    const unsigned ldsbase = (unsigned)(size_t)lds;
    const int aoff = lds_byte(wr * 64 + fr, fq * 8), boff = lds_byte(wc * 32 + fr, fq * 8);
#define PG8_SA(b, h) (((b) * 2 + (h)) * HTB)
#define PG8_SB(b, h) ((4 + (b) * 2 + (h)) * HTB)
#define PG8_STAGE(bufoff, gbase, voff) do { _Pragma("unroll") for (int _i = 0; _i < 2; ++_i) \
        asm volatile("s_mov_b32 m0, %0\n\ts_nop 0\n\tglobal_load_lds_dwordx4 %1, %2" :: "s"((unsigned)(__builtin_amdgcn_readfirstlane((int)(ldsbase + (unsigned)(bufoff) + ldsw + (unsigned)_i * 8192u)))), "v"((voff)[_i]), "s"((const char*)(gbase)) : "m0", "memory"); } while (0)
#define PG8_STAGE_UNLESS(rx, bufoff, gbase, voff) do { _Pragma("unroll") for (int _i = 0; _i < 2; ++_i) \
        asm volatile("s_cmp_lg_u32 %3, 0\n\ts_cbranch_scc1 .Lst_skip_%=\n\ts_mov_b32 m0, %0\n\ts_nop 0\n\tglobal_load_lds_dwordx4 %1, %2\n.Lst_skip_%=:" :: "s"((unsigned)(__builtin_amdgcn_readfirstlane((int)(ldsbase + (unsigned)(bufoff) + ldsw + (unsigned)_i * 8192u)))), "v"((voff)[_i]), "s"((const char*)(gbase)), "s"(rx) : "m0", "memory", "scc"); } while (0)
#define PG8_LDA(dst, b, h) do { _Pragma("unroll") for (int m = 0; m < 4; ++m) _Pragma("unroll") for (int k = 0; k < 2; ++k) dst[m][k] = *(const LAS bf16x8*)(lds + PG8_SA(b, h) + aoff + m * 2048 + k * 1024); } while (0)
#define PG8_LDB(dst, b, h) do { _Pragma("unroll") for (int n = 0; n < 2; ++n) _Pragma("unroll") for (int k = 0; k < 2; ++k) dst[n][k] = *(const LAS bf16x8*)(lds + PG8_SB(b, h) + boff + n * 2048 + k * 1024); } while (0)
#define PG8_MMA(ai, bj, At, Bt) do { __builtin_amdgcn_s_setprio(1); _Pragma("unroll") for (int m = 0; m < 4; ++m) _Pragma("unroll") for (int n = 0; n < 2; ++n) _Pragma("unroll") for (int k = 0; k < 2; ++k) \
        acc[ai][bj][m][n] = __builtin_amdgcn_mfma_f32_16x16x32_bf16(Bt[n][k], At[m][k], acc[ai][bj][m][n], 0, 0, 0); __builtin_amdgcn_s_setprio(0); } while (0)
#define PG8_WAIT_V(n) asm volatile("s_waitcnt vmcnt(" #n ")" ::: "memory")
#define PG8_WAIT_L(n) asm volatile("s_waitcnt lgkmcnt(" #n ")" ::: "memory")
#define PG8_WAIT_V_RX(rx) do { if constexpr (Epi::NST >= 16) asm volatile("s_cmp_lg_u32 %0, 0\n\ts_cbranch_scc1 .Lrx_skip_%=\n\ts_waitcnt vmcnt(8)\n.Lrx_skip_%=:\n\ts_waitcnt vmcnt(24)" :: "s"(rx) : "memory", "scc"); \
        else asm volatile("s_cmp_lg_u32 %0, 0\n\ts_cbranch_scc1 .Lrx_skip_%=\n\ts_waitcnt vmcnt(8)\n.Lrx_skip_%=:\n\ts_waitcnt vmcnt(16)" :: "s"(rx) : "memory", "scc"); } while (0)
#define PG8_BAR __builtin_amdgcn_s_barrier()
#define PG8_SCHED __builtin_amdgcn_sched_barrier(0)
#define PG8_ABASE(u) ((const char*)g.A + (size_t)((u).z == 0 ? g.zoff0 : (u).z == 1 ? g.zoff1 : g.zoff2) * 2 + (size_t)(u).pm * tstepA)
#define PG8_BBASE(u) ((const char*)g.Bt + (size_t)((u).z * g.zB) * 2 + (size_t)(u).pn * tstepB)
    Unit cur, nxt; int ui = 0;
    if (!S.next(0, cur)) return;
    f32x4 acc[2][2][4][2];
#pragma unroll
    for (int a = 0; a < 2; ++a)
#pragma unroll
        for (int b = 0; b < 2; ++b)
#pragma unroll
            for (int m = 0; m < 4; ++m)
#pragma unroll
                for (int n = 0; n < 2; ++n) acc[a][b][m][n] = (f32x4){0.f, 0.f, 0.f, 0.f};
    bf16x8 At[4][2], B0[2][2], B1[2][2];
    const char* cA = PG8_ABASE(cur); const char* cB = PG8_BBASE(cur);
    PG8_STAGE(PG8_SB(0, 0), cB, voffB); PG8_STAGE(PG8_SB(0, 1), cB + hstepB, voffB); PG8_STAGE(PG8_SA(0, 0), cA, voffA); PG8_STAGE(PG8_SA(0, 1), cA + hstepA, voffA);
    if (wr == 1) PG8_BAR;
    PG8_WAIT_V(2); PG8_BAR;
    PG8_STAGE(PG8_SB(1, 0), cB + kstep, voffB); PG8_STAGE(PG8_SA(1, 0), cA + kstep, voffA); PG8_STAGE(PG8_SB(1, 1), cB + hstepB + kstep, voffB);
    PG8_WAIT_V(6); PG8_BAR;
    for (;;) {
        const bool has_next = S.next(ui + 1, nxt);
        const char* nA = has_next ? PG8_ABASE(nxt) : cA; const char* nB = has_next ? PG8_BBASE(nxt) : cB;
        for (int t = 0; t < nt; t += 2) {
            const bool last = (t == nt - 2);
            const char* a1 = cA + (size_t)(t + 1) * kstep;
            const char* a2 = last ? nA : cA + (size_t)(t + 2) * kstep; const char* b2 = last ? nB : cB + (size_t)(t + 2) * kstep;
            const char* a3 = a2 + kstep; const char* b3 = b2 + kstep;
            const int rx = __builtin_amdgcn_readfirstlane(((t == 0) && (ui > 0)) ? 1 : 0);
            PG8_LDB(B0, 0, 0); PG8_LDB(B1, 0, 1); PG8_SCHED; PG8_LDA(At, 0, 0); PG8_STAGE_UNLESS(rx, PG8_SA(1, 1), a1 + hstepA, voffA);
            PG8_WAIT_V_RX(rx);
            PG8_WAIT_L(0); PG8_BAR; PG8_MMA(0, 0, At, B0); PG8_MMA(0, 1, At, B1); PG8_BAR; PG8_SCHED;
            PG8_LDA(At, 0, 1); PG8_STAGE(PG8_SB(0, 0), b2, voffB); PG8_STAGE(PG8_SB(0, 1), b2 + hstepB, voffB); PG8_STAGE(PG8_SA(0, 0), a2, voffA);
            PG8_WAIT_V_RX(rx);
            PG8_WAIT_L(0); PG8_BAR; PG8_MMA(1, 0, At, B0); PG8_MMA(1, 1, At, B1); PG8_BAR; PG8_SCHED;
            PG8_LDB(B0, 1, 0); PG8_LDB(B1, 1, 1); PG8_SCHED; PG8_LDA(At, 1, 0); PG8_STAGE(PG8_SA(0, 1), a2 + hstepA, voffA);
            PG8_WAIT_V_RX(rx); PG8_WAIT_L(0); PG8_BAR; PG8_MMA(0, 0, At, B0); PG8_MMA(0, 1, At, B1); PG8_BAR; PG8_SCHED;
            PG8_LDA(At, 1, 1); PG8_STAGE(PG8_SB(1, 0), b3, voffB); PG8_STAGE(PG8_SB(1, 1), b3 + hstepB, voffB); PG8_STAGE(PG8_SA(1, 0), a3, voffA);
            PG8_WAIT_V(8); PG8_WAIT_L(0); PG8_BAR; PG8_MMA(1, 0, At, B0); PG8_MMA(1, 1, At, B1); PG8_BAR; PG8_SCHED;
        }
        if (wr == 0) PG8_BAR;
        PG8_STAGE(PG8_SA(1, 1), nA + kstep + hstepA, voffA);
        E(acc, cur, wr, wc, fr, fq);
        if (!has_next) break;
#pragma unroll
        for (int a = 0; a < 2; ++a)
#pragma unroll
            for (int b = 0; b < 2; ++b)
#pragma unroll
                for (int m = 0; m < 4; ++m)
#pragma unroll
                    for (int n = 0; n < 2; ++n) acc[a][b][m][n] = zero4();
        cur = nxt; cA = nA; cB = nB; ++ui;
        if (wr == 1) PG8_BAR;
    }
    PG8_WAIT_V(0);
    PG8_BAR;
#undef PG8_SA
#undef PG8_SB
#undef PG8_STAGE
#undef PG8_LDA
#undef PG8_LDB
#undef PG8_MMA
#undef PG8_WAIT_V
#undef PG8_WAIT_L
#undef PG8_WAIT_V_RX
#undef PG8_STAGE_UNLESS
#undef PG8_BAR
#undef PG8_SCHED
#undef PG8_ABASE
#undef PG8_BBASE
}
}

__device__ __forceinline__ void rms_row_bf16(const float* xrow, const float* g, bf16_t* orow, int lane) {
    const f32x4* xr = (const f32x4*)xrow + lane; const f32x4* gr = (const f32x4*)g + lane;
    f32x4 v[4]; float s = 0.f;
#pragma unroll
    for (int j = 0; j < 4; ++j) { v[j] = xr[64 * j]; s += (v[j].x * v[j].x + v[j].y * v[j].y) + (v[j].z * v[j].z + v[j].w * v[j].w); }
    const float rstd = rsqrtf(wave_sum(s) * (1.f / 1024.f) + 1e-6f);
    u32x2* o8 = (u32x2*)orow + lane;
#pragma unroll
    for (int j = 0; j < 4; ++j) { const f32x4 gg = gr[64 * j]; u32x2 w; w.x = cvt_pk_bf16(v[j].x * rstd * gg.x, v[j].y * rstd * gg.y); w.y = cvt_pk_bf16(v[j].z * rstd * gg.z, v[j].w * rstd * gg.w); o8[64 * j] = w; }
}
__device__ __forceinline__ void rms_row_final(const bf16_t* xrow, const float* g, float* orow, int lane) {
    const u32x4 a = *((const u32x4*)xrow + lane), b = *((const u32x4*)xrow + 64 + lane);
    float v[16] = {bflo(a.x), bfhi(a.x), bflo(a.y), bfhi(a.y), bflo(a.z), bfhi(a.z), bflo(a.w), bfhi(a.w), bflo(b.x), bfhi(b.x), bflo(b.y), bfhi(b.y), bflo(b.z), bfhi(b.z), bflo(b.w), bfhi(b.w)};
    float s = 0.f;
#pragma unroll
    for (int j = 0; j < 16; ++j) s += v[j] * v[j];
    const float rstd = rsqrtf(wave_sum(s) * (1.f / 1024.f) + 1e-6f);
#pragma unroll
    for (int hh = 0; hh < 2; ++hh)
#pragma unroll
        for (int q = 0; q < 2; ++q) { const int e = hh * 512 + lane * 8 + q * 4; const f32x4 gg = *(const f32x4*)(g + e);
            *(f32x4*)(orow + e) = (f32x4){v[hh * 8 + q * 4 + 0] * rstd * gg.x, v[hh * 8 + q * 4 + 1] * rstd * gg.y, v[hh * 8 + q * 4 + 2] * rstd * gg.z, v[hh * 8 + q * 4 + 3] * rstd * gg.w}; }
}

__device__ __forceinline__ void wt_item(const float* W, int K, int N, bf16_t* WT, int mode, int item, LAS float* scr, int lane, const float* gain) {
    const int nblk = N >> 6, kb = item / nblk, nb = item - kb * nblk, k0 = kb * 64, n0 = nb * 64;
#pragma unroll 16
    for (int kk = 0; kk < 64; ++kk) scr[kk * 65 + lane] = __builtin_nontemporal_load(W + (size_t)(k0 + kk) * N + n0 + lane);
    asm volatile("s_waitcnt lgkmcnt(0)" ::: "memory");
    const int c = lane & 7;
    f32x4 ga = (f32x4){1.f, 1.f, 1.f, 1.f}, gb = ga;
    if (gain) { ga = *(const f32x4*)(gain + k0 + 8 * c); gb = *(const f32x4*)(gain + k0 + 8 * c + 4); }
#pragma unroll
    for (int j = 0; j < 8; ++j) { const int n = (lane >> 3) + 8 * j, sn = n0 + n; const LAS float* q = scr + (8 * c) * 65 + n;
        const int dr = mode == 0 ? sn : (256 * (sn >> 7) + (sn & 127) + (mode == 2 ? 128 : 0));
        u32x4 o; o.x = cvt_pk_bf16(q[0 * 65] * ga.x, q[1 * 65] * ga.y); o.y = cvt_pk_bf16(q[2 * 65] * ga.z, q[3 * 65] * ga.w); o.z = cvt_pk_bf16(q[4 * 65] * gb.x, q[5 * 65] * gb.y); o.w = cvt_pk_bf16(q[6 * 65] * gb.z, q[7 * 65] * gb.w);
        *(u32x4*)(WT + (size_t)dr * K + k0 + 8 * c) = o; }
    asm volatile("s_waitcnt lgkmcnt(0)" ::: "memory");
}

__device__ __forceinline__ void rot16(const bf16_t* row, const f32x2* tabrow, int jg, float sc, unsigned (&y1)[8], unsigned (&y2)[8]) {
    const u32x4 a0 = *(const u32x4*)(row + jg * 16), a1 = *(const u32x4*)(row + jg * 16 + 8);
    const u32x4 b0 = *(const u32x4*)(row + 64 + jg * 16), b1 = *(const u32x4*)(row + 64 + jg * 16 + 8);
    const unsigned aw[8] = {a0.x, a0.y, a0.z, a0.w, a1.x, a1.y, a1.z, a1.w};
    const unsigned bw[8] = {b0.x, b0.y, b0.z, b0.w, b1.x, b1.y, b1.z, b1.w};
    const f32x4* tp = (const f32x4*)(tabrow + jg * 16);
#pragma unroll
    for (int i = 0; i < 8; ++i) {
        const f32x4 cs = tp[i];
        const float x1a = bflo(aw[i]), x1b = bfhi(aw[i]), x2a = bflo(bw[i]), x2b = bfhi(bw[i]);
        y1[i] = cvt_pk_bf16((x1a * cs.x - x2a * cs.y) * sc, (x1b * cs.z - x2b * cs.w) * sc);
        y2[i] = cvt_pk_bf16((x1a * cs.y + x2a * cs.x) * sc, (x1b * cs.w + x2b * cs.z) * sc);
    }
}

constexpr int RP = 136;

__device__ __forceinline__ void ret_state_item(const bf16_t* proj, const f32x2* tab, bf16_t* states, int item, LAS unsigned char* lds, int tid) {
    const int wave = tid >> 6, lane = tid & 63, fr = lane & 15, fq = lane >> 4;
    const int h = item & 3, n = (item >> 2) & 31, bl = item >> 7;
    const size_t tok0 = (size_t)bl * SEQ + n * 128;
    LAS bf16_t* KT = (LAS bf16_t*)lds;
    LAS bf16_t* VT = (LAS bf16_t*)(lds + 128 * RP * 2);
    const float lg = log2g(h);
    {
        const int c = tid >> 2, jg = tid & 3;
        const bf16_t* row = proj + (tok0 + c) * INW + C_RK + h * 128;
        unsigned y1[8], y2[8];
        rot16(row, tab + (size_t)(n * 128 + c) * 64, jg, 0.08838834764831845f * exp2f(-(float)(c + 1) * lg), y1, y2);
#pragma unroll
        for (int i = 0; i < 8; ++i) {
            const int j = jg * 16 + 2 * i;
            KT[(j) * RP + c] = (bf16_t)(y1[i] & 0xffffu); KT[(j + 1) * RP + c] = (bf16_t)(y1[i] >> 16);
            KT[(j + 64) * RP + c] = (bf16_t)(y2[i] & 0xffffu); KT[(j + 65) * RP + c] = (bf16_t)(y2[i] >> 16);
        }
        const bf16_t* vrow = proj + (tok0 + c) * INW + C_RV + h * 256 + jg * 64;
#pragma unroll
        for (int i = 0; i < 8; ++i) {
            const u32x4 v = *(const u32x4*)(vrow + i * 8);
            const unsigned vw[4] = {v.x, v.y, v.z, v.w};
#pragma unroll
            for (int k = 0; k < 4; ++k) { const int e = jg * 64 + i * 8 + 2 * k; VT[e * RP + c] = (bf16_t)(vw[k] & 0xffffu); VT[(e + 1) * RP + c] = (bf16_t)(vw[k] >> 16); }
        }
    }
    __syncthreads();
    f32x4 acc[8][2];
#pragma unroll
    for (int dt = 0; dt < 8; ++dt) { acc[dt][0] = (f32x4){0.f, 0.f, 0.f, 0.f}; acc[dt][1] = (f32x4){0.f, 0.f, 0.f, 0.f}; }
#pragma unroll
    for (int ks = 0; ks < 4; ++ks) {
        bf16x8 bfr[2];
#pragma unroll
        for (int et = 0; et < 2; ++et) bfr[et] = *(const LAS bf16x8*)(VT + (32 * wave + 16 * et + fr) * RP + 32 * ks + 8 * fq);
#pragma unroll
        for (int dt = 0; dt < 8; ++dt) {
            const bf16x8 a = *(const LAS bf16x8*)(KT + (16 * dt + fr) * RP + 32 * ks + 8 * fq);
            acc[dt][0] = mfma16(a, bfr[0], acc[dt][0]); acc[dt][1] = mfma16(a, bfr[1], acc[dt][1]);
        }
    }
    const float gch = exp2f(128.f * lg);
    bf16_t* sp = states + (size_t)item * 32768;
#pragma unroll
    for (int et = 0; et < 2; ++et)
#pragma unroll
        for (int dt = 0; dt < 8; ++dt) { const f32x4 v = acc[dt][et] * gch; *(u32x2*)(sp + (size_t)(32 * wave + 16 * et + fr) * 128 + 16 * dt + 4 * fq) = (u32x2){cvt_pk_bf16(v[0], v[1]), cvt_pk_bf16(v[2], v[3])}; }
    __syncthreads();
}

__device__ __forceinline__ void ret_scan(bf16_t* states, int gtid, int nthreads, int dry) {
    for (int i = gtid; i < 16 * 8192; i += nthreads) {
        const int bh = i >> 13, off = i & 8191, bl = bh >> 2, h = bh & 3;
        const float g = exp2f(128.f * log2g(h));
        u32x2* p = (u32x2*)(states + ((size_t)(bl * 32) * 4 + h) * 32768) + off;
        f32x4 R = (f32x4){0.f, 0.f, 0.f, 0.f};
        for (int n0 = 0; n0 < 32; n0 += 8) {
            u32x2 sv[8];
#pragma unroll
            for (int k = 0; k < 8; ++k) sv[k] = p[(size_t)(n0 + k) * 32768];
#pragma unroll
            for (int k = 0; k < 8; ++k) { if (!dry) p[(size_t)(n0 + k) * 32768] = (u32x2){cvt_pk_bf16(R[0], R[1]), cvt_pk_bf16(R[2], R[3])};
                R = R * g + (f32x4){bflo(sv[k].x), bfhi(sv[k].x), bflo(sv[k].y), bfhi(sv[k].y)}; }
        }
    }
}

__device__ __forceinline__ void ret_out_item(bf16_t* proj, const f32x2* tab, const bf16_t* states, const float* gn, int item, LAS unsigned char* lds, int tid, int dry) {
    const int wave = tid >> 6, lane = tid & 63, fr = lane & 15, fq = lane >> 4;
    const int h = item & 3, n = (item >> 2) & 31, bl = item >> 7;
    const size_t tok0 = (size_t)bl * SEQ + n * 128;
    LAS bf16_t* QS = (LAS bf16_t*)lds;
    LAS bf16_t* KS = (LAS bf16_t*)(lds + 128 * RP * 2);
    LAS bf16_t* VT = (LAS bf16_t*)(lds + 2 * 128 * RP * 2);
    LAS float* red = (LAS float*)(lds + 4 * 128 * RP * 2);
    const float lg = log2g(h);
    {
        const int c = tid >> 2, jg = tid & 3;
        const f32x2* tr = tab + (size_t)(n * 128 + c) * 64;
        unsigned y1[8], y2[8];
        rot16(proj + (tok0 + c) * INW + C_RQ + h * 128, tr, jg, exp2f((float)(c + 1) * lg), y1, y2);
        *(LAS u32x4*)(QS + c * RP + jg * 16) = (u32x4){y1[0], y1[1], y1[2], y1[3]}; *(LAS u32x4*)(QS + c * RP + jg * 16 + 8) = (u32x4){y1[4], y1[5], y1[6], y1[7]};
        *(LAS u32x4*)(QS + c * RP + 64 + jg * 16) = (u32x4){y2[0], y2[1], y2[2], y2[3]}; *(LAS u32x4*)(QS + c * RP + 64 + jg * 16 + 8) = (u32x4){y2[4], y2[5], y2[6], y2[7]};
        rot16(proj + (tok0 + c) * INW + C_RK + h * 128, tr, jg, 0.08838834764831845f * exp2f(-(float)(c + 1) * lg), y1, y2);
        *(LAS u32x4*)(KS + c * RP + jg * 16) = (u32x4){y1[0], y1[1], y1[2], y1[3]}; *(LAS u32x4*)(KS + c * RP + jg * 16 + 8) = (u32x4){y1[4], y1[5], y1[6], y1[7]};
        *(LAS u32x4*)(KS + c * RP + 64 + jg * 16) = (u32x4){y2[0], y2[1], y2[2], y2[3]}; *(LAS u32x4*)(KS + c * RP + 64 + jg * 16 + 8) = (u32x4){y2[4], y2[5], y2[6], y2[7]};
        const bf16_t* vrow = proj + (tok0 + c) * INW + C_RV + h * 256 + jg * 64;
#pragma unroll
        for (int i = 0; i < 8; ++i) {
            const u32x4 v = *(const u32x4*)(vrow + i * 8);
            const unsigned vw[4] = {v.x, v.y, v.z, v.w};
#pragma unroll
            for (int k = 0; k < 4; ++k) { const int e = jg * 64 + i * 8 + 2 * k; VT[e * RP + c] = (bf16_t)(vw[k] & 0xffffu); VT[(e + 1) * RP + c] = (bf16_t)(vw[k] >> 16); }
        }
    }
    __syncthreads();
    unsigned pk[8][2];
    {
        f32x4 pacc[8];
#pragma unroll
        for (int st = 0; st < 8; ++st) pacc[st] = (f32x4){0.f, 0.f, 0.f, 0.f};
#pragma unroll
        for (int ks = 0; ks < 4; ++ks) {
            const bf16x8 b = *(const LAS bf16x8*)(QS + (16 * wave + fr) * RP + 32 * ks + 8 * fq);
#pragma unroll
            for (int st = 0; st < 8; ++st) { const bf16x8 a = *(const LAS bf16x8*)(KS + (16 * st + fr) * RP + 32 * ks + 8 * fq); pacc[st] = mfma16(a, b, pacc[st]); }
        }
        const int c = 16 * wave + fr;
#pragma unroll
        for (int st = 0; st < 8; ++st) { float v[4];
#pragma unroll
            for (int j = 0; j < 4; ++j) { const int s = 16 * st + 4 * fq + j; v[j] = (s <= c) ? pacc[st][j] : 0.f; }
            pk[st][0] = cvt_pk_bf16(v[0], v[1]); pk[st][1] = cvt_pk_bf16(v[2], v[3]); }
    }
    __syncthreads();
    {
        const int c = 16 * wave + fr;
#pragma unroll
        for (int st = 0; st < 8; ++st) *(LAS u32x2*)(KS + c * RP + 16 * st + 4 * fq) = (u32x2){pk[st][0], pk[st][1]};
    }
    __syncthreads();
    f32x4 acc[2][8];
#pragma unroll
    for (int et = 0; et < 2; ++et)
#pragma unroll
        for (int ct = 0; ct < 8; ++ct) acc[et][ct] = (f32x4){0.f, 0.f, 0.f, 0.f};
    const bf16_t* sp = states + (size_t)item * 32768;
#pragma unroll
    for (int ks = 0; ks < 4; ++ks) {
        bf16x8 av[2], ar[2];
#pragma unroll
        for (int et = 0; et < 2; ++et) {
            const int e = 32 * wave + 16 * et + fr;
            av[et] = *(const LAS bf16x8*)(VT + e * RP + 32 * ks + 8 * fq);
            ar[et] = *(const bf16x8*)(sp + (size_t)e * 128 + 32 * ks + 8 * fq);
        }
#pragma unroll
        for (int ct = 0; ct < 8; ++ct) {
            const bf16x8 bp = *(const LAS bf16x8*)(KS + (16 * ct + fr) * RP + 32 * ks + 8 * fq);
            const bf16x8 bq = *(const LAS bf16x8*)(QS + (16 * ct + fr) * RP + 32 * ks + 8 * fq);
#pragma unroll
            for (int et = 0; et < 2; ++et) { acc[et][ct] = mfma16(av[et], bp, acc[et][ct]); acc[et][ct] = mfma16(ar[et], bq, acc[et][ct]); }
        }
    }
#pragma unroll
    for (int ct = 0; ct < 8; ++ct) {
        float s = 0.f;
#pragma unroll
        for (int et = 0; et < 2; ++et) s += (acc[et][ct][0] * acc[et][ct][0] + acc[et][ct][1] * acc[et][ct][1]) + (acc[et][ct][2] * acc[et][ct][2] + acc[et][ct][3] * acc[et][ct][3]);
        s += __shfl_xor(s, 16); s += __shfl_xor(s, 32);
        if (fq == 0) red[wave * 128 + 16 * ct + fr] = s;
    }
    __syncthreads();
#pragma unroll
    for (int ct = 0; ct < 8; ++ct) {
        const int c = 16 * ct + fr;
        float s = 0.f;
#pragma unroll
        for (int w = 0; w < 8; ++w) s += red[w * 128 + c];
        const float rstd = rsqrtf(s * (1.f / 256.f) + 1e-6f);
        bf16_t* grow = proj + (tok0 + c) * INW + C_RG + h * 256;
#pragma unroll
        for (int et = 0; et < 2; ++et) {
            const int e = 32 * wave + 16 * et + 4 * fq;
            const u32x2 gw = *(const u32x2*)(grow + e);
            const f32x4 gg = *(const f32x4*)(gn + h * 256 + e);
            const float g0 = bflo(gw.x), g1 = bfhi(gw.x), g2 = bflo(gw.y), g3 = bfhi(gw.y);
            const float o0 = acc[et][ct][0] * rstd * gg.x * g0 * sigmoidf_(g0), o1 = acc[et][ct][1] * rstd * gg.y * g1 * sigmoidf_(g1);
            const float o2 = acc[et][ct][2] * rstd * gg.z * g2 * sigmoidf_(g2), o3 = acc[et][ct][3] * rstd * gg.w * g3 * sigmoidf_(g3);
            if (!dry) *(u32x2*)(grow + e) = (u32x2){cvt_pk_bf16(o0, o1), cvt_pk_bf16(o2, o3)};
        }
    }
    __syncthreads();
}

__device__ __forceinline__ int rowperm(int d) { return (d & ~31) | (((d >> 2) & 1) << 4) | (((d >> 3) & 3) << 2) | (d & 3); }
constexpr int SKP = 72, SVP = 264;
__device__ __forceinline__ void swa_item(bf16_t* proj, const float* sinks, int item, LAS unsigned char* lds, int tid, int dry) {
    const int wave = tid >> 6, lane = tid & 63, fr = lane & 15, fq = lane >> 4;
    const int kh = item & 1, n = (item >> 1) & 31, bl = item >> 6;
    const size_t tok0 = (size_t)bl * SEQ + n * 128;
    LAS bf16_t* Ks = (LAS bf16_t*)lds;
    LAS bf16_t* Vt = (LAS bf16_t*)(lds + 256 * SKP * 2);
#pragma unroll
    for (int i = 0; i < 4; ++i) {
        const int ch = tid + 512 * i, key = ch >> 3, part = ch & 7;
        u32x4 kv = (u32x4){0u, 0u, 0u, 0u}, vv = (u32x4){0u, 0u, 0u, 0u};
        if (n > 0 || key >= 128) { const bf16_t* r = proj + (tok0 + key - 128) * INW; kv = *(const u32x4*)(r + C_SK + kh * 64 + part * 8); vv = *(const u32x4*)(r + C_SV + kh * 64 + part * 8); }
        *(LAS u32x4*)(Ks + key * SKP + part * 8) = kv;
        const unsigned vw[4] = {vv.x, vv.y, vv.z, vv.w};
#pragma unroll
        for (int k = 0; k < 4; ++k) { const int d = part * 8 + 2 * k; Vt[rowperm(d) * SVP + key] = (bf16_t)(vw[k] & 0xffffu); Vt[rowperm(d + 1) * SVP + key] = (bf16_t)(vw[k] >> 16); }
    }
    __syncthreads();
    const int h = kh * 8 + wave; const float sink = sinks[h];
    for (int qt = 0; qt < 8; ++qt) {
        bf16_t* qrow = proj + (tok0 + 16 * qt + fr) * INW + C_SQ + h * 64;
        bf16x8 qf[2];
        qf[0] = *(const bf16x8*)(qrow + 8 * fq); qf[1] = *(const bf16x8*)(qrow + 32 + 8 * fq);
        f32x4 s[10];
#pragma unroll
        for (int r = 0; r < 9; ++r) { s[r] = (f32x4){0.f, 0.f, 0.f, 0.f};
#pragma unroll
            for (int ks = 0; ks < 2; ++ks) { const bf16x8 a = *(const LAS bf16x8*)(Ks + (16 * (qt + r) + fr) * SKP + 32 * ks + 8 * fq); s[r] = mfma16(a, qf[ks], s[r]); } }
        s[9] = (f32x4){0.f, 0.f, 0.f, 0.f};
        const int c = 16 * qt + fr; float mxr = -1e30f;
#pragma unroll
        for (int r = 0; r < 9; ++r) {
            const bool tile_ok = (n > 0) || (qt + r >= 8);
            if (r == 0 || r == 8 || !tile_ok) {
#pragma unroll
                for (int j = 0; j < 4; ++j) { const int kpos = 16 * (qt + r) + 4 * fq + j;
                    bool valid = tile_ok;
                    if (r == 0) valid = valid && (kpos > c);
                    if (r == 8) valid = valid && (kpos <= c + 128);
                    s[r][j] = valid ? s[r][j] : -1e30f; }
            }
            mxr = fmaxf(mxr, fmaxf(fmaxf(s[r][0], s[r][1]), fmaxf(s[r][2], s[r][3])));
        }
        mxr = fmaxf(mxr, __shfl_xor(mxr, 16)); mxr = fmaxf(mxr, __shfl_xor(mxr, 32));
        const float mx = fmaxf(mxr * 0.125f, sink);
        const float c1 = 0.125f * 1.4426950408889634f, mo = -mx * 1.4426950408889634f;
        float sum = 0.f;
#pragma unroll
        for (int r = 0; r < 9; ++r)
#pragma unroll
            for (int j = 0; j < 4; ++j) { const float pv = __builtin_amdgcn_exp2f(fmaf(s[r][j], c1, mo)); s[r][j] = pv; sum += pv; }
        sum += __shfl_xor(sum, 16); sum += __shfl_xor(sum, 32);
        sum += __expf(sink - mx);
        const float inv = __builtin_amdgcn_rcpf(sum);
        f32x4 o[4];
#pragma unroll
        for (int dt = 0; dt < 4; ++dt) o[dt] = (f32x4){0.f, 0.f, 0.f, 0.f};
#pragma unroll
        for (int k2 = 0; k2 < 5; ++k2) {
            u32x4 pw; pw.x = cvt_pk_bf16(s[2 * k2][0], s[2 * k2][1]); pw.y = cvt_pk_bf16(s[2 * k2][2], s[2 * k2][3]); pw.z = cvt_pk_bf16(s[2 * k2 + 1][0], s[2 * k2 + 1][1]); pw.w = cvt_pk_bf16(s[2 * k2 + 1][2], s[2 * k2 + 1][3]);
            const bf16x8 pf = __builtin_bit_cast(bf16x8, pw);
            const int kb = 16 * (qt + 2 * k2);
#pragma unroll
            for (int dt = 0; dt < 4; ++dt) {
                const u32x2 v0 = *(const LAS u32x2*)(Vt + (16 * dt + fr) * SVP + kb + 4 * fq), v1 = *(const LAS u32x2*)(Vt + (16 * dt + fr) * SVP + kb + (k2 == 4 ? 0 : 16) + 4 * fq);
                const bf16x8 a = __builtin_bit_cast(bf16x8, ((u32x4){v0.x, v0.y, v1.x, v1.y}));
                o[dt] = mfma16(a, pf, o[dt]);
            }
        }
#pragma unroll
        for (int pp = 0; pp < 2; ++pp) if (!dry) *(u32x4*)(qrow + 32 * pp + 8 * fq) = (u32x4){cvt_pk_bf16(o[2 * pp][0] * inv, o[2 * pp][1] * inv), cvt_pk_bf16(o[2 * pp][2] * inv, o[2 * pp][3] * inv), cvt_pk_bf16(o[2 * pp + 1][0] * inv, o[2 * pp + 1][1] * inv), cvt_pk_bf16(o[2 * pp + 1][2] * inv, o[2 * pp + 1][3] * inv)};
    }
    __syncthreads();
}

constexpr int MP = 264;
__device__ __forceinline__ void mem_item(bf16_t* proj, const bf16_t* mk, const bf16_t* mvT, int bglob0, int item, LAS unsigned char* lds, int tid, int dry) {
    const int wave = tid >> 6, lane = tid & 63, fr = lane & 15, fq = lane >> 4;
    const int qt = item & 15, h = (item >> 4) & 3, bl = item >> 6, b = bglob0 + bl;
    const size_t tok0 = (size_t)bl * SEQ + qt * 256;
    LAS bf16_t* Ms = (LAS bf16_t*)lds;
    {
        const bf16_t* src = mk + (size_t)b * 256 * 1024 + h * 256;
#pragma unroll 1
        for (int i0 = 0; i0 < 16; i0 += 8) {
            u32x4 st[8];
#pragma unroll
            for (int i = 0; i < 8; ++i) { const int ch = tid + 512 * (i0 + i), row = ch >> 5, part = ch & 31; st[i] = *(const u32x4*)(src + (size_t)row * 1024 + part * 8); }
#pragma unroll
            for (int i = 0; i < 8; ++i) { const int ch = tid + 512 * (i0 + i), row = ch >> 5, part = ch & 31; *(LAS u32x4*)(Ms + row * MP + part * 8) = st[i]; }
        }
    }
    bf16_t* qrow0 = proj + (tok0 + 16 * wave + fr) * INW + C_MQ + h * 256;
    const bf16_t* mvsrc = mvT + ((size_t)b * 1024 + h * 256) * 256;
    __syncthreads();
    bf16x8 pf[2][8]; float inv[2];
#pragma unroll
    for (int sub = 0; sub < 2; ++sub) {
        const bf16_t* qrow = qrow0 + (size_t)sub * 128 * INW;
        bf16x8 qf[8];
#pragma unroll
        for (int ks = 0; ks < 8; ++ks) qf[ks] = *(const bf16x8*)(qrow + 32 * ks + 8 * fq);
        f32x4 s[16];
#pragma unroll
        for (int t = 0; t < 16; ++t) { s[t] = (f32x4){0.f, 0.f, 0.f, 0.f};
#pragma unroll
            for (int ks = 0; ks < 8; ++ks) { const bf16x8 a = *(const LAS bf16x8*)(Ms + (16 * t + fr) * MP + 32 * ks + 8 * fq); s[t] = mfma16(a, qf[ks], s[t]); } }
        float mxr = -1e30f;
#pragma unroll
        for (int t = 0; t < 16; ++t) mxr = fmaxf(mxr, fmaxf(fmaxf(s[t][0], s[t][1]), fmaxf(s[t][2], s[t][3])));
        mxr = fmaxf(mxr, __shfl_xor(mxr, 16)); mxr = fmaxf(mxr, __shfl_xor(mxr, 32));
        const float c1 = 0.0625f * 1.4426950408889634f, mo = -mxr * c1;
        float sum = 0.f;
#pragma unroll
        for (int t = 0; t < 16; ++t)
#pragma unroll
            for (int j = 0; j < 4; ++j) { const float pv = __builtin_amdgcn_exp2f(fmaf(s[t][j], c1, mo)); s[t][j] = pv; sum += pv; }
        sum += __shfl_xor(sum, 16); sum += __shfl_xor(sum, 32);
        inv[sub] = __builtin_amdgcn_rcpf(sum);
#pragma unroll
        for (int k2 = 0; k2 < 8; ++k2) { u32x4 pw; pw.x = cvt_pk_bf16(s[2 * k2][0], s[2 * k2][1]); pw.y = cvt_pk_bf16(s[2 * k2][2], s[2 * k2][3]); pw.z = cvt_pk_bf16(s[2 * k2 + 1][0], s[2 * k2 + 1][1]); pw.w = cvt_pk_bf16(s[2 * k2 + 1][2], s[2 * k2 + 1][3]);
            pf[sub][k2] = __builtin_bit_cast(bf16x8, pw); }
    }
    __syncthreads();
    {
#pragma unroll 1
        for (int i0 = 0; i0 < 16; i0 += 8) {
            u32x4 st[8];
#pragma unroll
            for (int i = 0; i < 8; ++i) { const int ch = tid + 512 * (i0 + i), row = ch >> 5, part = ch & 31; st[i] = *(const u32x4*)(mvsrc + (size_t)row * 256 + part * 8); }
#pragma unroll
            for (int i = 0; i < 8; ++i) { const int ch = tid + 512 * (i0 + i), row = ch >> 5, part = ch & 31; *(LAS u32x4*)(Ms + rowperm(row) * MP + part * 8) = st[i]; }
        }
    }
    __syncthreads();
#pragma unroll
    for (int dp = 0; dp < 8; ++dp) {
        f32x4 oa0 = (f32x4){0.f, 0.f, 0.f, 0.f}, oa1 = oa0, ob0 = oa0, ob1 = oa0;
#pragma unroll
        for (int k2 = 0; k2 < 8; ++k2) {
            const u32x2 v0 = *(const LAS u32x2*)(Ms + (32 * dp + fr) * MP + 32 * k2 + 4 * fq), v1 = *(const LAS u32x2*)(Ms + (32 * dp + fr) * MP + 32 * k2 + 16 + 4 * fq);
            const u32x2 w0 = *(const LAS u32x2*)(Ms + (32 * dp + 16 + fr) * MP + 32 * k2 + 4 * fq), w1 = *(const LAS u32x2*)(Ms + (32 * dp + 16 + fr) * MP + 32 * k2 + 16 + 4 * fq);
            const bf16x8 a = __builtin_bit_cast(bf16x8, ((u32x4){v0.x, v0.y, v1.x, v1.y})), bb = __builtin_bit_cast(bf16x8, ((u32x4){w0.x, w0.y, w1.x, w1.y}));
            oa0 = mfma16(a, pf[0][k2], oa0); oa1 = mfma16(a, pf[1][k2], oa1); ob0 = mfma16(bb, pf[0][k2], ob0); ob1 = mfma16(bb, pf[1][k2], ob1);
        }
        if (!dry) {
            *(u32x4*)(qrow0 + 32 * dp + 8 * fq) = (u32x4){cvt_pk_bf16(oa0[0] * inv[0], oa0[1] * inv[0]), cvt_pk_bf16(oa0[2] * inv[0], oa0[3] * inv[0]), cvt_pk_bf16(ob0[0] * inv[0], ob0[1] * inv[0]), cvt_pk_bf16(ob0[2] * inv[0], ob0[3] * inv[0])};
            *(u32x4*)(qrow0 + (size_t)128 * INW + 32 * dp + 8 * fq) = (u32x4){cvt_pk_bf16(oa1[0] * inv[1], oa1[1] * inv[1]), cvt_pk_bf16(oa1[2] * inv[1], oa1[3] * inv[1]), cvt_pk_bf16(ob1[0] * inv[1], ob1[1] * inv[1]), cvt_pk_bf16(ob1[2] * inv[1], ob1[3] * inv[1])};
        }
    }
    __syncthreads();
}

#define XB_TMO      128
#define XB_XCNT(j)  (256  + 64 * (j))
#define XB_XSUB(j)  (1280 + 64 * (j))
#define XB_XGEN(j)  (2304 + 64 * (j))
#define XB_TOP      3328
#define XB_TOPGEN   3392
#define XCD_BAR_WORDS 3456
#define XB_SPIN_CAP (1u << 18)
__device__ __forceinline__ unsigned xb_ld(unsigned* p)              { return __hip_atomic_load(p, __ATOMIC_RELAXED, __HIP_MEMORY_SCOPE_AGENT); }
__device__ __forceinline__ unsigned xb_add(unsigned* p, unsigned v) { return __hip_atomic_fetch_add(p, v, __ATOMIC_RELAXED, __HIP_MEMORY_SCOPE_AGENT); }
__device__ __forceinline__ unsigned xb_xcc_id() { return (unsigned)__builtin_amdgcn_s_getreg((3 << 11) | 20) & 0xFu; }
#define XB_SPIN(cond, bar) do { unsigned _sp = 0; while (cond) { __builtin_amdgcn_s_sleep(1); \
    if ((++_sp & 255u) == 0u) { if (xb_ld(&(bar)[XB_TMO])) break; if (_sp > XB_SPIN_CAP) { atomicAdd(&(bar)[XB_TMO], 1u); break; } } } } while (0)
struct XcdBarrier { unsigned* bar; unsigned x; volatile LAS unsigned* st; };
__device__ __forceinline__ XcdBarrier xcd_barrier_post(unsigned* bar, volatile LAS unsigned* st) {
    XcdBarrier b; b.bar = bar; b.x = xb_xcc_id(); b.st = st;
    if (threadIdx.x == 0) (void)xb_add(&bar[XB_XCNT(b.x)], 1u);
    return b;
}
__device__ __forceinline__ void xcd_barrier_complete(unsigned* bar, unsigned x, unsigned& nloc, unsigned& nx) {
    const unsigned G = gridDim.x * gridDim.y * gridDim.z;
    unsigned sum, cnt, mine, sp = 0u;
    for (;;) {
        sum = 0u; cnt = 0u; mine = 0u;
#pragma unroll
        for (unsigned j = 0; j < 16; ++j) { const unsigned c = xb_ld(&bar[XB_XCNT(j)]); sum += c; cnt += (c > 0u) ? 1u : 0u; mine = (j == x) ? c : mine; }
        if (sum == G) break;
        __builtin_amdgcn_s_sleep(1);
        if ((++sp & 255u) == 0u) { if (xb_ld(&bar[XB_TMO])) break; if (sp > XB_SPIN_CAP) { atomicAdd(&bar[XB_TMO], 1u); break; } }
    }
    nloc = mine > 0u ? mine : 1u; nx = cnt > 0u ? cnt : 1u;
}
__device__ __forceinline__ void xcd_barrier(const XcdBarrier& b) {
    asm volatile("s_waitcnt vmcnt(0)" ::: "memory");
    __syncthreads();
    if (threadIdx.x == 0) {
        unsigned* bar = b.bar;
        __builtin_amdgcn_s_waitcnt(0);
        unsigned nloc = b.st[0], nx = b.st[1];
        if (nloc == 0u) { xcd_barrier_complete(bar, b.x, nloc, nx); b.st[0] = nloc; b.st[1] = nx; }
        const unsigned old = xb_add(&bar[XB_XSUB(b.x)], 1u);
        const unsigned gen = old / nloc;
        if (old + 1u == (gen + 1u) * nloc) {
            __builtin_amdgcn_fence(__ATOMIC_RELEASE, "agent");
            asm volatile("s_waitcnt vmcnt(0)" ::: "memory");
            const unsigned og = xb_add(&bar[XB_TOP], 1u);
            const unsigned tg = og / nx;
            if (og + 1u == (tg + 1u) * nx) xb_add(&bar[XB_TOPGEN], 1u);
            else XB_SPIN(xb_ld(&bar[XB_TOPGEN]) == tg, bar);
            __builtin_amdgcn_fence(__ATOMIC_ACQUIRE, "agent");
            xb_add(&bar[XB_XGEN(b.x)], 1u);
            asm volatile("s_waitcnt vmcnt(0)" ::: "memory");
        } else {
            XB_SPIN(xb_ld(&bar[XB_XGEN(b.x)]) == gen, bar);
            __builtin_amdgcn_fence(__ATOMIC_ACQUIRE, "agent");
            asm volatile("s_waitcnt vmcnt(0)" ::: "memory");
        }
    }
    __syncthreads();
}

__device__ __forceinline__ void run_phase(const Params& p, int ph, LAS unsigned char* lds, int dry) {
    int tid = threadIdx.x; asm volatile("" : "+v"(tid));
    const int lane = tid & 63, wave = tid >> 6;
    int G = gridDim.x, cu = blockIdx.x; asm volatile("" : "+s"(G), "+s"(cu));
    const int gw = cu * 8 + wave, ngw = G * 8;
    unsigned char* ws = p.ws; asm volatile("" : "+s"(ws));
    bf16_t* XB = (bf16_t*)p.out; asm volatile("" : "+s"(XB));
    const float* xin = p.in[0]; asm volatile("" : "+s"(xin));
    bf16_t* Hb = (bf16_t*)(ws + WS_H);
    if ((PHMASK & 1) && ph == NPH - 1) {
        for (int r = gw; r < T_ALL; r += ngw) rms_row_final(Hb + (size_t)r * DM, p.in[20], p.out + (size_t)r * DM, lane);
        return;
    }
    const int l = ph / NPL, k = ph - l * NPL;
    float* ssq1 = (float*)(ws + WS_SSQ); float* ssq2 = ssq1 + 4 * T_ALL; float* ssq3 = ssq2 + 4 * T_ALL;
    if (k == 0) {
        const size_t oFF = (size_t)l * DM * FF, oDD = (size_t)l * DM * DM;
        constexpr int I_F = 16 * 44, I_IN = 16 * 132, I_MKV = 16 * 32, I_DD = 16 * 16;
        constexpr int NIT = 6 * I_F + I_IN + I_MKV + 4 * I_DD;
        LAS float* scr = (LAS float*)(lds + wave * 16640);
        const float* g1 = p.in[2] + l * DM; const float* gm = p.in[6] + l * DM; const float* g2 = p.in[16] + l * DM; const float* gnone = nullptr;
        for (int it = gw; it < NIT; it += ngw) {
            int r = it;
            if (r < I_F) { wt_item(p.in[3] + oFF, DM, FF, (bf16_t*)(ws + WS_W13A), 1, r, scr, lane, g1); continue; } r -= I_F;
            if (r < I_F) { wt_item(p.in[4] + oFF, DM, FF, (bf16_t*)(ws + WS_W13A), 2, r, scr, lane, g1); continue; } r -= I_F;
            if (r < I_F) { wt_item(p.in[5] + oFF, FF, DM, (bf16_t*)(ws + WS_W2A), 0, r, scr, lane, gnone); continue; } r -= I_F;
            if (r < I_F) { wt_item(p.in[17] + oFF, DM, FF, (bf16_t*)(ws + WS_W13B), 1, r, scr, lane, g2); continue; } r -= I_F;
            if (r < I_F) { wt_item(p.in[18] + oFF, DM, FF, (bf16_t*)(ws + WS_W13B), 2, r, scr, lane, g2); continue; } r -= I_F;
            if (r < I_F) { wt_item(p.in[19] + oFF, FF, DM, (bf16_t*)(ws + WS_W2B), 0, r, scr, lane, gnone); continue; } r -= I_F;
            if (r < I_IN) { wt_item(p.in[7] + (size_t)l * DM * INW, DM, INW, (bf16_t*)(ws + WS_WIN), 0, r, scr, lane, gm); continue; } r -= I_IN;
            if (r < I_MKV) { wt_item(p.in[11] + (size_t)l * DM * 2048, DM, 2048, (bf16_t*)(ws + WS_WMKV), 0, r, scr, lane, gnone); continue; } r -= I_MKV;
            if (r < I_DD) { wt_item(p.in[12] + oDD, DM, DM, (bf16_t*)(ws + WS_WUP), 0, r, scr, lane, gnone); continue; } r -= I_DD;
            if (r < I_DD) { wt_item(p.in[13] + oDD, DM, DM, (bf16_t*)(ws + WS_WUP) + (size_t)DM * DM, 0, r, scr, lane, gnone); continue; } r -= I_DD;
            if (r < I_DD) { wt_item(p.in[14] + oDD, DM, DM, (bf16_t*)(ws + WS_WUP) + (size_t)2 * DM * DM, 0, r, scr, lane, gnone); continue; } r -= I_DD;
            wt_item(p.in[15] + oDD, DM, DM, (bf16_t*)(ws + WS_WO), 0, r, scr, lane, gnone);
        }
        for (int r = gw; r < 2048; r += ngw) rms_row_bf16(p.in[1] + (size_t)r * DM, p.in[10] + l * DM, (bf16_t*)(ws + WS_MEMH) + (size_t)r * DM, lane);
        if (l == 0) {
            for (int r = gw; r < T_ALL; r += ngw) {
                const f32x4* xr = (const f32x4*)(xin + (size_t)r * DM) + lane; u32x2* o8 = (u32x2*)(XB + (size_t)r * DM) + lane; float sacc = 0.f;
#pragma unroll
                for (int j = 0; j < 4; ++j) { const f32x4 v = __builtin_nontemporal_load(xr + 64 * j); sacc += (v.x * v.x + v.y * v.y) + (v.z * v.z + v.w * v.w); o8[64 * j] = (u32x2){cvt_pk_bf16(v.x, v.y), cvt_pk_bf16(v.z, v.w)}; }
                sacc = wave_sum(sacc); if (lane == 0) *(f32x4*)(ssq1 + (size_t)r * 4) = (f32x4){sacc, 0.f, 0.f, 0.f};
            }
            f32x2* tab = (f32x2*)(ws + WS_TAB);
            for (int i = cu * 512 + tid; i < SEQ * 64; i += G * 512) {
                const int pos = i >> 6, j = i & 63;
                const float inv = exp2f(-(float)j * (13.287712379549449f / 64.f));
                const float ang = (float)pos * inv;
                double rr = (double)ang * 0.15915494309189535; rr -= rint(rr);
                const float rf = (float)rr;
                tab[i] = (f32x2){__builtin_amdgcn_cosf(rf), __builtin_amdgcn_sinf(rf)};
            }
        }
        return;
    }
    if (k == 1 || k == 14) {
        pg8::Gemm g; g.A = XB; g.Bt = (const bf16_t*)(ws + (k == 1 ? WS_W13A : WS_W13B)); g.M = T_ALL; g.N = 2 * FF; g.K = DM; g.lda = DM; g.zoff0 = g.zoff1 = g.zoff2 = 0; g.zB = 0;
        pg8::Order S; S.init(g.M, g.N, G, cu, 1);
        LAS float* rtab = (LAS float*)(lds + pg8::STAGE_BYTES);
        { const float* sq = (k == 1) ? ssq1 : ssq3; pg8::Unit uu;
          for (int i = 0; i < 12 && S.next(i, uu); ++i) if (tid < 256) { const f32x4 q = *(const f32x4*)(sq + (size_t)(uu.pm * 256 + tid) * 4); rtab[i * 256 + tid] = rsqrtf(((q.x + q.y) + (q.z + q.w)) * (1.f / 1024.f) + 1e-6f); } }
        __syncthreads();
        pg8::EpiSwiglu E; E.U = (bf16_t*)(ws + WS_U); E.ldu = FF; E.rtab = rtab;
        pg8::gemm_phase(lds, g, S, E, tid);
        return;
    }
    if (k == 2 || k == 15 || k == 13) {
        pg8::Gemm g; pg8::EpiResid E; E.red = (LAS float*)(lds + pg8::STAGE_BYTES); g.zoff0 = g.zoff1 = g.zoff2 = 0; g.zB = 0; g.N = DM; g.M = T_ALL; E.ld = DM; E.src = XB; E.dst = XB;
        if (k == 2 || k == 15) {
            g.A = (const bf16_t*)(ws + WS_U); g.Bt = (const bf16_t*)(ws + (k == 2 ? WS_W2A : WS_W2B)); g.K = FF; g.lda = FF;
            E.scale = dry ? 0.f : 0.5f; E.ssq = (k == 2) ? ssq2 : ssq1;
            if (k == 15 && l == 1) E.dst = Hb;
        } else {
            g.A = Hb; g.Bt = (const bf16_t*)(ws + WS_WO); g.K = DM; g.lda = DM;
            E.scale = dry ? 0.f : 1.0f; E.ssq = ssq3;
        }
        pg8::Order S; S.init(g.M, g.N, G, cu, 1, 1);
        pg8::gemm_phase(lds, g, S, E, tid);
        return;
    }
    const int half = (k - 3) / 5, s = (k - 3) - 5 * half;
    bf16_t* proj = (bf16_t*)(ws + WS_PROJ);
    bf16_t* states = (bf16_t*)(ws + WS_ST);
    const f32x2* tab = (const f32x2*)(ws + WS_TAB);
    if (s == 0) {
        LAS float* rtab = (LAS float*)(lds + pg8::STAGE_BYTES);
        {
            pg8::Gemm g; g.A = XB + (size_t)half * T_HALF * DM; g.Bt = (const bf16_t*)(ws + WS_WIN); g.M = T_HALF; g.N = 8192; g.K = DM; g.lda = DM; g.zoff0 = g.zoff1 = g.zoff2 = 0; g.zB = 0;
            pg8::Order S; S.init(g.M, g.N, G, cu, 1, 2);
            { const float* sq = ssq2 + (size_t)half * T_HALF * 4; pg8::Unit uu;
              for (int i = 0; i < 12 && S.next(i, uu); ++i) if (tid < 256) { const f32x4 q = *(const f32x4*)(sq + (size_t)(uu.pm * 256 + tid) * 4); rtab[i * 256 + tid] = rsqrtf(((q.x + q.y) + (q.z + q.w)) * (1.f / 1024.f) + 1e-6f); } }
            __syncthreads();
            pg8::EpiStore E; E.O = proj; E.ldc = INW; E.rtab = rtab;
            pg8::gemm_phase(lds, g, S, E, tid);
        }
        if (half == 0) {
            {
                pg8::Gemm g; g.A = XB; g.Bt = (const bf16_t*)(ws + WS_WIN) + (size_t)8192 * DM; g.M = T_ALL; g.N = 256; g.K = DM; g.lda = DM; g.zoff0 = g.zoff1 = g.zoff2 = 0; g.zB = 0;
                pg8::Order S; S.init(g.M, g.N, G, cu < 128 ? cu : G, 1);
                { pg8::Unit uu;
                  for (int i = 0; i < 12 && S.next(i, uu); ++i) if (tid < 256) { const f32x4 q = *(const f32x4*)(ssq2 + (size_t)(uu.pm * 256 + tid) * 4); rtab[i * 256 + tid] = rsqrtf(((q.x + q.y) + (q.z + q.w)) * (1.f / 1024.f) + 1e-6f); } }
                __syncthreads();
                pg8::EpiStore E; E.O = (bf16_t*)(ws + WS_GL2); E.ldc = 256; E.rtab = rtab;
                pg8::gemm_phase(lds, g, S, E, tid);
            }
            {
                pg8::Gemm g2; g2.A = (const bf16_t*)(ws + WS_MEMH); g2.Bt = (const bf16_t*)(ws + WS_WMKV); g2.M = 2048; g2.N = 2048; g2.K = DM; g2.lda = DM; g2.zoff0 = g2.zoff1 = g2.zoff2 = 0; g2.zB = 0;
                pg8::Order S2; S2.init(2048, 2048, G, (cu >= 128 && cu < 192) ? cu - 128 : G, 1);
                pg8::EpiMkv E2; E2.mk = (bf16_t*)(ws + WS_MK); E2.mvT = (bf16_t*)(ws + WS_MVT);
                pg8::gemm_phase(lds, g2, S2, E2, tid);
            }
        }
        return;
    }
    if (s == 1) {
#ifndef MIXSUB
#define MIXSUB 7
#endif
        if (!dry || (MIXSUB & 1)) for (int it = cu; it < 512; it += G) ret_state_item(proj, tab, states, it, lds, tid);
        if (!dry || (MIXSUB & 2)) for (int it = cu; it < 256; it += G) swa_item(proj, p.in[9] + l * 16, it, lds, tid, dry);
        if (!dry || (MIXSUB & 4)) for (int it = cu; it < 256; it += G) mem_item(proj, (const bf16_t*)(ws + WS_MK), (const bf16_t*)(ws + WS_MVT), half * 4, it, lds, tid, dry);
        return;
    }
    if (s == 2) { ret_scan(states, cu * 512 + tid, G * 512, dry); return; }
    if (s == 3) {
        for (int it = cu; it < 512; it += G) ret_out_item(proj, tab, states, p.in[8] + l * 1024, it, lds, tid, dry);
        return;
    }
    {
        pg8::Gemm g; g.A = proj; g.Bt = (const bf16_t*)(ws + WS_WUP); g.M = T_HALF; g.N = DM; g.K = DM; g.lda = INW; g.zoff0 = C_RG; g.zoff1 = C_SQ; g.zoff2 = C_MQ; g.zB = (long)DM * DM;
        pg8::Order S; S.init(g.M, g.N, G, cu, 3);
        pg8::EpiGate E; E.Mg = Hb + (size_t)half * T_HALF * DM; E.gl = proj + C_GL; E.ldg = INW; E.gl2 = (const bf16_t*)(ws + WS_GL2) + (size_t)half * T_HALF * 256;
        pg8::gemm_phase(lds, g, S, E, tid);
    }
}

__global__ __launch_bounds__(512, 2) void mega(Params p, int ph_lo, int ph_hi) {
    extern __shared__ __attribute__((aligned(16))) unsigned char shm[];
    LAS unsigned char* lds = (LAS unsigned char*)shm;
    cg::grid_group grid = cg::this_grid();
    volatile LAS unsigned* st = (volatile LAS unsigned*)(lds + LDS_PHASE);
    if (threadIdx.x == 0) { st[0] = 0u; st[1] = 0u; st[2] = 0u; st[3] = 0u; }
    __syncthreads();
    const XcdBarrier xb = xcd_barrier_post((unsigned*)(p.ws + WS_BAR), st);
    for (int ph = ph_lo; ph < ph_hi; ++ph) {
        int nrep = 1;
#if DBL_MASK
        { const int kk = (ph == NPH - 1) ? 16 : ph % NPL; nrep += (DBL_MASK >> kk) & 1; }
#endif
        for (int rep = 0; rep < nrep; ++rep) { int dry = rep; asm volatile("" : "+s"(dry)); run_phase(p, ph, lds, dry); if (rep + 1 < nrep) __syncthreads(); }
        if (ph + 1 < ph_hi) { if (ph_hi < 0) grid.sync(); else xcd_barrier(xb); }
    }
}

extern "C" void kernel_launch(void* const* d_in, const int* in_sizes, int n_in, void* d_out, int out_size, void* d_ws, size_t ws_size, hipStream_t stream) {
    static int grid = 0;
    if (grid == 0) {
        if (n_in != 21 || out_size != T_ALL * DM || ws_size < WS_END2) { fprintf(stderr, "kernel_launch: unexpected shapes (n_in %d out %d ws %zu need %zu)\n", n_in, out_size, ws_size, (size_t)WS_END2); grid = -1; return; }
        int dev = 0, cus = 0, per_cu = 0;
        if (hipGetDevice(&dev) != hipSuccess || hipDeviceGetAttribute(&cus, hipDeviceAttributeMultiprocessorCount, dev) != hipSuccess) { grid = -1; return; }
        if (hipFuncSetAttribute((const void*)mega, hipFuncAttributeMaxDynamicSharedMemorySize, LDS_BYTES) != hipSuccess) { fprintf(stderr, "kernel_launch: hipFuncSetAttribute failed\n"); grid = -1; return; }
        if (hipOccupancyMaxActiveBlocksPerMultiprocessor(&per_cu, (const void*)mega, 512, LDS_BYTES) != hipSuccess || per_cu < 1) { fprintf(stderr, "kernel_launch: occupancy query says %d\n", per_cu); per_cu = 1; }
        (void)hipGetLastError();
        grid = cus;
    }
    if (grid <= 0) return;
    Params p{};
    for (int i = 0; i < 21; ++i) p.in[i] = (const float*)d_in[i];
    p.out = (float*)d_out; p.ws = (unsigned char*)d_ws;
    (void)hipMemsetAsync((unsigned char*)d_ws + WS_BAR, 0, 16384, stream);
#if MK_ONE_LAUNCH
    int lo = 0, hi = NPH;
    void* args[] = {&p, &lo, &hi};
    hipError_t e = hipLaunchCooperativeKernel((const void*)mega, dim3(grid), dim3(512), args, LDS_BYTES, stream);
    if (e != hipSuccess) fprintf(stderr, "cooperative launch failed: %s (grid %d)\n", hipGetErrorString(e), grid);
#else
    for (int ph = 0; ph < NPH; ++ph) hipLaunchKernelGGL(mega, dim3(grid), dim3(512), LDS_BYTES, stream, p, ph, ph + 1);
#endif
}
```
